# Optimizing an MI355X kernel written in HIP

```python
import math
import jax
import jax.numpy as jnp
from jax import lax
import numpy as np

D_MODEL = 1024
BATCH = 2
SEQ = 8192
DEPTH = 4

GRID_W = 64
CTX_LEN = 256
N_MIXERS = 4
CTX_READING_MIXERS = (0, 1)
RMS_EPS = 1e-6
MLP_HIDDEN = 4 * D_MODEL
N_MOD = 6

SSD_EXPAND = 2
SSD_INNER = SSD_EXPAND * D_MODEL
SSD_HEADDIM = 64
SSD_HEADS = SSD_INNER // SSD_HEADDIM
SSD_GROUPS = 4
SSD_HPG = SSD_HEADS // SSD_GROUPS
SSD_STATE = 128
SSD_CONV = 3
SSD_CHUNK = 128
SSD_BC = 2 * 2 * SSD_GROUPS * SSD_STATE
SSD_CONV_CH = SSD_INNER + SSD_BC
SSD_IN = SSD_INNER + SSD_CONV_CH + 2 * SSD_HEADS

NA_HEADS = 16
NA_HEADDIM = D_MODEL // NA_HEADS
NA_WIN_ROWS = 8
NA_WIN_COLS = 16

SC_CONV = 3

FN_GROUPS = 8
FN_GROUP_CH = D_MODEL // FN_GROUPS

kernel_name = 'hybrid_interleaved_diffusion_trunk'


def rmsnorm(t, g):
    tf = t.astype(jnp.float32)
    tf = tf * lax.rsqrt(jnp.mean(tf * tf, axis=-1, keepdims=True) + RMS_EPS)
    return tf.astype(t.dtype) * g


def modulate(t, shift, scale):
    return t * (1 + scale) + shift


def dwconv_centred(u, w):
    k, ch = w.shape
    return lax.conv_general_dilated(u, w[:, None, :], window_strides=(1,), padding=[(k // 2, k // 2)],
                                    dimension_numbers=('NWC', 'WIO', 'NWC'), feature_group_count=ch)


def sq_relu_mlp(h, w1, w2):
    return jnp.square(jax.nn.relu(h @ w1)) @ w2


def finish_layer(t, y, m, g, w1, w2):
    t = t + m[2] * rmsnorm(y, g[1])
    h2 = modulate(rmsnorm(t, g[2]), m[3], m[4])
    return t + m[5] * rmsnorm(sq_relu_mlp(h2, w1, w2), g[3])


def ssd_scan(x, dt, a, bm, cm, state0):
    bsz, seq = x.shape[:2]
    nc = seq // SSD_CHUNK

    def chunkify(t):
        return jnp.moveaxis(t.reshape(bsz, nc, SSD_CHUNK, *t.shape[2:]), 1, 0)

    mask = jnp.tril(jnp.ones((SSD_CHUNK, SSD_CHUNK), bool))[:, :, None, None]

    def step(state, inp):
        xc, dtc, bc, cc = inp
        cum = jnp.cumsum(dtc * a, axis=1)
        seg = cum[:, :, None] - cum[:, None, :]
        decay = jnp.exp(jnp.where(mask, seg, -jnp.inf))
        cb = jnp.einsum('bign,bjgn->bijg', cc, bc)
        scores = cb[..., None] * decay * dtc[:, None]
        y = jnp.einsum('bijge,bjgep->bigep', scores, xc)
        y = y + jnp.einsum('bign,bgepn->bigep', cc, state) * jnp.exp(cum)[..., None]
        w_end = jnp.exp(cum[:, -1:] - cum) * dtc
        state = state * jnp.exp(cum[:, -1])[..., None, None] + jnp.einsum('bjgn,bjge,bjgep->bgepn', bc, w_end, xc)
        return state, y

    state, ys = lax.scan(step, state0, (chunkify(x), chunkify(dt), chunkify(bm), chunkify(cm)))
    return jnp.moveaxis(ys, 0, 1).reshape(x.shape), state


def ssd_mixer(h, w_in, conv_w, conv_b, dt_bias, a_log, d_skip, norm_g, state0):
    bsz, seq, _ = h.shape
    proj = h @ w_in
    z = proj[..., :SSD_INNER]
    xbc = jax.nn.silu(dwconv_centred(proj[..., SSD_INNER:SSD_INNER + SSD_CONV_CH], conv_w) + conv_b)
    dt_raw = proj[..., SSD_INNER + SSD_CONV_CH:].reshape(bsz, seq, 2, SSD_HEADS)
    xs = xbc[..., :SSD_INNER].reshape(bsz, seq, SSD_GROUPS, SSD_HPG, SSD_HEADDIM).astype(jnp.float32)
    bc = xbc[..., SSD_INNER:].reshape(bsz, seq, 2, 2, SSD_GROUPS, SSD_STATE).astype(jnp.float32)
    dt = jax.nn.softplus(dt_raw.astype(jnp.float32) + dt_bias.astype(jnp.float32))
    dt = dt.reshape(bsz, seq, 2, SSD_GROUPS, SSD_HPG)
    a = -jnp.exp(a_log.astype(jnp.float32)).reshape(2, SSD_GROUPS, SSD_HPG)
    rev = lambda t: jnp.flip(t, axis=1)
    y_f, s_f = ssd_scan(xs, dt[:, :, 0], a[0], bc[:, :, 0, 0], bc[:, :, 0, 1], state0[0])
    y_b, s_b = ssd_scan(rev(xs), rev(dt[:, :, 1]), a[1], rev(bc[:, :, 1, 0]), rev(bc[:, :, 1, 1]), state0[1])
    d_tot = d_skip.astype(jnp.float32).sum(0).reshape(SSD_GROUPS, SSD_HPG)
    y = y_f + rev(y_b) + d_tot[..., None] * xs
    y = y.reshape(bsz, seq, SSD_INNER).astype(h.dtype) * jax.nn.silu(z)
    return rmsnorm(y, norm_g), jnp.stack([s_f, s_b])


def split_qkv(h, w_qkv):
    bsz, seq, _ = h.shape
    qkv = (h @ w_qkv).reshape(bsz, seq, 3, NA_HEADS, NA_HEADDIM)
    return qkv[:, :, 0], qkv[:, :, 1], qkv[:, :, 2]


def context_attention(qc, kc, vc):
    bsz, n, _, _ = qc.shape
    s = jnp.einsum('bqhd,bkhd->bhqk', qc, kc) * NA_HEADDIM ** -0.5
    p = jax.nn.softmax(s.astype(jnp.float32), axis=-1).astype(vc.dtype)
    return jnp.einsum('bhqk,bkhd->bqhd', p, vc).reshape(bsz, n, D_MODEL)


def neighbourhood_attention(h, kc, vc, w_qkv, rpb):
    bsz, seq, _ = h.shape
    rows = seq // GRID_W
    wr = min(NA_WIN_ROWS, rows)
    wc = NA_WIN_COLS
    n_loc = wr * wc
    q, k, v = split_qkv(h, w_qkv)
    q, k, v = (t.reshape(bsz, rows, GRID_W, NA_HEADS, NA_HEADDIM) for t in (q, k, v))
    cols = jnp.arange(GRID_W)
    col_idx = jnp.clip(cols - wc // 2, 0, GRID_W - wc)[:, None] + jnp.arange(wc)
    rpb_col = jnp.take(rpb, col_idx - cols[:, None] + NA_WIN_COLS - 1, axis=2)
    scale = NA_HEADDIM ** -0.5

    def row_block(r):
        r0 = jnp.clip(r - wr // 2, 0, rows - wr)
        q_r = lax.dynamic_index_in_dim(q, r, axis=1, keepdims=False)
        k_w = jnp.take(lax.dynamic_slice_in_dim(k, r0, wr, axis=1), col_idx, axis=2)
        v_w = jnp.take(lax.dynamic_slice_in_dim(v, r0, wr, axis=1), col_idx, axis=2)
        bias = jnp.take(rpb_col, r0 + jnp.arange(wr) - r + NA_WIN_ROWS - 1, axis=1)
        s_loc = jnp.einsum('bqhd,bwqchd->bqhwc', q_r, k_w) * scale + jnp.transpose(bias, (2, 0, 1, 3))
        s_ctx = jnp.einsum('bqhd,bkhd->bqhk', q_r, kc) * scale
        s = jnp.concatenate([s_loc.reshape(bsz, GRID_W, NA_HEADS, n_loc), s_ctx], axis=-1)
        p = jax.nn.softmax(s.astype(jnp.float32), axis=-1).astype(v.dtype)
        p_loc = p[..., :n_loc].reshape(bsz, GRID_W, NA_HEADS, wr, wc)
        return (jnp.einsum('bqhwc,bwqchd->bqhd', p_loc, v_w)
                + jnp.einsum('bqhk,bkhd->bqhd', p[..., n_loc:], vc))

    out = lax.map(row_block, jnp.arange(rows))
    return jnp.transpose(out, (1, 0, 2, 3, 4)).reshape(bsz, seq, D_MODEL)


def short_conv_mixer(h, w_in, conv_w, w_out):
    b_gate, c_gate, u = jnp.split(h @ w_in, 3, axis=-1)
    return (b_gate * dwconv_centred(c_gate * u, conv_w)) @ w_out


def fourier_mixer(h, w_out):
    bsz, seq, _ = h.shape
    hg = h.astype(jnp.float32).reshape(bsz, seq, FN_GROUPS, FN_GROUP_CH)
    f = jnp.fft.fft2(hg, axes=(1, 3)).real.reshape(bsz, seq, D_MODEL)
    return f.astype(h.dtype) @ w_out


def setup_inputs(seed: int = 0) -> dict:
    key = jax.random.key(seed)
    kit = iter(list(jax.random.split(key, 32)))
    f32 = jnp.float32

    def nrm(shape, scale):
        return jax.random.normal(next(kit), shape, f32) * scale

    n_a, n_b, n_c, n_d = (len(range(k, DEPTH, N_MIXERS)) for k in range(N_MIXERS))
    dt0 = jnp.exp(jax.random.uniform(next(kit), (n_a, 2, SSD_HEADS), f32, math.log(1e-3), math.log(1e-1)))
    return {
        'x': nrm((BATCH, SEQ, D_MODEL), 1.0),
        'c': nrm((BATCH, D_MODEL), 1.0),
        'ctx': nrm((BATCH, CTX_LEN, D_MODEL), 1.0),
        'c_ctx': nrm((D_MODEL,), 1.0),
        'mod_w': nrm((DEPTH, D_MODEL, N_MOD * D_MODEL), 0.5 * D_MODEL ** -0.5),
        'mod_b': nrm((DEPTH, N_MOD * D_MODEL), 0.02),
        'norm_g': 1.0 + nrm((DEPTH, 4, D_MODEL), 0.05),
        'mlp_w1': nrm((DEPTH, D_MODEL, MLP_HIDDEN), D_MODEL ** -0.5),
        'mlp_w2': nrm((DEPTH, MLP_HIDDEN, D_MODEL), MLP_HIDDEN ** -0.5),
        'ssd_w_in': nrm((n_a, D_MODEL, SSD_IN), D_MODEL ** -0.5),
        'ssd_conv_w': nrm((n_a, SSD_CONV, SSD_CONV_CH), SSD_CONV ** -0.5),
        'ssd_conv_b': nrm((n_a, SSD_CONV_CH), 0.02),
        'ssd_dt_bias': dt0 + jnp.log(-jnp.expm1(-dt0)),
        'ssd_a_log': jnp.log(jax.random.uniform(next(kit), (n_a, 2, SSD_HEADS), f32, 1.0, 16.0)),
        'ssd_d': 1.0 + nrm((n_a, 2, SSD_HEADS), 0.1),
        'ssd_norm_g': 1.0 + nrm((n_a, SSD_INNER), 0.05),
        'ssd_w_out': nrm((n_a, SSD_INNER, D_MODEL), SSD_INNER ** -0.5),
        'na_w_qkv': nrm((n_b, D_MODEL, 3 * D_MODEL), D_MODEL ** -0.5),
        'na_rpb': nrm((n_b, NA_HEADS, 2 * NA_WIN_ROWS - 1, 2 * NA_WIN_COLS - 1), 0.1),
        'na_w_out': nrm((n_b, D_MODEL, D_MODEL), D_MODEL ** -0.5),
        'sc_w_in': nrm((n_c, D_MODEL, 3 * D_MODEL), D_MODEL ** -0.5),
        'sc_conv_w': nrm((n_c, SC_CONV, D_MODEL), SC_CONV ** -0.5),
        'sc_w_out': nrm((n_c, D_MODEL, D_MODEL), D_MODEL ** -0.5),
        'fn_w_out': nrm((n_d, D_MODEL, D_MODEL), D_MODEL ** -0.5),
    }


def reference(x, c, ctx, c_ctx, mod_w, mod_b, norm_g, mlp_w1, mlp_w2, ssd_w_in, ssd_conv_w, ssd_conv_b,
              ssd_dt_bias, ssd_a_log, ssd_d, ssd_norm_g, ssd_w_out, na_w_qkv, na_rpb, na_w_out,
              sc_w_in, sc_conv_w, sc_w_out, fn_w_out):
    c_act = jax.nn.silu(c)
    c_ctx_act = jax.nn.silu(c_ctx)
    for i in range(DEPTH):
        kind, j = i % N_MIXERS, i // N_MIXERS
        ctx_needed_later = any((l % N_MIXERS) in CTX_READING_MIXERS for l in range(i + 1, DEPTH))
        m_lat = [m[:, None, :] for m in jnp.split(c_act @ mod_w[i] + mod_b[i], N_MOD, axis=-1)]
        m_ctx = jnp.split(c_ctx_act @ mod_w[i] + mod_b[i], N_MOD, axis=-1)
        g = norm_g[i]
        h = modulate(rmsnorm(x, g[0]), m_lat[0], m_lat[1])
        hc = None
        if kind in CTX_READING_MIXERS or ctx_needed_later:
            hc = modulate(rmsnorm(ctx, g[0]), m_ctx[0], m_ctx[1])
        y_ctx = None
        if kind == 0:
            prm = (ssd_w_in[j], ssd_conv_w[j], ssd_conv_b[j], ssd_dt_bias[j], ssd_a_log[j], ssd_d[j], ssd_norm_g[j])
            zero_state = jnp.zeros((2, hc.shape[0], SSD_GROUPS, SSD_HPG, SSD_HEADDIM, SSD_STATE), jnp.float32)
            yc_inner, ctx_states = ssd_mixer(hc, *prm, zero_state)
            y_inner, _ = ssd_mixer(h, *prm, ctx_states)
            y = y_inner @ ssd_w_out[j]
            if ctx_needed_later:
                y_ctx = yc_inner @ ssd_w_out[j]
        elif kind == 1:
            qc, kc, vc = split_qkv(hc, na_w_qkv[j])
            y = neighbourhood_attention(h, kc, vc, na_w_qkv[j], na_rpb[j]) @ na_w_out[j]
            if ctx_needed_later:
                y_ctx = context_attention(qc, kc, vc) @ na_w_out[j]
        elif kind == 2:
            y = short_conv_mixer(h, sc_w_in[j], sc_conv_w[j], sc_w_out[j])
            if ctx_needed_later:
                y_ctx = short_conv_mixer(hc, sc_w_in[j], sc_conv_w[j], sc_w_out[j])
        else:
            y = fourier_mixer(h, fn_w_out[j])
            if ctx_needed_later:
                y_ctx = fourier_mixer(hc, fn_w_out[j])
        x = finish_layer(x, y, m_lat, g, mlp_w1[i], mlp_w2[i])
        if ctx_needed_later:
            ctx = finish_layer(ctx, y_ctx, m_ctx, g, mlp_w1[i], mlp_w2[i])
    return x
```

```cpp
#include <hip/hip_runtime.h>
#include <hip/hip_cooperative_groups.h>
#include <cstdio>
#include <cstdint>
namespace cg = cooperative_groups;
namespace pg8 {
#define PG8_LAS __attribute__((address_space(3)))
typedef unsigned short bf16_t;
typedef short bf16x8 __attribute__((ext_vector_type(8)));
typedef float f32x4 __attribute__((ext_vector_type(4)));
typedef unsigned u32x4 __attribute__((ext_vector_type(4)));
constexpr int BM = 256, BK = 64, HALF = 128, HTB = HALF * BK * 2  , STAGE_BYTES = 8 * HTB, NXCD = 8, WGM = 8;

__host__ __device__ __forceinline__ int lds_byte(int r, int c) { const int st = (r >> 4) * 2 + (c >> 5), rr = r & 15, cc = c & 31, ob = rr * 64 + cc * 2; return st * 1024 + (ob ^ (((ob >> 9) & 1) << 5)); }
__host__ __device__ __forceinline__ void stage_rc(int b, int& R, int& C) { const int st = b / 1024, sb = b % 1024, swz = sb ^ (((sb >> 9) & 1) << 5); R = (st >> 1) * 16 + swz / 64; C = (st & 1) * 32 + (swz % 64) / 2; }
__host__ __device__ __forceinline__ int perm32(int rho) { const int n = rho >> 4, i = rho & 15; return 8 * (i >> 2) + 4 * n + (i & 3); }

struct Unit { int pm, pn; };
struct Gemm { const bf16_t* A; const bf16_t* Bt; int M, N, K; };

struct StaticOrder {
    int nM, nN, nwg, G, c;
    __host__ __device__ void init(int M, int N, int G_, int c_) { nM = M / BM; nN = N / BM; nwg = nM * nN; G = G_; c = c_; }
    __host__ __device__ bool next(int i, Unit& u) const {
        const long L = (long)i * G + c; if (L >= nwg) return false;
        int wgid = (int)L; { const int q = nwg / NXCD, r = nwg % NXCD, xcd = wgid % NXCD, off = wgid / NXCD; wgid = (xcd < r ? xcd * (q + 1) : r * (q + 1) + (xcd - r) * q) + off; }
        const int nig = WGM * nN, gid = wgid / nig, fm = gid * WGM, gsz = (nM - fm) < WGM ? (nM - fm) : WGM;
        u.pm = fm + ((wgid % nig) % gsz); u.pn = (wgid % nig) / gsz; return true;
    }
    __device__ __forceinline__ void a_ready(const Unit&) const {}
    __device__ __forceinline__ void done(const Unit&) const {}
};

typedef float f32x2_cv __attribute__((ext_vector_type(2))); typedef __bf16 bf16x2_cv __attribute__((ext_vector_type(2)));
__device__ __forceinline__ unsigned cvt_pk_bf16(float lo, float hi) { const f32x2_cv v = {lo, hi}; const bf16x2_cv b = __builtin_convertvector(v, bf16x2_cv); return __builtin_bit_cast(unsigned, b); }
typedef float f32x2 __attribute__((ext_vector_type(2)));
template <int ACT> struct EpiStore {
    static constexpr bool PERM = true, AFTER_DRAIN = false;
    bf16_t* O; int ldc;
    __device__ __forceinline__ void operator()(const f32x4 (&acc)[2][2][4][2], const Unit& u, int wr, int wc, int fr, int fq) const {
        const int row0 = u.pm * BM + wr * 64 + fr; const int col0 = u.pn * BM + wc * 32 + 8 * fq;
#pragma unroll
        for (int ai = 0; ai < 2; ++ai)
#pragma unroll
            for (int m = 0; m < 4; ++m) { bf16_t* rowp = O + (size_t)(row0 + ai * HALF + m * 16) * ldc + col0;
#pragma unroll
                for (int bj = 0; bj < 2; ++bj) { f32x4 v0 = acc[ai][bj][m][0], v1 = acc[ai][bj][m][1];
                    if (ACT == 1) {
#pragma unroll
                        for (int e = 0; e < 4; ++e) { float a = v0[e] > 0.f ? v0[e] : 0.f; v0[e] = a * a; float b = v1[e] > 0.f ? v1[e] : 0.f; v1[e] = b * b; } }
                    u32x4 w; w.x = cvt_pk_bf16(v0[0], v0[1]); w.y = cvt_pk_bf16(v0[2], v0[3]); w.z = cvt_pk_bf16(v1[0], v1[1]); w.w = cvt_pk_bf16(v1[2], v1[3]);
                    *(u32x4*)(rowp + bj * HALF) = w; } }
    }
};
struct EpiSsdIn {
    static constexpr bool PERM = true, AFTER_DRAIN = false;
    bf16_t* ZX; float* DT; const float* dt_bias;
    __device__ __forceinline__ void operator()(const f32x4 (&acc)[2][2][4][2], const Unit& u, int wr, int wc, int fr, int fq) const {
        const int row0 = u.pm * BM + wr * 64 + fr;
        if (u.pn < 24) {
            const int col0 = u.pn * BM + wc * 32 + 8 * fq;
#pragma unroll
            for (int ai = 0; ai < 2; ++ai)
#pragma unroll
                for (int m = 0; m < 4; ++m) { bf16_t* rowp = ZX + (size_t)(row0 + ai * HALF + m * 16) * 6144 + col0;
#pragma unroll
                    for (int bj = 0; bj < 2; ++bj) { const f32x4 v0 = acc[ai][bj][m][0], v1 = acc[ai][bj][m][1];
                        u32x4 w; w.x = cvt_pk_bf16(v0[0], v0[1]); w.y = cvt_pk_bf16(v0[2], v0[3]); w.z = cvt_pk_bf16(v1[0], v1[1]); w.w = cvt_pk_bf16(v1[2], v1[3]);
                        *(u32x4*)(rowp + bj * HALF) = w; } }
        } else if (wc < 2) {
            const int col0 = wc * 32 + 8 * fq;
#pragma unroll
            for (int ai = 0; ai < 2; ++ai)
#pragma unroll
                for (int m = 0; m < 4; ++m) { float* rowp = DT + (size_t)(row0 + ai * HALF + m * 16) * 64 + col0;
#pragma unroll
                    for (int n = 0; n < 2; ++n) { f32x4 v = acc[ai][0][m][n]; f32x4 o;
#pragma unroll
                        for (int e = 0; e < 4; ++e) { const float x = v[e] + dt_bias[col0 + 4 * n + e]; o[e] = x > 20.f ? x : log1pf(__expf(x)); }
                        *(f32x4*)(rowp + 4 * n) = o; } }
        }
    }
};
#ifndef PG8_AUX
#define PG8_AUX 0
#endif

template <class Epi, class Sched, bool ALIGN_EPI = false, bool SP2 = false>
__device__ __forceinline__ void gemm_phase(PG8_LAS unsigned char* lds, const Gemm g, const Sched& S, const Epi& E) {
    int tid_l = threadIdx.x; asm volatile("" : "+v"(tid_l)); const int tid = tid_l, wid = __builtin_amdgcn_readfirstlane(tid >> 6), lane = tid & 63, wr = wid >> 2, wc = wid & 3, fr = lane & 15, fq = lane >> 4;
    const int K = g.K, nt = K / BK;
    unsigned voffA[2], voffB[2];
#pragma unroll
    for (int i = 0; i < 2; ++i) { int R, C; stage_rc(tid * 16 + i * 8192, R, C); const int Rb = Epi::PERM ? ((R & ~31) + perm32(R & 31)) : R;
        voffA[i] = (unsigned)(R * K + C) * 2u; voffB[i] = (unsigned)(Rb * K + C) * 2u; }
    const size_t kstep = (size_t)(BK * 2);
    const size_t hstep = (size_t)HALF * K * 2;
    const size_t tstep = 2 * hstep;
    const unsigned ldsw = (unsigned)wid * 1024u;
    const int aoff = lds_byte(wr * 64 + fr, fq * 8), boff = lds_byte(wc * 32 + fr, fq * 8);
#define PG8_SA(b, h) (((b) * 2 + (h)) * HTB)
#define PG8_SB(b, h) ((4 + (b) * 2 + (h)) * HTB)
#define PG8_STAGE(bufoff, gbase, voff) do { _Pragma("unroll") for (int _i = 0; _i < 2; ++_i) \
        __builtin_amdgcn_global_load_lds((const unsigned*)((const char*)(gbase) + (voff)[_i]), (PG8_LAS unsigned*)(lds + (bufoff) + ldsw + _i * 8192), 16, 0, PG8_AUX); } while (0)
#define PG8_LDA(dst, b, h) do { _Pragma("unroll") for (int m = 0; m < 4; ++m) _Pragma("unroll") for (int k = 0; k < 2; ++k) dst[m][k] = *(const PG8_LAS bf16x8*)(lds + PG8_SA(b, h) + aoff + m * 2048 + k * 1024); } while (0)
#define PG8_LDB(dst, b, h) do { _Pragma("unroll") for (int n = 0; n < 2; ++n) _Pragma("unroll") for (int k = 0; k < 2; ++k) dst[n][k] = *(const PG8_LAS bf16x8*)(lds + PG8_SB(b, h) + boff + n * 2048 + k * 1024); } while (0)
#define PG8_MMA(ai, bj, At, Bt) do { __builtin_amdgcn_s_setprio(1); _Pragma("unroll") for (int m = 0; m < 4; ++m) _Pragma("unroll") for (int n = 0; n < 2; ++n) _Pragma("unroll") for (int k = 0; k < 2; ++k) \
        acc[ai][bj][m][n] = __builtin_amdgcn_mfma_f32_16x16x32_bf16(Bt[n][k], At[m][k], acc[ai][bj][m][n], 0, 0, 0); __builtin_amdgcn_s_setprio(0); } while (0)
#define PG8_WAIT_V(n) asm volatile("s_waitcnt vmcnt(" #n ")" ::: "memory")
#define PG8_WAIT_L(n) asm volatile("s_waitcnt lgkmcnt(" #n ")" ::: "memory")
#define PG8_BAR __builtin_amdgcn_s_barrier()
#define PG8_SCHED __builtin_amdgcn_sched_barrier(0)
    Unit cur, nxt; int ui = 0;
    if (!S.next(0, cur)) return;
    f32x4 acc[2][2][4][2];
#pragma unroll
    for (int a = 0; a < 2; ++a)
#pragma unroll
        for (int b = 0; b < 2; ++b)
#pragma unroll
            for (int m = 0; m < 4; ++m)
#pragma unroll
                for (int n = 0; n < 2; ++n) acc[a][b][m][n] = (f32x4){0.f, 0.f, 0.f, 0.f};
    bf16x8 At[4][2], B0[2][2], B1[2][2];
    const char* cA = (const char*)g.A + (size_t)cur.pm * tstep; const char* cB = (const char*)g.Bt + (size_t)cur.pn * tstep;
    S.a_ready(cur);
    if constexpr (SP2) {
        PG8_STAGE(PG8_SB(0, 0), cB, voffB); PG8_STAGE(PG8_SB(0, 1), cB + hstep, voffB); PG8_STAGE(PG8_SA(0, 0), cA, voffA); PG8_STAGE(PG8_SA(0, 1), cA + hstep, voffA);
        if (wr == 1) PG8_BAR;
        PG8_WAIT_V(2); PG8_BAR;
        PG8_STAGE(PG8_SB(1, 0), cB + kstep, voffB); PG8_STAGE(PG8_SA(1, 0), cA + kstep, voffA); PG8_STAGE(PG8_SB(1, 1), cB + hstep + kstep, voffB);
        PG8_WAIT_V(6); PG8_BAR;
    } else {
        PG8_STAGE(PG8_SB(0, 0), cB, voffB); PG8_STAGE(PG8_SA(0, 0), cA, voffA); PG8_STAGE(PG8_SB(0, 1), cB + hstep, voffB); PG8_STAGE(PG8_SA(0, 1), cA + hstep, voffA);
        if (wr == 1) PG8_BAR;
        PG8_WAIT_V(4); PG8_BAR;
        PG8_STAGE(PG8_SB(1, 0), cB + kstep, voffB); PG8_STAGE(PG8_SA(1, 0), cA + kstep, voffA); PG8_STAGE(PG8_SB(1, 1), cB + hstep + kstep, voffB);
        PG8_WAIT_V(6); PG8_BAR;
    }
    for (;;) {
        const bool has_next = S.next(ui + 1, nxt);
        const char* nA = has_next ? (const char*)g.A + (size_t)nxt.pm * tstep : cA; const char* nB = has_next ? (const char*)g.Bt + (size_t)nxt.pn * tstep : cB;
        for (int t = 0; t < nt; t += 2) {
            const bool last = (t == nt - 2);
            const char* a1 = cA + (size_t)(t + 1) * kstep;
            const char* a2 = last ? nA : cA + (size_t)(t + 2) * kstep; const char* b2 = last ? nB : cB + (size_t)(t + 2) * kstep;
            const char* a3 = a2 + kstep; const char* b3 = b2 + kstep;
            if (last && has_next) S.a_ready(nxt);
            if constexpr (SP2) {
            PG8_LDB(B0, 0, 0); PG8_LDB(B1, 0, 1); PG8_SCHED; PG8_LDA(At, 0, 0); PG8_STAGE(PG8_SA(1, 1), a1 + hstep, voffA);
            PG8_WAIT_V(8); PG8_WAIT_L(0); PG8_BAR; PG8_MMA(0, 0, At, B0); PG8_MMA(0, 1, At, B1); PG8_BAR; PG8_SCHED;
            PG8_LDA(At, 0, 1); PG8_STAGE(PG8_SB(0, 0), b2, voffB); PG8_STAGE(PG8_SB(0, 1), b2 + hstep, voffB); PG8_STAGE(PG8_SA(0, 0), a2, voffA);
            PG8_WAIT_V(8); PG8_WAIT_L(0); PG8_BAR; PG8_MMA(1, 0, At, B0); PG8_MMA(1, 1, At, B1); PG8_BAR; PG8_SCHED;
            PG8_LDB(B0, 1, 0); PG8_LDB(B1, 1, 1); PG8_SCHED; PG8_LDA(At, 1, 0); PG8_STAGE(PG8_SA(0, 1), a2 + hstep, voffA);
            PG8_WAIT_V(8); PG8_WAIT_L(0); PG8_BAR; PG8_MMA(0, 0, At, B0); PG8_MMA(0, 1, At, B1); PG8_BAR; PG8_SCHED;
            PG8_LDA(At, 1, 1); PG8_STAGE(PG8_SB(1, 0), b3, voffB); PG8_STAGE(PG8_SB(1, 1), b3 + hstep, voffB); PG8_STAGE(PG8_SA(1, 0), a3, voffA);
            PG8_WAIT_V(8); PG8_WAIT_L(0); PG8_BAR; PG8_MMA(1, 0, At, B0); PG8_MMA(1, 1, At, B1); PG8_BAR; PG8_SCHED;
            } else {
            PG8_LDB(B0, 0, 0); PG8_SCHED; PG8_LDA(At, 0, 0); PG8_STAGE(PG8_SA(1, 1), a1 + hstep, voffA);
            PG8_WAIT_L(8); PG8_BAR; PG8_WAIT_L(0); PG8_MMA(0, 0, At, B0); PG8_BAR; PG8_SCHED;
            PG8_LDB(B1, 0, 1); PG8_STAGE(PG8_SB(0, 0), b2, voffB);
            PG8_BAR; PG8_WAIT_L(0); PG8_MMA(0, 1, At, B1); PG8_BAR;
            PG8_LDA(At, 0, 1); PG8_STAGE(PG8_SA(0, 0), a2, voffA);
            PG8_BAR; PG8_WAIT_L(0); PG8_MMA(1, 0, At, B0); PG8_BAR; PG8_SCHED;
            PG8_STAGE(PG8_SB(0, 1), b2 + hstep, voffB);
            PG8_WAIT_V(6); PG8_BAR; PG8_MMA(1, 1, At, B1); PG8_BAR;
            PG8_LDB(B0, 1, 0); PG8_SCHED; PG8_LDA(At, 1, 0); PG8_STAGE(PG8_SA(0, 1), a2 + hstep, voffA);
            PG8_WAIT_L(8); PG8_BAR; PG8_WAIT_L(0); PG8_MMA(0, 0, At, B0); PG8_BAR; PG8_SCHED;
            PG8_LDB(B1, 1, 1); PG8_STAGE(PG8_SB(1, 0), b3, voffB);
            PG8_BAR; PG8_WAIT_L(0); PG8_MMA(0, 1, At, B1); PG8_BAR;
            PG8_LDA(At, 1, 1); PG8_STAGE(PG8_SA(1, 0), a3, voffA);
            PG8_BAR; PG8_WAIT_L(0); PG8_MMA(1, 0, At, B0); PG8_BAR; PG8_SCHED;
            PG8_STAGE(PG8_SB(1, 1), b3 + hstep, voffB);
            PG8_WAIT_V(6); PG8_BAR; PG8_MMA(1, 1, At, B1); PG8_BAR;
            }
        }
        if constexpr (ALIGN_EPI) { if (wr == 0) PG8_BAR; }
        if constexpr (!Epi::AFTER_DRAIN) { E(acc, cur, wr, wc, fr, fq); S.done(cur);
#ifdef EPI_DRAIN
        PG8_WAIT_V(0);
#endif
        }
        if (!has_next) break;
#pragma unroll
        for (int a = 0; a < 2; ++a)
#pragma unroll
            for (int b = 0; b < 2; ++b)
#pragma unroll
                for (int m = 0; m < 4; ++m)
#pragma unroll
                    for (int n = 0; n < 2; ++n) acc[a][b][m][n] = (f32x4){0.f, 0.f, 0.f, 0.f};
        cur = nxt; cA = nA; cB = nB; ++ui;
        if constexpr (ALIGN_EPI) { if (wr == 1) PG8_BAR; }
    }
    PG8_WAIT_V(0);
    if constexpr (!ALIGN_EPI) { if (wr == 0) PG8_BAR; }
    PG8_BAR;
    if constexpr (Epi::AFTER_DRAIN) { E.fused(acc, cur, wr, wc, fr, fq, lds, wid, lane); S.done(cur); }
#undef PG8_SA
#undef PG8_SB
#undef PG8_STAGE
#undef PG8_LDA
#undef PG8_LDB
#undef PG8_MMA
#undef PG8_WAIT_V
#undef PG8_WAIT_L
#undef PG8_BAR
#undef PG8_SCHED
}
}
#define LAS __attribute__((address_space(3)))
typedef unsigned short bf16;
typedef unsigned v4u __attribute__((ext_vector_type(4)));
typedef unsigned v2u __attribute__((ext_vector_type(2)));
typedef float F4 __attribute__((ext_vector_type(4)));
typedef float F16 __attribute__((ext_vector_type(16)));
typedef short B8 __attribute__((ext_vector_type(8)));
typedef short S4 __attribute__((ext_vector_type(4)));
typedef LAS unsigned char* lptr;

constexpr int NT = 512, NWAVES = 8;
constexpr int D = 1024, SEQ = 8192, NLAT = 16384, CTXL = 256, R = 16896, FF = 4096;
constexpr int LDS_BYTES = 155648;
constexpr size_t MiB = 1u << 20;
constexpr size_t WS_MV = 0, WS_CST = 512 * 1024, WS_D64 = 576 * 1024, WS_D128 = 640 * 1024, WS_TW = 704 * 1024;
constexpr size_t WS_XS = 4 * MiB, WS_H = 70 * MiB, WS_Y = 103 * MiB;
constexpr size_t WS_SSDIN = 136 * MiB, WS_SSDOUT = WS_SSDIN + 6400ull * 1024 * 2, WS_W1_0 = WS_SSDOUT + 4 * MiB, WS_W2_0 = WS_W1_0 + 8 * MiB;
constexpr size_t WS_WL = WS_W2_0 + 8 * MiB;
#ifdef SWAP_W
constexpr size_t WS_W1L = WS_WL, WS_W2L = WS_W1L + 24 * MiB, WS_SCIN = WS_W2L + 24 * MiB, WS_NAOUT = WS_SCIN + 6 * MiB, WS_QKVW = WS_NAOUT + 2 * MiB;
#define WS_SCIN_END (WS_QKVW + 6 * MiB)
#else
constexpr size_t WS_W1L = WS_WL, WS_W2L = WS_W1L + 24 * MiB, WS_QKVW = WS_W2L + 24 * MiB, WS_NAOUT = WS_QKVW + 6 * MiB, WS_SCIN = WS_NAOUT + 2 * MiB;
#define WS_SCIN_END (WS_SCIN + 6 * MiB)
#endif

    constexpr size_t WS_SCOUT = WS_SCIN_END, WS_FNW = WS_SCOUT + 2 * MiB;
constexpr size_t WS_G = WS_FNW + 2 * MiB;
constexpr size_t WS_ZX = WS_WL;
constexpr size_t WS_DT = WS_G + 132 * MiB;
constexpr size_t WS_END = WS_DT + (size_t)R * 64 * 4;
constexpr size_t WS_YF = WS_XS, WS_YB = WS_H;
static_assert(WS_WL == 168 * MiB + MiB / 2 && WS_G == 234 * MiB + MiB / 2, "map");
static_assert(WS_ZX + (size_t)R * 6144 * 2 == WS_DT, "ZX fills later-weights + G");
static_assert(WS_H + (size_t)R * D * 2 == WS_Y && WS_Y + (size_t)R * D * 2 == WS_SSDIN && WS_XS + (size_t)R * D * 4 == WS_H, "map2");

struct Args { const float* in[24]; float* out; unsigned char* ws; };

__device__ __forceinline__ unsigned pk2(float lo, float hi) { return pg8::cvt_pk_bf16(lo, hi); }
__device__ __forceinline__ float bflo(unsigned w) { return __builtin_bit_cast(float, w << 16); }
__device__ __forceinline__ float bfhi(unsigned w) { return __builtin_bit_cast(float, w & 0xffff0000u); }
__device__ __forceinline__ float bf2f(unsigned short b) { return __builtin_bit_cast(float, (unsigned)b << 16); }
__device__ __forceinline__ unsigned short f2bf(float f) { return (unsigned short)(pk2(f, 0.f) & 0xffffu); }
__device__ __forceinline__ float wave_sum(float v) {
#pragma unroll
    for (int o = 1; o < 64; o <<= 1) v += __shfl_xor(v, o);
    return v;
}
__device__ __forceinline__ float silu_f(float v) { return v / (1.f + __expf(-v)); }
__device__ __forceinline__ int rowmap(int reg, int hf) { return (reg & 3) + 8 * (reg >> 2) + 4 * hf; }
#define LDS_WAIT() asm volatile("s_waitcnt lgkmcnt(0)" ::: "memory")

template <int KS> __device__ __forceinline__ void mma_lds(F16& acc, lptr A, int sa, lptr B, int sb, int lane) {
    const int r = lane & 31, h = lane >> 5;
    lptr pa = A + r * sa + h * 16; lptr pb = B + r * sb + h * 16;
#pragma unroll
    for (int s = 0; s < KS; ++s) { const B8 a = *(const LAS B8*)(pa + s * 32); const B8 b = *(const LAS B8*)(pb + s * 32); acc = __builtin_amdgcn_mfma_f32_32x32x16_bf16(a, b, acc, 0, 0, 0); }
}
template <int KS> __device__ __forceinline__ void mma_gA(F16& acc, const bf16* A, int lda, lptr B, int sb, int lane) {
    const int r = lane & 31, h = lane >> 5;
    const bf16* pa = A + (size_t)r * lda + h * 8; lptr pb = B + r * sb + h * 16;
#pragma unroll
    for (int s = 0; s < KS; ++s) { const B8 a = *(const B8*)(pa + s * 16); const B8 b = *(const LAS B8*)(pb + s * 32); acc = __builtin_amdgcn_mfma_f32_32x32x16_bf16(a, b, acc, 0, 0, 0); }
}

__device__ __forceinline__ void transpose_item(const float* W, int K, int N, bf16* WT, LAS float* scr, int item, int lane) {
    const int nblk = N / 32, kb = item / nblk, nb = item % nblk, k0 = 64 * kb, n0 = 32 * nb;
#pragma unroll 8
    for (int i = 0; i < 32; ++i) { const int kk = 2 * i + (lane >> 5); scr[kk * 33 + (lane & 31)] = W[(size_t)(k0 + kk) * N + n0 + (lane & 31)]; }
    LDS_WAIT(); asm volatile("" ::: "memory");
    const int c = lane & 7;
#pragma unroll
    for (int j = 0; j < 4; ++j) { const int n = (lane >> 3) + 8 * j; const LAS float* s = scr + (8 * c) * 33 + n;
        v4u o; o.x = pk2(s[0 * 33], s[1 * 33]); o.y = pk2(s[2 * 33], s[3 * 33]); o.z = pk2(s[4 * 33], s[5 * 33]); o.w = pk2(s[6 * 33], s[7 * 33]);
        *(v4u*)(WT + (size_t)(n0 + n) * K + k0 + 8 * c) = o; }
    LDS_WAIT(); asm volatile("" ::: "memory");
}
#define TJOB(W_, K_, N_, WT_) { const int ni_ = ((K_) / 64) * ((N_) / 32); if (r < ni_) { transpose_item((W_), (K_), (N_), (WT_), scr, r, lane); continue; } r -= ni_; }

struct RowArgs { const float* tA; const float* tB; const bf16* Y; const float* gate; const float* gY; float* oA; float* oB; bf16* H; const float* gH; const float* shift; const float* scale; int nrows; };
__device__ __forceinline__ void rowpass(const RowArgs& a, int gw, int NGW, int lane) {
    for (int row = gw; row < a.nrows; row += NGW) {
        const int set = row < SEQ ? 0 : (row < NLAT ? 1 : 2);
        const float* tp = row < NLAT ? a.tA + (size_t)row * D : a.tB + (size_t)(row - NLAT) * D;
        F4 t[4];
#pragma unroll
        for (int j = 0; j < 4; ++j) t[j] = ((const F4*)tp)[lane + 64 * j];
        if (a.Y) {
            F4 y[4]; float ss = 0.f;
#pragma unroll
            for (int j = 0; j < 4; ++j) { const v2u w = ((const v2u*)(a.Y + (size_t)row * D))[lane + 64 * j]; y[j] = (F4){bflo(w.x), bfhi(w.x), bflo(w.y), bfhi(w.y)};
                ss += (y[j].x * y[j].x + y[j].y * y[j].y) + (y[j].z * y[j].z + y[j].w * y[j].w); }
            const float rstd = rsqrtf(wave_sum(ss) * (1.f / D) + 1e-6f);
#pragma unroll
            for (int j = 0; j < 4; ++j) { const F4 g4 = ((const F4*)(a.gate + set * 6144))[lane + 64 * j]; const F4 gy = ((const F4*)a.gY)[lane + 64 * j]; t[j] = t[j] + g4 * ((y[j] * rstd) * gy); }
        }
        if (a.oA) { float* op = row < NLAT ? a.oA + (size_t)row * D : a.oB + (size_t)(row - NLAT) * D;
#pragma unroll
            for (int j = 0; j < 4; ++j) ((F4*)op)[lane + 64 * j] = t[j]; }
        if (a.H) {
            float ss = 0.f;
#pragma unroll
            for (int j = 0; j < 4; ++j) ss += (t[j].x * t[j].x + t[j].y * t[j].y) + (t[j].z * t[j].z + t[j].w * t[j].w);
            const float rstd = rsqrtf(wave_sum(ss) * (1.f / D) + 1e-6f);
#pragma unroll
            for (int j = 0; j < 4; ++j) { const F4 g = ((const F4*)a.gH)[lane + 64 * j]; const F4 sh = ((const F4*)(a.shift + set * 6144))[lane + 64 * j]; const F4 sc = ((const F4*)(a.scale + set * 6144))[lane + 64 * j];
                const F4 hv = ((t[j] * rstd) * g) * (sc + 1.f) + sh; v2u w; w.x = pk2(hv.x, hv.y); w.y = pk2(hv.z, hv.w);
                ((v2u*)(a.H + (size_t)row * D))[lane + 64 * j] = w; }
        }
    }
}

__device__ __forceinline__ void p0_prologue(const Args& A, lptr lds, int tid, int lane, int wave) {
    unsigned char* ws = A.ws;
    LAS float* cv = (LAS float*)(lds + 131072);
    LAS float* red = (LAS float*)(lds + 131072 + 12288);
    for (int i = tid; i < 3 * D; i += NT) { const float v = i < 2 * D ? A.in[1][i] : A.in[3][i - 2 * D]; cv[i] = silu_f(v); }
    __syncthreads();
    float* MV = (float*)(ws + WS_MV);
    for (int it = blockIdx.x; it < 4 * 96; it += gridDim.x) {
        const int layer = it / 96, n0 = (it % 96) * 64, col = tid & 63;
        const float* w = A.in[4] + (size_t)layer * D * 6144 + n0 + col;
        float a0 = 0.f, a1 = 0.f, a2 = 0.f;
#pragma unroll 8
        for (int i = 0; i < 128; ++i) { const int k = wave + 8 * i; const float wv = w[(size_t)k * 6144]; a0 += cv[k] * wv; a1 += cv[D + k] * wv; a2 += cv[2 * D + k] * wv; }
        red[(wave * 3 + 0) * 64 + col] = a0; red[(wave * 3 + 1) * 64 + col] = a1; red[(wave * 3 + 2) * 64 + col] = a2;
        __syncthreads();
        if (tid < 192) { const int s = tid >> 6, c = tid & 63; float v = A.in[5][layer * 6144 + n0 + c];
#pragma unroll
            for (int w8 = 0; w8 < 8; ++w8) v += red[(w8 * 3 + s) * 64 + c];
            MV[((size_t)layer * 3 + s) * 6144 + n0 + c] = v; }
        __syncthreads();
    }
    const int gt = blockIdx.x * NT + tid, NGT = gridDim.x * NT;
    const float TWO_PI = 6.283185307179586f;
    {
        bf16* CST = (bf16*)(ws + WS_CST); bf16* D64 = (bf16*)(ws + WS_D64); bf16* D128 = (bf16*)(ws + WS_D128); float* TW = (float*)(ws + WS_TW);
        for (int i = gt; i < 256 * 128; i += NGT) { const int rr = i >> 7, n = i & 127, m = rr & 127; const float ang = TWO_PI * (float)((m * n) & 127) * (1.f / 128.f);
            CST[i] = f2bf(rr < 128 ? cosf(ang) : -sinf(ang)); }
        for (int i = gt; i < 128 * 128; i += NGT) { const int rr = i >> 7, cc = i & 127, k1 = rr & 63, t1 = cc & 63, co = rr >> 6, ci = cc >> 6; const float ang = TWO_PI * (float)((k1 * t1) & 63) * (1.f / 64.f);
            const float cs = cosf(ang), sn = sinf(ang); D64[i] = f2bf(co == ci ? cs : (co == 0 ? sn : -sn)); }
        for (int i = gt; i < 128 * 256; i += NGT) { const int k2 = i >> 8, cc = i & 255, t2 = cc & 127, ci = cc >> 7; const float ang = TWO_PI * (float)((k2 * t2) & 127) * (1.f / 128.f);
            D128[i] = f2bf(ci == 0 ? cosf(ang) : sinf(ang)); }
        for (int i = gt; i < 64 * 128; i += NGT) { const int k1 = i >> 7, t2 = i & 127; const float ang = TWO_PI * (float)(k1 * t2) * (1.f / 8192.f); TW[2 * i] = cosf(ang); TW[2 * i + 1] = sinf(ang); }
    }
    {
        v4u* z = (v4u*)(ws + WS_SSDIN + (size_t)6208 * 1024 * 2); const v4u zero = {0u, 0u, 0u, 0u};
        for (int i = gt; i < 192 * 1024 * 2 / 16; i += NGT) z[i] = zero;
    }
    LAS float* scr = (LAS float*)(lds + wave * 16384);
    const int gw = blockIdx.x * NWAVES + wave, NGW = gridDim.x * NWAVES;
    constexpr int NIT0 = 16 * 194 + 32 * 32 + 16 * 128 + 64 * 32;
    for (int it = gw; it < NIT0; it += NGW) {
        int r = it;
        TJOB(A.in[9], 1024, 6208, (bf16*)(ws + WS_SSDIN))
        TJOB(A.in[16], 2048, 1024, (bf16*)(ws + WS_SSDOUT))
        TJOB(A.in[7], 1024, 4096, (bf16*)(ws + WS_W1_0))
        TJOB(A.in[8], 4096, 1024, (bf16*)(ws + WS_W2_0))
    }
}
__device__ __forceinline__ void late_weights(const Args& A, lptr lds, int lane, int wave) {
    unsigned char* ws = A.ws;
    LAS float* scr = (LAS float*)(lds + wave * 16384);
    const int gw = blockIdx.x * NWAVES + wave, NGW = gridDim.x * NWAVES;
    constexpr int NIT = 6 * 2048 + 1536 + 512 + 1536 + 512 + 512;
    for (int it = gw; it < NIT; it += NGW) {
        int r = it;
        TJOB(A.in[7] + (size_t)1 * D * FF, 1024, 4096, (bf16*)(ws + WS_W1L))
        TJOB(A.in[7] + (size_t)2 * D * FF, 1024, 4096, (bf16*)(ws + WS_W1L + 8 * MiB))
        TJOB(A.in[7] + (size_t)3 * D * FF, 1024, 4096, (bf16*)(ws + WS_W1L + 16 * MiB))
        TJOB(A.in[8] + (size_t)1 * D * FF, 4096, 1024, (bf16*)(ws + WS_W2L))
        TJOB(A.in[8] + (size_t)2 * D * FF, 4096, 1024, (bf16*)(ws + WS_W2L + 8 * MiB))
        TJOB(A.in[8] + (size_t)3 * D * FF, 4096, 1024, (bf16*)(ws + WS_W2L + 16 * MiB))
        TJOB(A.in[17], 1024, 3072, (bf16*)(ws + WS_QKVW))
        TJOB(A.in[19], 1024, 1024, (bf16*)(ws + WS_NAOUT))
        TJOB(A.in[20], 1024, 3072, (bf16*)(ws + WS_SCIN))
        TJOB(A.in[22], 1024, 1024, (bf16*)(ws + WS_SCOUT))
        TJOB(A.in[23], 1024, 1024, (bf16*)(ws + WS_FNW))
    }
}
__device__ __forceinline__ void conv8(const bf16* zx, size_t rowc, bool hasPrev, bool hasNext, int col, const LAS float* w, int W, int c0, float (&o)[8]) {
    const v4u zero = {0u, 0u, 0u, 0u};
    const v4u vc = *(const v4u*)(zx + rowc * 6144 + col);
    const v4u vp = hasPrev ? *(const v4u*)(zx + (rowc - 1) * 6144 + col) : zero;
    const v4u vn = hasNext ? *(const v4u*)(zx + (rowc + 1) * 6144 + col) : zero;
    const unsigned pc[4] = {vc.x, vc.y, vc.z, vc.w}, pp[4] = {vp.x, vp.y, vp.z, vp.w}, pn[4] = {vn.x, vn.y, vn.z, vn.w};
#pragma unroll
    for (int e = 0; e < 8; ++e) {
        const float xc = (e & 1) ? bfhi(pc[e >> 1]) : bflo(pc[e >> 1]), xp = (e & 1) ? bfhi(pp[e >> 1]) : bflo(pp[e >> 1]), xn = (e & 1) ? bfhi(pn[e >> 1]) : bflo(pn[e >> 1]);
        const float v = w[0 * W + c0 + e] * xp + w[1 * W + c0 + e] * xc + w[2 * W + c0 + e] * xn + w[3 * W + c0 + e];
        o[e] = silu_f(v);
    }
}
template <int DUMMY> __device__ __forceinline__ void mma_lds_rt(F16& acc, lptr A, int sa, lptr B, int sb, int lane, int ks) {
    const int r = lane & 31, h = lane >> 5;
    lptr pa = A + r * sa + h * 16; lptr pb = B + r * sb + h * 16;
#pragma unroll 2
    for (int s = 0; s < ks; ++s) { const B8 a = *(const LAS B8*)(pa + s * 32); const B8 b = *(const LAS B8*)(pb + s * 32); acc = __builtin_amdgcn_mfma_f32_32x32x16_bf16(a, b, acc, 0, 0, 0); }
}

__device__ __forceinline__ void ssd_scan_phase(const Args& A, lptr lds, int tid, int lane, int wave) {
    unsigned char* ws = A.ws;
    const bf16* ZX = (const bf16*)(ws + WS_ZX); const float* DT = (const float*)(ws + WS_DT);
    constexpr int SR = 272;
    lptr Cm = lds, Bm = lds + 34816, BTw = lds + 69632, XT = lds + 104448, St = lds + 121856;
    LAS float* cumL = (LAS float*)(lds + 139264); LAS float* dtL = cumL + 128; LAS float* wendL = cumL + 256; LAS float* ecumL = cumL + 384;
    LAS float* wX = (LAS float*)(lds + 141312); LAS float* wB = wX + 256; LAS float* wC = wB + 512;
    const int hf = lane >> 5, l31 = lane & 31;
    for (int unit = blockIdx.x; unit < 128; unit += gridDim.x) {
        const int b = unit >> 6, d = (unit >> 5) & 1, h = unit & 31, g = h >> 3;
        const int chX = h * 64, chB = 2048 + ((d * 2 + 0) * 4 + g) * 128, chC = 2048 + ((d * 2 + 1) * 4 + g) * 128;
        const float a_neg = -__expf(A.in[13][d * 32 + h]);
        const float Dtot = A.in[14][h] + A.in[14][32 + h];
        bf16* Yout = (bf16*)(ws + (d ? WS_YB : WS_YF));
        __syncthreads();
        for (int i = tid; i < 1280; i += NT) {
            int k, ch;
            if (i < 256) { k = i >> 6; ch = chX + (i & 63); } else if (i < 768) { k = (i - 256) >> 7; ch = chB + ((i - 256) & 127); } else { k = (i - 768) >> 7; ch = chC + ((i - 768) & 127); }
            wX[i] = k < 3 ? A.in[10][k * 4096 + ch] : A.in[11][ch];
        }
        for (int i = tid; i < 64 * SR / 4; i += NT) ((LAS unsigned*)St)[i] = 0u;
        F16 acc_st;
#pragma unroll
        for (int e = 0; e < 16; ++e) acc_st[e] = 0.f;
        __syncthreads();
        for (int ph = 0; ph < 2; ++ph) {
            const int nch = ph ? 64 : 2, rowbase = ph ? b * SEQ : NLAT + b * CTXL, seqlen = ph ? SEQ : CTXL;
            for (int ci = 0; ci < nch; ++ci) {
                const int c = d ? nch - 1 - ci : ci, t0 = c * 128;
                if (wave == 0) {
                    const int tA = d ? t0 + 127 - lane : t0 + lane, tB = d ? t0 + 63 - lane : t0 + 64 + lane;
                    const float dt0 = DT[(size_t)(rowbase + tA) * 64 + d * 32 + h], dt1 = DT[(size_t)(rowbase + tB) * 64 + d * 32 + h];
                    float v0 = dt0 * a_neg, v1 = dt1 * a_neg;
#pragma unroll
                    for (int o = 1; o < 64; o <<= 1) { const float u0 = __shfl_up(v0, o), u1 = __shfl_up(v1, o); if (lane >= o) { v0 += u0; v1 += u1; } }
                    v1 += __shfl(v0, 63);
                    const float cend = __shfl(v1, 63);
                    cumL[lane] = v0; cumL[lane + 64] = v1; dtL[lane] = dt0; dtL[lane + 64] = dt1;
                    wendL[lane] = __expf(cend - v0) * dt0; wendL[lane + 64] = __expf(cend - v1) * dt1;
                    ecumL[lane] = __expf(v0); ecumL[lane + 64] = __expf(v1);
                }
                __syncthreads();
#pragma unroll 1
                for (int k = 0; k < 2; ++k) { const int it = tid + NT * k, j = it >> 3, cg = it & 7; const int t = d ? t0 + 127 - j : t0 + j;
                    float o[8]; conv8(ZX, (size_t)(rowbase + t), t > 0, t < seqlen - 1, 2048 + chX + 8 * cg, wX, 64, 8 * cg, o);
#pragma unroll
                    for (int e = 0; e < 8; ++e) *(LAS bf16*)(XT + (8 * cg + e) * SR + j * 2) = f2bf(o[e]); }
#pragma unroll 1
                for (int k = 0; k < 4; ++k) { const int it = tid + NT * k, j = it >> 4, cg = it & 15; const int t = d ? t0 + 127 - j : t0 + j;
                    float o[8]; conv8(ZX, (size_t)(rowbase + t), t > 0, t < seqlen - 1, 2048 + chB + 8 * cg, wB, 128, 8 * cg, o);
                    v4u w; w.x = pk2(o[0], o[1]); w.y = pk2(o[2], o[3]); w.z = pk2(o[4], o[5]); w.w = pk2(o[6], o[7]);
                    *(LAS v4u*)(Bm + j * SR + cg * 16) = w;
                    const float we = wendL[j];
#pragma unroll
                    for (int e = 0; e < 8; ++e) *(LAS bf16*)(BTw + (8 * cg + e) * SR + j * 2) = f2bf(o[e] * we); }
#pragma unroll 1
                for (int k = 0; k < 4; ++k) { const int it = tid + NT * k, j = it >> 4, cg = it & 15; const int t = d ? t0 + 127 - j : t0 + j;
                    float o[8]; conv8(ZX, (size_t)(rowbase + t), t > 0, t < seqlen - 1, 2048 + chC + 8 * cg, wC, 128, 8 * cg, o);
                    v4u w; w.x = pk2(o[0], o[1]); w.y = pk2(o[2], o[3]); w.z = pk2(o[4], o[5]); w.w = pk2(o[6], o[7]);
                    *(LAS v4u*)(Cm + j * SR + cg * 16) = w; }
                __syncthreads();
                F16 cb0, cb1, acc2;
#pragma unroll
                for (int e = 0; e < 16; ++e) { cb0[e] = 0.f; cb1[e] = 0.f; acc2[e] = 0.f; }
                const int ti0 = (2 * wave) >> 2, tj0 = (2 * wave) & 3, tj1 = tj0 + 1;
                if (tj0 <= ti0) mma_lds<8>(cb0, Cm + ti0 * 32 * SR, SR, Bm + tj0 * 32 * SR, SR, lane);
                if (tj1 <= ti0) mma_lds<8>(cb1, Cm + ti0 * 32 * SR, SR, Bm + tj1 * 32 * SR, SR, lane);
                const int ti2 = wave >> 1, tp = wave & 1;
                mma_lds<8>(acc2, Cm + ti2 * 32 * SR, SR, St + tp * 32 * SR, SR, lane);
                __syncthreads();
                if (tj0 <= ti0) {
#pragma unroll
                    for (int e = 0; e < 16; ++e) { const int i = ti0 * 32 + rowmap(e, hf), j = tj0 * 32 + l31;
                        const float v = (j <= i) ? cb0[e] * __expf(cumL[i] - cumL[j]) * dtL[j] : 0.f; *(LAS bf16*)(Bm + i * SR + j * 2) = f2bf(v); } }
                if (tj1 <= ti0) {
#pragma unroll
                    for (int e = 0; e < 16; ++e) { const int i = ti0 * 32 + rowmap(e, hf), j = tj1 * 32 + l31;
                        const float v = (j <= i) ? cb1[e] * __expf(cumL[i] - cumL[j]) * dtL[j] : 0.f; *(LAS bf16*)(Bm + i * SR + j * 2) = f2bf(v); } }
                __syncthreads();
                F16 acc1;
#pragma unroll
                for (int e = 0; e < 16; ++e) acc1[e] = 0.f;
                mma_lds_rt<0>(acc1, Bm + ti2 * 32 * SR, SR, XT + tp * 32 * SR, SR, lane, 2 * (ti2 + 1));
#pragma unroll
                for (int e = 0; e < 16; ++e) { const int i = ti2 * 32 + rowmap(e, hf), p = tp * 32 + l31; const int t = d ? t0 + 127 - i : t0 + i; const size_t row = (size_t)(rowbase + t);
                    float y = acc1[e] + ecumL[i] * acc2[e];
                    if (d == 0) y += Dtot * bf2f(*(const LAS bf16*)(XT + p * SR + i * 2));
                    const float z = bf2f(ZX[row * 6144 + h * 64 + p]);
                    Yout[row * 2048 + h * 64 + p] = f2bf(y * silu_f(z)); }
                const int tps = wave >> 2, tn = wave & 3; const float decay = __expf(cumL[127]);
#pragma unroll
                for (int e = 0; e < 16; ++e) acc_st[e] *= decay;
                mma_lds<8>(acc_st, XT + tps * 32 * SR, SR, BTw + tn * 32 * SR, SR, lane);
#pragma unroll
                for (int e = 0; e < 16; ++e) { const int p = tps * 32 + rowmap(e, hf), n = tn * 32 + l31; *(LAS bf16*)(St + p * SR + n * 2) = f2bf(acc_st[e]); }
                __syncthreads();
            }
        }
    }
}

__device__ __forceinline__ void ssd_combine(const Args& A, int gw, int NGW, int lane) {
    unsigned char* ws = A.ws;
    const bf16* YF = (const bf16*)(ws + WS_YF); const bf16* YB = (const bf16*)(ws + WS_YB); bf16* YN = (bf16*)(ws + WS_G);
    for (int row = gw; row < R; row += NGW) {
        F4 s[8]; float ss = 0.f;
#pragma unroll
        for (int j = 0; j < 8; ++j) { const v2u f = ((const v2u*)(YF + (size_t)row * 2048))[lane + 64 * j], bk = ((const v2u*)(YB + (size_t)row * 2048))[lane + 64 * j];
            s[j] = (F4){bflo(f.x) + bflo(bk.x), bfhi(f.x) + bfhi(bk.x), bflo(f.y) + bflo(bk.y), bfhi(f.y) + bfhi(bk.y)};
            ss += (s[j].x * s[j].x + s[j].y * s[j].y) + (s[j].z * s[j].z + s[j].w * s[j].w); }
        const float rstd = rsqrtf(wave_sum(ss) * (1.f / 2048.f) + 1e-6f);
#pragma unroll
        for (int j = 0; j < 8; ++j) { const F4 g = ((const F4*)A.in[15])[lane + 64 * j]; const F4 o = (s[j] * rstd) * g; v2u w; w.x = pk2(o.x, o.y); w.y = pk2(o.z, o.w);
            ((v2u*)(YN + (size_t)row * 2048))[lane + 64 * j] = w; }
    }
}

__device__ __forceinline__ void na_phase(const Args& A, lptr lds, int tid, int lane, int wave) {
    unsigned char* ws = A.ws;
    const bf16* QKV = (const bf16*)(ws + WS_G); bf16* O = (bf16*)(ws + WS_H);
    constexpr int KSR = 528, VSR = 144;
    lptr Kt = lds; lptr VT = lds + 64 * KSR; LAS float* rp = (LAS float*)(lds + 64 * KSR + 256 * VSR);
    const int hf = lane >> 5, l31 = lane & 31, hl = wave >> 1, qh = wave & 1;
    for (int unit = blockIdx.x; unit < 1024; unit += gridDim.x) {
        const int b = unit >> 9, r = (unit >> 2) & 127, hq = unit & 3;
        const int r0 = min(max(r - 4, 0), 120), hh = 4 * hq + hl;
        __syncthreads();
        for (int i = tid; i < 4 * 465; i += NT) rp[i] = A.in[18][(4 * hq) * 465 + i];
        const size_t qrow = (size_t)b * SEQ + r * 64 + 32 * qh + l31;
        B8 qf[4];
#pragma unroll
        for (int s = 0; s < 4; ++s) qf[s] = *(const B8*)(QKV + qrow * 3072 + hh * 64 + 16 * s + 8 * hf);
        const int qc = 32 * qh + l31, c0 = min(max(qc - 8, 0), 48);
        float m = -1e30f, l = 0.f; F16 o0, o1;
#pragma unroll
        for (int e = 0; e < 16; ++e) { o0[e] = 0.f; o1[e] = 0.f; }
        for (int it = 0; it < 12; ++it) {
            __syncthreads();
            const size_t keybase = it < 8 ? (size_t)b * SEQ + (r0 + it) * 64 : (size_t)NLAT + b * CTXL + (it - 8) * 64;
#pragma unroll
            for (int k = 0; k < 4; ++k) { const int pc = tid + NT * k, key = pc >> 5, c8 = pc & 31;
                const bf16* src = QKV + (keybase + key) * 3072 + 1024 + hq * 256 + 8 * c8;
                const v4u kv = *(const v4u*)src; const v4u vv = *(const v4u*)(src + 1024);
                *(LAS v4u*)(Kt + key * KSR + c8 * 16) = kv;
                const unsigned pv[4] = {vv.x, vv.y, vv.z, vv.w};
#pragma unroll
                for (int e = 0; e < 8; ++e) *(LAS bf16*)(VT + (8 * c8 + e) * VSR + key * 2) = (bf16)((e & 1) ? (pv[e >> 1] >> 16) : (pv[e >> 1] & 0xffffu)); }
            __syncthreads();
            F16 s0, s1;
#pragma unroll
            for (int e = 0; e < 16; ++e) { s0[e] = 0.f; s1[e] = 0.f; }
#pragma unroll
            for (int s = 0; s < 4; ++s) { const B8 a0 = *(const LAS B8*)(Kt + l31 * KSR + hl * 128 + s * 32 + hf * 16); const B8 a1 = *(const LAS B8*)(Kt + (32 + l31) * KSR + hl * 128 + s * 32 + hf * 16);
                s0 = __builtin_amdgcn_mfma_f32_32x32x16_bf16(a0, qf[s], s0, 0, 0, 0); s1 = __builtin_amdgcn_mfma_f32_32x32x16_bf16(a1, qf[s], s1, 0, 0, 0); }
            if (it < 8) {
                const LAS float* rph = rp + hl * 465 + (r0 + it - r + 7) * 31 + 15 - qc;
#pragma unroll
                for (int e = 0; e < 16; ++e) { const int k0 = rowmap(e, hf), k1 = k0 + 32;
                    s0[e] = (k0 >= c0 && k0 < c0 + 16) ? s0[e] * 0.125f + rph[k0] : -1e30f;
                    s1[e] = (k1 >= c0 && k1 < c0 + 16) ? s1[e] * 0.125f + rph[k1] : -1e30f; }
            } else {
#pragma unroll
                for (int e = 0; e < 16; ++e) { s0[e] *= 0.125f; s1[e] *= 0.125f; }
            }
            float mx = -1e30f;
#pragma unroll
            for (int e = 0; e < 16; ++e) mx = fmaxf(mx, fmaxf(s0[e], s1[e]));
            mx = fmaxf(mx, __shfl_xor(mx, 32));
            const float mn = fmaxf(m, mx), alpha = __expf(m - mn); m = mn;
            float ls = 0.f;
#pragma unroll
            for (int e = 0; e < 16; ++e) { s0[e] = __expf(s0[e] - mn); s1[e] = __expf(s1[e] - mn); ls += s0[e] + s1[e]; o0[e] *= alpha; o1[e] *= alpha; }
            l = l * alpha + ls;
#pragma unroll
            for (int kt = 0; kt < 2; ++kt)
#pragma unroll
                for (int s = 0; s < 2; ++s) {
                    const F16& pp = kt ? s1 : s0;
                    v4u pw; pw.x = pk2(pp[8 * s + 0], pp[8 * s + 1]); pw.y = pk2(pp[8 * s + 2], pp[8 * s + 3]); pw.z = pk2(pp[8 * s + 4], pp[8 * s + 5]); pw.w = pk2(pp[8 * s + 6], pp[8 * s + 7]);
                    const B8 pb = __builtin_bit_cast(B8, pw);
                    const int koff = (kt * 32 + 16 * s + 4 * hf) * 2;
                    { lptr vr = VT + (hl * 64 + l31) * VSR + koff; const v2u x0 = *(const LAS v2u*)vr, x1 = *(const LAS v2u*)(vr + 16); const v4u aw = {x0.x, x0.y, x1.x, x1.y};
                      o0 = __builtin_amdgcn_mfma_f32_32x32x16_bf16(__builtin_bit_cast(B8, aw), pb, o0, 0, 0, 0); }
                    { lptr vr = VT + (hl * 64 + 32 + l31) * VSR + koff; const v2u x0 = *(const LAS v2u*)vr, x1 = *(const LAS v2u*)(vr + 16); const v4u aw = {x0.x, x0.y, x1.x, x1.y};
                      o1 = __builtin_amdgcn_mfma_f32_32x32x16_bf16(__builtin_bit_cast(B8, aw), pb, o1, 0, 0, 0); }
                }
        }
        const float inv = 1.f / (l + __shfl_xor(l, 32));
        bf16* op = O + qrow * D + hh * 64;
#pragma unroll
        for (int gq = 0; gq < 4; ++gq) { const int dd = 8 * gq + 4 * hf;
            v2u w0; w0.x = pk2(o0[4 * gq] * inv, o0[4 * gq + 1] * inv); w0.y = pk2(o0[4 * gq + 2] * inv, o0[4 * gq + 3] * inv); *(v2u*)(op + dd) = w0;
            v2u w1; w1.x = pk2(o1[4 * gq] * inv, o1[4 * gq + 1] * inv); w1.y = pk2(o1[4 * gq + 2] * inv, o1[4 * gq + 3] * inv); *(v2u*)(op + 32 + dd) = w1; }
    }
}

__device__ __forceinline__ void sc_conv_phase(const Args& A, int gt, int NGT) {
    unsigned char* ws = A.ws;
    const bf16* P = (const bf16*)(ws + WS_G); bf16* V = (bf16*)(ws + WS_H); const float* cw = A.in[21];
    for (int it = gt; it < NLAT * 128; it += NGT) {
        const int row = it >> 7, c8 = it & 127, t = row & (SEQ - 1);
        const bf16* pr = P + (size_t)row * 3072 + 8 * c8;
        const v4u zero = {0u, 0u, 0u, 0u};
        const v4u bg = *(const v4u*)pr, cc = *(const v4u*)(pr + 1024), uc = *(const v4u*)(pr + 2048);
#ifdef CONV_NO_NEIGH
        const v4u cp = zero, up = zero, cn = zero, un = zero; (void)t;
#else
        const v4u cp = t > 0 ? *(const v4u*)(pr - 3072 + 1024) : zero, up = t > 0 ? *(const v4u*)(pr - 3072 + 2048) : zero;
        const v4u cn = t < SEQ - 1 ? *(const v4u*)(pr + 3072 + 1024) : zero, un = t < SEQ - 1 ? *(const v4u*)(pr + 3072 + 2048) : zero;
#endif
        const unsigned abg[4] = {bg.x, bg.y, bg.z, bg.w}, acc_[4] = {cc.x, cc.y, cc.z, cc.w}, auc[4] = {uc.x, uc.y, uc.z, uc.w}, acp[4] = {cp.x, cp.y, cp.z, cp.w}, aup[4] = {up.x, up.y, up.z, up.w},
                       acn[4] = {cn.x, cn.y, cn.z, cn.w}, aun[4] = {un.x, un.y, un.z, un.w};
        float o[8];
#pragma unroll
        for (int e = 0; e < 8; ++e) { const int q = e >> 1;
#define SEL(a) ((e & 1) ? bfhi(a[q]) : bflo(a[q]))
            const float v = cw[0 * D + 8 * c8 + e] * (SEL(acp) * SEL(aup)) + cw[1 * D + 8 * c8 + e] * (SEL(acc_) * SEL(auc)) + cw[2 * D + 8 * c8 + e] * (SEL(acn) * SEL(aun));
            o[e] = SEL(abg) * v;
#undef SEL
        }
        v4u w; w.x = pk2(o[0], o[1]); w.y = pk2(o[2], o[3]); w.z = pk2(o[4], o[5]); w.w = pk2(o[6], o[7]);
        *(v4u*)(V + (size_t)row * D + 8 * c8) = w;
    }
}

__device__ __forceinline__ void fn_stage2(const Args& A, lptr lds, int tid, int lane, int wave) {
    unsigned char* ws = A.ws;
    const bf16* Wc = (const bf16*)(ws + WS_G); bf16* U = (bf16*)(ws + WS_G + 64 * MiB); const bf16* D64 = (const bf16*)(ws + WS_D64); const float* TW = (const float*)(ws + WS_TW);
    constexpr int SR = 272;
    lptr Bl = lds; LAS float* twc = (LAS float*)(lds + 128 * SR);
    const int hf = lane >> 5, l31 = lane & 31;
    for (int unit = blockIdx.x; unit < 2048; unit += gridDim.x) {
        const int b = unit >> 10, t2 = (unit >> 3) & 127, g = unit & 7;
        __syncthreads();
#pragma unroll
        for (int k = 0; k < 4; ++k) { const int idx = tid + NT * k, t1 = idx >> 5, pc = idx & 31, comp = pc >> 4, m0 = (pc & 15) * 8;
            const v4u v = *(const v4u*)(Wc + ((size_t)b * SEQ + 128 * t1 + t2) * 2048 + g * 256 + 8 * pc);
            const unsigned pv[4] = {v.x, v.y, v.z, v.w};
#pragma unroll
            for (int e = 0; e < 8; ++e) *(LAS bf16*)(Bl + (m0 + e) * SR + (comp * 64 + t1) * 2) = (bf16)((e & 1) ? (pv[e >> 1] >> 16) : (pv[e >> 1] & 0xffffu)); }
        if (tid < 128) twc[tid] = TW[((tid >> 1) * 128 + t2) * 2 + (tid & 1)];
        __syncthreads();
        const int a = wave >> 2, bt = wave & 3;
        F16 ar, ai;
#pragma unroll
        for (int e = 0; e < 16; ++e) { ar[e] = 0.f; ai[e] = 0.f; }
        mma_gA<8>(ar, D64 + (size_t)(32 * a) * 128, 128, Bl + bt * 32 * SR, SR, lane);
        mma_gA<8>(ai, D64 + (size_t)(64 + 32 * a) * 128, 128, Bl + bt * 32 * SR, SR, lane);
#pragma unroll
        for (int e = 0; e < 16; ++e) { const int k1 = 32 * a + rowmap(e, hf), m = bt * 32 + l31; const float cs = twc[2 * k1], sn = twc[2 * k1 + 1];
            const float ur = ar[e] * cs + ai[e] * sn, ui = ai[e] * cs - ar[e] * sn;
            bf16* dst = U + (((size_t)b * 64 + k1) * 128 + t2) * 2048 + g * 256 + m;
            dst[0] = f2bf(ur); dst[128] = f2bf(ui); }
    }
}
__device__ __forceinline__ void fn_stage3(const Args& A, lptr lds, int tid, int lane, int wave) {
    unsigned char* ws = A.ws;
    const bf16* U = (const bf16*)(ws + WS_G + 64 * MiB); bf16* Fr = (bf16*)(ws + WS_H); const bf16* D128 = (const bf16*)(ws + WS_D128);
    constexpr int SR = 528;
    lptr Bl = lds;
    const int hf = lane >> 5, l31 = lane & 31;
    for (int unit = blockIdx.x; unit < 1024; unit += gridDim.x) {
        const int b = unit >> 9, k1 = (unit >> 3) & 63, g = unit & 7;
        __syncthreads();
#pragma unroll
        for (int k = 0; k < 8; ++k) { const int idx = tid + NT * k, t2 = idx >> 5, pc = idx & 31, comp = pc >> 4, m0 = (pc & 15) * 8;
            const v4u v = *(const v4u*)(U + (((size_t)b * 64 + k1) * 128 + t2) * 2048 + g * 256 + 8 * pc);
            const unsigned pv[4] = {v.x, v.y, v.z, v.w};
#pragma unroll
            for (int e = 0; e < 8; ++e) *(LAS bf16*)(Bl + (m0 + e) * SR + (comp * 128 + t2) * 2) = (bf16)((e & 1) ? (pv[e >> 1] >> 16) : (pv[e >> 1] & 0xffffu)); }
        __syncthreads();
        const int a = wave >> 1, bt0 = (wave & 1) * 2;
        F16 c0, c1;
#pragma unroll
        for (int e = 0; e < 16; ++e) { c0[e] = 0.f; c1[e] = 0.f; }
        mma_gA<16>(c0, D128 + (size_t)(32 * a) * 256, 256, Bl + bt0 * 32 * SR, SR, lane);
        mma_gA<16>(c1, D128 + (size_t)(32 * a) * 256, 256, Bl + (bt0 + 1) * 32 * SR, SR, lane);
#pragma unroll
        for (int e = 0; e < 16; ++e) { const int k2 = 32 * a + rowmap(e, hf); bf16* dst = Fr + ((size_t)b * SEQ + k1 + 64 * k2) * D + g * 128 + bt0 * 32 + l31;
            dst[0] = f2bf(c0[e]); dst[32] = f2bf(c1[e]); }
    }
}

#ifdef PROBE_L
#define PROBE_ONE(q, ptr, n) { const unsigned* rp_ = (ptr); const size_t n_ = (n); unsigned long long s = 0ull; for (size_t i = gt; i < n_; i += NGT) s += (unsigned long long)__hip_atomic_load(rp_ + i, __ATOMIC_RELAXED, __HIP_MEMORY_SCOPE_AGENT) * (unsigned long long)(2 * (i & 1023) + 1); atomicAdd(&SV[q], s); }
#define PROBE_CMP(q) { const unsigned long long cur = __hip_atomic_load(&SV[q], __ATOMIC_RELAXED, __HIP_MEMORY_SCOPE_AGENT); if (valid && cur != SV[8 + q]) fl |= (1ull << q); SV[8 + q] = cur; }
#define PROBE_RUN() { FRESH() \
            unsigned long long* SV = (unsigned long long*)(ws + 372 * MiB); \
            PROBE_ONE(0, PROBE_R0, PROBE_N0) PROBE_ONE(1, PROBE_R1, PROBE_N1) PROBE_ONE(2, PROBE_R2, PROBE_N2) PROBE_ONE(3, PROBE_R3, PROBE_N3) \
            GSYNC(); \
            if (blockIdx.x == 0 && tid == 0) { unsigned long long fl = 0ull; const bool valid = (SV[16] == 0x1234567887654321ull); \
                if (valid) fl = SV[17]; \
                PROBE_CMP(0) PROBE_CMP(1) PROBE_CMP(2) PROBE_CMP(3) \
                SV[16] = 0x1234567887654321ull; SV[17] = fl; } \
            GSYNC(); \
            const float scale = 1.f + 0.1f * (float)__hip_atomic_load(&SV[17], __ATOMIC_RELAXED, __HIP_MEMORY_SCOPE_AGENT); \
            for (int row = gw; row < NLAT; row += NGW) for (int j = 0; j < 16; ++j) A.out[(size_t)row * D + lane + 64 * j] = scale * (float)((row * 1024 + lane + 64 * j) % 977) * 0.01f; \
            return; }
#else
#define PROBE_POS -1
#define PROBE_L -1
#define PROBE_RUN() {}
#endif
__global__ void __launch_bounds__(NT, 2) mega_fwd(Args A) {
    extern __shared__ __attribute__((aligned(16))) unsigned char lds_raw[];
    cg::grid_group grid = cg::this_grid();
#define GSYNC() do { asm volatile("s_waitcnt vmcnt(0) lgkmcnt(0)" ::: "memory"); __builtin_amdgcn_fence(__ATOMIC_RELEASE, "agent"); grid.sync(); __builtin_amdgcn_fence(__ATOMIC_ACQUIRE, "agent"); asm volatile("s_waitcnt vmcnt(0) lgkmcnt(0)" ::: "memory"); __syncthreads(); } while (0)
    lptr lds = (lptr)lds_raw;
    const int G = gridDim.x, NGW = G * NWAVES, NGT = G * NT;
#define FRESH() int tid = threadIdx.x; asm volatile("" : "+v"(tid)); const int lane = tid & 63, wave = __builtin_amdgcn_readfirstlane(tid >> 6); const int gw = blockIdx.x * NWAVES + wave, gt = blockIdx.x * NT + tid; (void)gw; (void)gt; (void)lane;
    unsigned char* ws = A.ws;
    const float* MV = (const float*)(ws + WS_MV);
    float* XS = (float*)(ws + WS_XS); bf16* H = (bf16*)(ws + WS_H); bf16* Y = (bf16*)(ws + WS_Y); bf16* GB = (bf16*)(ws + WS_G);
    const float* norm_g = A.in[6];


#ifndef NO_P0
    { FRESH() p0_prologue(A, lds, tid, lane, wave); }
#ifdef PROBE_L
    if (blockIdx.x == 0 && threadIdx.x < 8) ((unsigned long long*)(ws + 372 * MiB))[threadIdx.x] = 0ull;
#endif
#endif

    GSYNC();
    { FRESH() RowArgs ra{A.in[0], A.in[2], nullptr, nullptr, nullptr, nullptr, nullptr, H, norm_g, MV, MV + 1024, R}; rowpass(ra, gw, NGW, lane); }
    GSYNC();

#pragma unroll 1
#ifndef NLAYERS
#define NLAYERS 4
#endif
    for (int L = 0; L < NLAYERS; ++L) {
        const float* MVL = MV + (size_t)L * 3 * 6144; const float* gL = norm_g + L * 4 * D;
        const int M = (L == 0) ? R : NLAT;
#ifdef SKIPMIX_L
        const bool skipmix = (L == SKIPMIX_L);
#else
        const bool skipmix = false;
#endif
        if (skipmix) {} else
        if (L == 0) {
            pg8::Gemm g{H, (const bf16*)(ws + WS_SSDIN), R, 6400, 1024}; pg8::StaticOrder S; S.init(R, 6400, G, (int)blockIdx.x);
            pg8::EpiSsdIn E{(bf16*)(ws + WS_ZX), (float*)(ws + WS_DT), A.in[12]};

#ifndef NO_GSSD
            pg8::gemm_phase<pg8::EpiSsdIn, pg8::StaticOrder, true, true>(lds, g, S, E);
#endif

        } else {
            pg8::Gemm g; pg8::EpiStore<0> E;
            if (L == 1) { g = pg8::Gemm{H, (const bf16*)(ws + WS_QKVW), R, 3072, 1024}; E = pg8::EpiStore<0>{GB, 3072}; }
            else if (L == 2) { g = pg8::Gemm{H, (const bf16*)(ws + WS_SCIN), NLAT, 3072, 1024}; E = pg8::EpiStore<0>{GB, 3072}; }
            else { g = pg8::Gemm{H, (const bf16*)(ws + WS_CST), NLAT * 8, 256, 128}; E = pg8::EpiStore<0>{GB, 256}; }
            pg8::StaticOrder S; S.init(g.M, g.N, G, (int)blockIdx.x);

#ifndef NO_GIN
            pg8::gemm_phase<pg8::EpiStore<0>, pg8::StaticOrder, true, true>(lds, g, S, E);
#endif

        }
        GSYNC();
#ifdef PROBE_L
        if (PROBE_POS == 0 && L == PROBE_L) PROBE_RUN()
#endif
#ifdef DUMP_P_L
        if (L == DUMP_P_L) { FRESH() const bf16* Pp = (const bf16*)(ws + DUMP_SRC) + DUMP_COL0;
            for (int row = gw; row < NLAT; row += NGW) for (int j = 0; j < 16; ++j) { const size_t ei = (size_t)row * DUMP_LD + lane + 64 * j; const unsigned wv = __hip_atomic_load((const unsigned*)Pp + (ei >> 1), __ATOMIC_RELAXED, __HIP_MEMORY_SCOPE_AGENT);
                A.out[(size_t)row * D + lane + 64 * j] = row < DUMP_ROWS ? ((ei & 1) ? bfhi(wv) : bflo(wv)) : 0.f; }
            return; }
#endif
        const bf16* oA = H; const bf16* oB; int oK = 1024;
        if (L == 0) {

#ifndef NO_SCAN
#ifdef SCAN_DELAY
            for (int q_ = 0; q_ < SCAN_DELAY; ++q_) __builtin_amdgcn_s_sleep(64);
            GSYNC();
#endif
            { FRESH() ssd_scan_phase(A, lds, tid, lane, wave); }
#endif

            GSYNC();
        if (PROBE_POS == 1 && L == PROBE_L) PROBE_RUN()


#ifndef NO_COMB
            { FRESH() ssd_combine(A, gw, NGW, lane);
            late_weights(A, lds, lane, wave); }
#endif

            GSYNC();
        if (PROBE_POS == 2 && L == PROBE_L) PROBE_RUN()

            oA = GB; oB = (const bf16*)(ws + WS_SSDOUT); oK = 2048;
        } else if (L == 1) {

#ifndef NO_NA
            { FRESH() na_phase(A, lds, tid, lane, wave); }
#endif

            GSYNC();
            oB = (const bf16*)(ws + WS_NAOUT);
        } else if (L == 2) {
            if (!skipmix)
#ifndef NO_CONV
            { FRESH() sc_conv_phase(A, gt, NGT); }
#endif

            GSYNC();
            oB = (const bf16*)(ws + WS_SCOUT);
        } else {

#ifndef NO_F2
            { FRESH() fn_stage2(A, lds, tid, lane, wave); }
#endif

            GSYNC();

#ifndef NO_F3
            { FRESH() fn_stage3(A, lds, tid, lane, wave); }
#endif

            GSYNC();
            oB = (const bf16*)(ws + WS_FNW);
        }
        if (!skipmix) { pg8::Gemm g{oA, oB, M, 1024, oK}; pg8::StaticOrder S; S.init(M, 1024, G, (int)blockIdx.x); pg8::EpiStore<0> E{Y, 1024};

#ifndef NO_GOUT
          pg8::gemm_phase<pg8::EpiStore<0>, pg8::StaticOrder, true, true>(lds, g, S, E);
#endif
 }
        GSYNC();
        if (PROBE_POS == 3 && L == PROBE_L) PROBE_RUN()
        { FRESH() RowArgs ra{L == 0 ? A.in[0] : XS, L == 0 ? A.in[2] : XS + (size_t)NLAT * D, Y, MVL + 2 * 1024, gL + 1 * D, XS, XS + (size_t)NLAT * D, H, gL + 2 * D, MVL + 3 * 1024, MVL + 4 * 1024, M};
          rowpass(ra, gw, NGW, lane); }
        GSYNC();
        if (PROBE_POS == 4 && L == PROBE_L) PROBE_RUN()
        { const bf16* w1 = (const bf16*)(ws + (L == 0 ? WS_W1_0 : WS_W1L + (size_t)(L - 1) * 8 * MiB));
          pg8::Gemm g{H, w1, M, FF, 1024}; pg8::StaticOrder S; S.init(M, FF, G, (int)blockIdx.x); pg8::EpiStore<1> E{GB, FF};

#ifndef NO_MLP1
          pg8::gemm_phase<pg8::EpiStore<1>, pg8::StaticOrder, true, true>(lds, g, S, E);
#endif
 }
        GSYNC();
        { const bf16* w2 = (const bf16*)(ws + (L == 0 ? WS_W2_0 : WS_W2L + (size_t)(L - 1) * 8 * MiB));
          pg8::Gemm g{GB, w2, M, 1024, FF}; pg8::StaticOrder S; S.init(M, 1024, G, (int)blockIdx.x); pg8::EpiStore<0> E{Y, 1024};

#ifndef NO_MLP2
          pg8::gemm_phase<pg8::EpiStore<0>, pg8::StaticOrder, true, true>(lds, g, S, E);
#endif
 }
        GSYNC();
        if (PROBE_POS == 6 && L == PROBE_L) PROBE_RUN()
        if (L < 3) {
            const float* MVN = MVL + 3 * 6144; const int Mn = (L == 0) ? R : NLAT;
            FRESH() RowArgs ra{XS, XS + (size_t)NLAT * D, Y, MVL + 5 * 1024, gL + 3 * D, XS, XS + (size_t)NLAT * D, H, gL + 4 * D, MVN, MVN + 1024, Mn};
            rowpass(ra, gw, NGW, lane);
            GSYNC();
        } else {
            FRESH() RowArgs ra{XS, XS, Y, MVL + 5 * 1024, gL + 3 * D, A.out, A.out, nullptr, nullptr, nullptr, nullptr, NLAT};
            rowpass(ra, gw, NGW, lane);
        }
    }
#if NLAYERS < 4
    { FRESH() for (int row = gw; row < NLAT; row += NGW) for (int j = 0; j < 4; ++j) ((F4*)(A.out + (size_t)row * D))[lane + 64 * j] = ((const F4*)(XS + (size_t)row * D))[lane + 64 * j]; }
#endif
}

extern "C" void kernel_launch(void* const* d_in, const int* in_sizes, int n_in, void* d_out, int out_size, void* d_ws, size_t ws_size, hipStream_t stream) {
    static int grid = 0;
    if (grid == 0) {
        if (n_in != 24 || ws_size < WS_END) { fprintf(stderr, "kernel_launch: need 24 inputs and %zu bytes of workspace (got %d, %zu)\n", (size_t)WS_END, n_in, ws_size); grid = -1; return; }
        int dev = 0, cus = 0, per_cu = 0;
        hipGetDevice(&dev); hipDeviceGetAttribute(&cus, hipDeviceAttributeMultiprocessorCount, dev);
        if (hipFuncSetAttribute((const void*)mega_fwd, hipFuncAttributeMaxDynamicSharedMemorySize, LDS_BYTES) != hipSuccess) { fprintf(stderr, "kernel_launch: hipFuncSetAttribute failed\n"); grid = -1; return; }
        if (hipOccupancyMaxActiveBlocksPerMultiprocessor(&per_cu, (const void*)mega_fwd, NT, LDS_BYTES) != hipSuccess || per_cu < 1) { fprintf(stderr, "kernel_launch: occupancy query says %d\n", per_cu); per_cu = 1; }
        (void)hipGetLastError();
        grid = cus;
    }
    if (grid < 0) return;
    Args a{};
    for (int i = 0; i < 24; ++i) a.in[i] = (const float*)d_in[i];
    a.out = (float*)d_out; a.ws = (unsigned char*)d_ws;
    void* args[] = {&a};
    hipError_t e = hipLaunchCooperativeKernel((const void*)mega_fwd, dim3(grid), dim3(NT), args, LDS_BYTES, stream);
    if (e != hipSuccess) fprintf(stderr, "cooperative launch failed: %s (grid %d)\n", hipGetErrorString(e), grid);
}
```

```cpp
#include <hip/hip_runtime.h>
#include <hip/hip_cooperative_groups.h>
#include <cstdio>
#include <cstdint>
namespace cg = cooperative_groups;
namespace pg8 {
#define PG8_LAS __attribute__((address_space(3)))
typedef unsigned short bf16_t;
typedef short bf16x8 __attribute__((ext_vector_type(8)));
typedef float f32x4 __attribute__((ext_vector_type(4)));
typedef unsigned u32x4 __attribute__((ext_vector_type(4)));
constexpr int BM = 256, BK = 64, HALF = 128, HTB = HALF * BK * 2  , STAGE_BYTES = 8 * HTB, NXCD = 8, WGM = 2;

__host__ __device__ __forceinline__ int lds_byte(int r, int c) { const int st = (r >> 4) * 2 + (c >> 5), rr = r & 15, cc = c & 31, ob = rr * 64 + cc * 2; return st * 1024 + (ob ^ (((ob >> 9) & 1) << 5)); }
__host__ __device__ __forceinline__ void stage_rc(int b, int& R, int& C) { const int st = b / 1024, sb = b % 1024, swz = sb ^ (((sb >> 9) & 1) << 5); R = (st >> 1) * 16 + swz / 64; C = (st & 1) * 32 + (swz % 64) / 2; }
__host__ __device__ __forceinline__ int perm32(int rho) { const int n = rho >> 4, i = rho & 15; return 8 * (i >> 2) + 4 * n + (i & 3); }

struct Unit { int pm, pn, ko, ks; };
struct Gemm { const bf16_t* A; const bf16_t* Bt; int M, N, K, ld; };

struct StaticOrder {
    int nM, nN, nwg, G, c, split, kbytes;
    __host__ __device__ void init(int M, int N, int G_, int c_) { nM = M / BM; nN = N / BM; nwg = nM * nN; G = G_; c = c_; split = 0; kbytes = 0; }
    __host__ __device__ bool next(int i, Unit& u) const {
        const long L = (long)i * G + c;
        if (split) { if (L >= 32) return false; const int t = (int)L >> 2; u.ks = (int)L & 3; u.ko = u.ks * kbytes; u.pm = 64 + (t >> 2); u.pn = t & 3; return true; }
        if (L >= nwg) return false;
        u.ko = 0; u.ks = 0;
        int wgid = (int)L; { const int q = nwg / NXCD, r = nwg % NXCD, xcd = wgid % NXCD, off = wgid / NXCD; wgid = (xcd < r ? xcd * (q + 1) : r * (q + 1) + (xcd - r) * q) + off; }
        const int nig = WGM * nN, gid = wgid / nig, fm = gid * WGM, gsz = (nM - fm) < WGM ? (nM - fm) : WGM;
        u.pm = fm + ((wgid % nig) % gsz); u.pn = (wgid % nig) / gsz; return true;
    }
    __device__ __forceinline__ void a_ready(const Unit&) const {}
    __device__ __forceinline__ void done(const Unit&) const {}
};

typedef float f32x2_cv __attribute__((ext_vector_type(2))); typedef __bf16 bf16x2_cv __attribute__((ext_vector_type(2)));
__device__ __forceinline__ unsigned cvt_pk_bf16(float lo, float hi) { const f32x2_cv v = {lo, hi}; const bf16x2_cv b = __builtin_convertvector(v, bf16x2_cv); return __builtin_bit_cast(unsigned, b); }
typedef float f32x2 __attribute__((ext_vector_type(2)));
template <int ACT> struct EpiStore {
    static constexpr bool PERM = true, AFTER_DRAIN = false;
    bf16_t* O; int ldc; size_t kstride; int rowsub;
    __device__ __forceinline__ void operator()(const f32x4 (&acc)[2][2][4][2], const Unit& u, int wr, int wc, int fr, int fq) const {
        bf16_t* O = this->O + (size_t)u.ks * kstride;
        const int row0 = u.pm * BM + wr * 64 + fr - rowsub; const int col0 = u.pn * BM + wc * 32 + 8 * fq;
#pragma unroll
        for (int ai = 0; ai < 2; ++ai)
#pragma unroll
            for (int m = 0; m < 4; ++m) { bf16_t* rowp = O + (size_t)(row0 + ai * HALF + m * 16) * ldc + col0;
#pragma unroll
                for (int bj = 0; bj < 2; ++bj) { f32x4 v0 = acc[ai][bj][m][0], v1 = acc[ai][bj][m][1];
                    if (ACT == 1) {
#pragma unroll
                        for (int e = 0; e < 4; ++e) { float a = v0[e] > 0.f ? v0[e] : 0.f; v0[e] = a * a; float b = v1[e] > 0.f ? v1[e] : 0.f; v1[e] = b * b; } }
                    u32x4 w; w.x = cvt_pk_bf16(v0[0], v0[1]); w.y = cvt_pk_bf16(v0[2], v0[3]); w.z = cvt_pk_bf16(v1[0], v1[1]); w.w = cvt_pk_bf16(v1[2], v1[3]);
                    *(u32x4*)(rowp + bj * HALF) = w; } }
    }
};
struct EpiSsdIn {
    static constexpr bool PERM = true, AFTER_DRAIN = false;
    bf16_t* ZX; float* DT; const float* dt_bias;
    __device__ __forceinline__ void operator()(const f32x4 (&acc)[2][2][4][2], const Unit& u, int wr, int wc, int fr, int fq) const {
        const int row0 = u.pm * BM + wr * 64 + fr;
        if (u.pn < 24) {
            const int col0 = u.pn * BM + wc * 32 + 8 * fq;
#pragma unroll
            for (int ai = 0; ai < 2; ++ai)
#pragma unroll
                for (int m = 0; m < 4; ++m) { bf16_t* rowp = ZX + (size_t)(row0 + ai * HALF + m * 16) * 6144 + col0;
#pragma unroll
                    for (int bj = 0; bj < 2; ++bj) { const f32x4 v0 = acc[ai][bj][m][0], v1 = acc[ai][bj][m][1];
                        u32x4 w; w.x = cvt_pk_bf16(v0[0], v0[1]); w.y = cvt_pk_bf16(v0[2], v0[3]); w.z = cvt_pk_bf16(v1[0], v1[1]); w.w = cvt_pk_bf16(v1[2], v1[3]);
                        *(u32x4*)(rowp + bj * HALF) = w; } }
        } else if (wc < 2) {
            const int col0 = wc * 32 + 8 * fq;
#pragma unroll
            for (int ai = 0; ai < 2; ++ai)
#pragma unroll
                for (int m = 0; m < 4; ++m) { float* rowp = DT + (size_t)(row0 + ai * HALF + m * 16) * 64 + col0;
#pragma unroll
                    for (int n = 0; n < 2; ++n) { f32x4 v = acc[ai][0][m][n]; f32x4 o;
#pragma unroll
                        for (int e = 0; e < 4; ++e) o[e] = v[e];
                        *(f32x4*)(rowp + 4 * n) = o; } }
        }
    }
};

struct RowStat {
    float* slots; unsigned* cnt;
    __device__ __forceinline__ void run(const f32x4 (&v)[2][2][4][2], const Unit& u, int wr, int wc, int fr, int fq, PG8_LAS unsigned char* lds, int tid, int lane) const {
        PG8_LAS float* P = (PG8_LAS float*)lds;
        PG8_LAS float* S = (PG8_LAS float*)(lds + 4096);
#pragma unroll
        for (int ai = 0; ai < 2; ++ai)
#pragma unroll
            for (int m = 0; m < 4; ++m) { float q = 0.f;
#pragma unroll
                for (int bj = 0; bj < 2; ++bj)
#pragma unroll
                    for (int n = 0; n < 2; ++n) { const f32x4 x = v[ai][bj][m][n]; q += (x[0] * x[0] + x[1] * x[1]) + (x[2] * x[2] + x[3] * x[3]); }
                q += __shfl_xor(q, 16); q += __shfl_xor(q, 32);
                if (fq == 0) P[(ai * HALF + wr * 64 + m * 16 + fr) * 4 + wc] = q; }
        asm volatile("s_waitcnt lgkmcnt(0)" ::: "memory"); __builtin_amdgcn_s_barrier(); asm volatile("" ::: "memory");
        if (tid < 256) { const float q = (P[tid * 4 + 0] + P[tid * 4 + 1]) + (P[tid * 4 + 2] + P[tid * 4 + 3]);
            __hip_atomic_store(slots + (size_t)(u.pm * BM + tid) * 4 + u.pn, q, __ATOMIC_RELAXED, __HIP_MEMORY_SCOPE_AGENT);
            asm volatile("s_waitcnt vmcnt(0)" ::: "memory");
            if (lane == 0) __hip_atomic_fetch_add(cnt + 64 * u.pm, 1u, __ATOMIC_RELAXED, __HIP_MEMORY_SCOPE_AGENT); }
        if (tid < 64) { while ((unsigned)__builtin_amdgcn_readfirstlane(__hip_atomic_load(cnt + 64 * u.pm, __ATOMIC_RELAXED, __HIP_MEMORY_SCOPE_AGENT)) < 16u) __builtin_amdgcn_s_sleep(1);
            __builtin_amdgcn_fence(__ATOMIC_ACQUIRE, "agent"); }
        asm volatile("s_waitcnt vmcnt(0) lgkmcnt(0)" ::: "memory"); __builtin_amdgcn_s_barrier(); asm volatile("" ::: "memory");
        if (tid < 256) { const float* sl = slots + (size_t)(u.pm * BM + tid) * 4; float q = 0.f;
#pragma unroll
            for (int t4 = 0; t4 < 4; ++t4) q += __hip_atomic_load(sl + t4, __ATOMIC_RELAXED, __HIP_MEMORY_SCOPE_AGENT);
            S[tid] = rsqrtf(q * (1.f / 1024.f) + 1e-6f); }
        asm volatile("s_waitcnt vmcnt(0) lgkmcnt(0)" ::: "memory"); __builtin_amdgcn_s_barrier(); asm volatile("" ::: "memory");
    }
};
struct EpiRowFuse {
    static constexpr bool PERM = false, AFTER_DRAIN = true;
    bf16_t* XS; float* outF; bf16_t* H;
    const float* gate; const float* gY; const float* gH; const float* shift; const float* scale;
    RowStat st1, st2;
    __device__ __forceinline__ void fused(f32x4 (&acc)[2][2][4][2], const Unit& u, int wr, int wc, int fr, int fq, PG8_LAS unsigned char* lds, int wid, int lane) const {
        const int tid = wid * 64 + lane; const int set = u.pm >= 32 ? 1 : 0;
        const PG8_LAS float* S = (const PG8_LAS float*)(lds + 4096);
        const int col0 = u.pn * BM + wc * 32 + 4 * fq;
        st1.run(acc, u, wr, wc, fr, fq, lds, tid, lane);
        typedef unsigned u32x2v __attribute__((ext_vector_type(2)));
#pragma unroll
        for (int bj = 0; bj < 2; ++bj)
#pragma unroll
            for (int n = 0; n < 2; ++n) { const int c = col0 + bj * HALF + n * 16;
                const f32x4 g4 = *(const f32x4*)(gate + set * 6144 + c), gy = *(const f32x4*)(gY + c);
#pragma unroll
                for (int ai = 0; ai < 2; ++ai)
#pragma unroll
                    for (int m = 0; m < 4; ++m) { const int r = ai * HALF + wr * 64 + m * 16 + fr; const size_t off = (size_t)(u.pm * BM + r) * 1024 + c;
                        const u32x2v w = *(const u32x2v*)(XS + off);
                        f32x4 t; t[0] = __builtin_bit_cast(float, w.x << 16); t[1] = __builtin_bit_cast(float, w.x & 0xffff0000u); t[2] = __builtin_bit_cast(float, w.y << 16); t[3] = __builtin_bit_cast(float, w.y & 0xffff0000u);
                        t = t + g4 * ((acc[ai][bj][m][n] * S[r]) * gy);
                        if (outF) { *(f32x4*)(outF + off) = t; }
                        else { u32x2v o; o.x = cvt_pk_bf16(t[0], t[1]); o.y = cvt_pk_bf16(t[2], t[3]); *(u32x2v*)(XS + off) = o;
                            t[0] = __builtin_bit_cast(float, o.x << 16); t[1] = __builtin_bit_cast(float, o.x & 0xffff0000u); t[2] = __builtin_bit_cast(float, o.y << 16); t[3] = __builtin_bit_cast(float, o.y & 0xffff0000u); }
                        acc[ai][bj][m][n] = t; } }
        if (H) {
            st2.run(acc, u, wr, wc, fr, fq, lds, tid, lane);
#pragma unroll
            for (int bj = 0; bj < 2; ++bj)
#pragma unroll
                for (int n = 0; n < 2; ++n) { const int c = col0 + bj * HALF + n * 16;
                    const f32x4 g = *(const f32x4*)(gH + c), sh = *(const f32x4*)(shift + set * 6144 + c), sc = *(const f32x4*)(scale + set * 6144 + c);
#pragma unroll
                    for (int ai = 0; ai < 2; ++ai)
#pragma unroll
                        for (int m = 0; m < 4; ++m) { const int r = ai * HALF + wr * 64 + m * 16 + fr; const size_t off = (size_t)(u.pm * BM + r) * 1024 + c;
                            const f32x4 hv = ((acc[ai][bj][m][n] * S[r]) * g) * (sc + 1.f) + sh;
                            u32x2v o; o.x = cvt_pk_bf16(hv[0], hv[1]); o.y = cvt_pk_bf16(hv[2], hv[3]); *(u32x2v*)(H + off) = o; } }
        }
    }
};
#ifndef PG8_AUX
#define PG8_AUX 0
#endif

template <class Epi, class Sched, bool ALIGN_EPI = false, bool SP2 = false>
__device__ __forceinline__ void gemm_phase(PG8_LAS unsigned char* lds, const Gemm g, const Sched& S, const Epi& E) {
    int tid_l = threadIdx.x; asm volatile("" : "+v"(tid_l)); const int tid = tid_l, wid = __builtin_amdgcn_readfirstlane(tid >> 6), lane = tid & 63, wr = wid >> 2, wc = wid & 3, fr = lane & 15, fq = lane >> 4;
    const int K = g.K, nt = K / BK, LD = g.ld ? g.ld : g.K;
    unsigned voffA[2], voffB[2];
#pragma unroll
    for (int i = 0; i < 2; ++i) { int R, C; stage_rc(tid * 16 + i * 8192, R, C); const int Rb = Epi::PERM ? ((R & ~31) + perm32(R & 31)) : R;
        voffA[i] = (unsigned)(R * LD + C) * 2u; voffB[i] = (unsigned)(Rb * LD + C) * 2u; }
    const size_t kstep = (size_t)(BK * 2);
    const size_t hstep = (size_t)HALF * LD * 2;
    const size_t tstep = 2 * hstep;
    const unsigned ldsw = (unsigned)wid * 1024u;
    const int aoff = lds_byte(wr * 64 + fr, fq * 8), boff = lds_byte(wc * 32 + fr, fq * 8);
#define PG8_SA(b, h) (((b) * 2 + (h)) * HTB)
#define PG8_SB(b, h) ((4 + (b) * 2 + (h)) * HTB)
#define PG8_STAGE(bufoff, gbase, voff) do { _Pragma("unroll") for (int _i = 0; _i < 2; ++_i) \
        __builtin_amdgcn_global_load_lds((const unsigned*)((const char*)(gbase) + (voff)[_i]), (PG8_LAS unsigned*)(lds + (bufoff) + ldsw + _i * 8192), 16, 0, PG8_AUX); } while (0)
#define PG8_LDA(dst, b, h) do { _Pragma("unroll") for (int m = 0; m < 4; ++m) _Pragma("unroll") for (int k = 0; k < 2; ++k) dst[m][k] = *(const PG8_LAS bf16x8*)(lds + PG8_SA(b, h) + aoff + m * 2048 + k * 1024); } while (0)
#define PG8_LDB(dst, b, h) do { _Pragma("unroll") for (int n = 0; n < 2; ++n) _Pragma("unroll") for (int k = 0; k < 2; ++k) dst[n][k] = *(const PG8_LAS bf16x8*)(lds + PG8_SB(b, h) + boff + n * 2048 + k * 1024); } while (0)
#define PG8_MMA(ai, bj, At, Bt) do { __builtin_amdgcn_s_setprio(1); _Pragma("unroll") for (int m = 0; m < 4; ++m) _Pragma("unroll") for (int n = 0; n < 2; ++n) _Pragma("unroll") for (int k = 0; k < 2; ++k) \
        acc[ai][bj][m][n] = __builtin_amdgcn_mfma_f32_16x16x32_bf16(Bt[n][k], At[m][k], acc[ai][bj][m][n], 0, 0, 0); __builtin_amdgcn_s_setprio(0); } while (0)
#define PG8_WAIT_V(n) asm volatile("s_waitcnt vmcnt(" #n ")" ::: "memory")
#define PG8_WAIT_L(n) asm volatile("s_waitcnt lgkmcnt(" #n ")" ::: "memory")
#define PG8_BAR __builtin_amdgcn_s_barrier()
#define PG8_SCHED __builtin_amdgcn_sched_barrier(0)
    Unit cur, nxt; int ui = 0;
    if (!S.next(0, cur)) return;
    f32x4 acc[2][2][4][2];
#pragma unroll
    for (int a = 0; a < 2; ++a)
#pragma unroll
        for (int b = 0; b < 2; ++b)
#pragma unroll
            for (int m = 0; m < 4; ++m)
#pragma unroll
                for (int n = 0; n < 2; ++n) acc[a][b][m][n] = (f32x4){0.f, 0.f, 0.f, 0.f};
    bf16x8 At[4][2], B0[2][2], B1[2][2];
    const char* cA = (const char*)g.A + (size_t)cur.pm * tstep + cur.ko; const char* cB = (const char*)g.Bt + (size_t)cur.pn * tstep + cur.ko;
    S.a_ready(cur);
    if constexpr (SP2) {
        PG8_STAGE(PG8_SB(0, 0), cB, voffB); PG8_STAGE(PG8_SB(0, 1), cB + hstep, voffB); PG8_STAGE(PG8_SA(0, 0), cA, voffA); PG8_STAGE(PG8_SA(0, 1), cA + hstep, voffA);
        if (wr == 1) PG8_BAR;
        PG8_WAIT_V(2); PG8_BAR;
        PG8_STAGE(PG8_SB(1, 0), cB + kstep, voffB); PG8_STAGE(PG8_SA(1, 0), cA + kstep, voffA); PG8_STAGE(PG8_SB(1, 1), cB + hstep + kstep, voffB);
        PG8_WAIT_V(6); PG8_BAR;
    } else {
        PG8_STAGE(PG8_SB(0, 0), cB, voffB); PG8_STAGE(PG8_SA(0, 0), cA, voffA); PG8_STAGE(PG8_SB(0, 1), cB + hstep, voffB); PG8_STAGE(PG8_SA(0, 1), cA + hstep, voffA);
        if (wr == 1) PG8_BAR;
        PG8_WAIT_V(4); PG8_BAR;
        PG8_STAGE(PG8_SB(1, 0), cB + kstep, voffB); PG8_STAGE(PG8_SA(1, 0), cA + kstep, voffA); PG8_STAGE(PG8_SB(1, 1), cB + hstep + kstep, voffB);
        PG8_WAIT_V(6); PG8_BAR;
    }
    for (;;) {
        const bool has_next = S.next(ui + 1, nxt);
        const char* nA = has_next ? (const char*)g.A + (size_t)nxt.pm * tstep + nxt.ko : cA; const char* nB = has_next ? (const char*)g.Bt + (size_t)nxt.pn * tstep + nxt.ko : cB;
        for (int t = 0; t < nt; t += 2) {
            const bool last = (t == nt - 2);
            const char* a1 = cA + (size_t)(t + 1) * kstep;
            const char* a2 = last ? nA : cA + (size_t)(t + 2) * kstep; const char* b2 = last ? nB : cB + (size_t)(t + 2) * kstep;
            const char* a3 = a2 + kstep; const char* b3 = b2 + kstep;
            if (last && has_next) S.a_ready(nxt);
            if constexpr (SP2) {
            PG8_LDB(B0, 0, 0); PG8_LDB(B1, 0, 1); PG8_SCHED; PG8_LDA(At, 0, 0); PG8_STAGE(PG8_SA(1, 1), a1 + hstep, voffA);
            PG8_WAIT_V(8); PG8_WAIT_L(0); PG8_BAR; PG8_MMA(0, 0, At, B0); PG8_MMA(0, 1, At, B1); PG8_BAR; PG8_SCHED;
            PG8_LDA(At, 0, 1); PG8_STAGE(PG8_SB(0, 0), b2, voffB); PG8_STAGE(PG8_SB(0, 1), b2 + hstep, voffB); PG8_STAGE(PG8_SA(0, 0), a2, voffA);
            PG8_WAIT_V(8); PG8_WAIT_L(0); PG8_BAR; PG8_MMA(1, 0, At, B0); PG8_MMA(1, 1, At, B1); PG8_BAR; PG8_SCHED;
            PG8_LDB(B0, 1, 0); PG8_LDB(B1, 1, 1); PG8_SCHED; PG8_LDA(At, 1, 0); PG8_STAGE(PG8_SA(0, 1), a2 + hstep, voffA);
            PG8_WAIT_V(8); PG8_WAIT_L(0); PG8_BAR; PG8_MMA(0, 0, At, B0); PG8_MMA(0, 1, At, B1); PG8_BAR; PG8_SCHED;
            PG8_LDA(At, 1, 1); PG8_STAGE(PG8_SB(1, 0), b3, voffB); PG8_STAGE(PG8_SB(1, 1), b3 + hstep, voffB); PG8_STAGE(PG8_SA(1, 0), a3, voffA);
            PG8_WAIT_V(8); PG8_WAIT_L(0); PG8_BAR; PG8_MMA(1, 0, At, B0); PG8_MMA(1, 1, At, B1); PG8_BAR; PG8_SCHED;
            } else {
            PG8_LDB(B0, 0, 0); PG8_SCHED; PG8_LDA(At, 0, 0); PG8_STAGE(PG8_SA(1, 1), a1 + hstep, voffA);
            PG8_WAIT_L(8); PG8_BAR; PG8_WAIT_L(0); PG8_MMA(0, 0, At, B0); PG8_BAR; PG8_SCHED;
            PG8_LDB(B1, 0, 1); PG8_STAGE(PG8_SB(0, 0), b2, voffB);
            PG8_BAR; PG8_WAIT_L(0); PG8_MMA(0, 1, At, B1); PG8_BAR;
            PG8_LDA(At, 0, 1); PG8_STAGE(PG8_SA(0, 0), a2, voffA);
            PG8_BAR; PG8_WAIT_L(0); PG8_MMA(1, 0, At, B0); PG8_BAR; PG8_SCHED;
            PG8_STAGE(PG8_SB(0, 1), b2 + hstep, voffB);
            PG8_WAIT_V(6); PG8_BAR; PG8_MMA(1, 1, At, B1); PG8_BAR;
            PG8_LDB(B0, 1, 0); PG8_SCHED; PG8_LDA(At, 1, 0); PG8_STAGE(PG8_SA(0, 1), a2 + hstep, voffA);
            PG8_WAIT_L(8); PG8_BAR; PG8_WAIT_L(0); PG8_MMA(0, 0, At, B0); PG8_BAR; PG8_SCHED;
            PG8_LDB(B1, 1, 1); PG8_STAGE(PG8_SB(1, 0), b3, voffB);
            PG8_BAR; PG8_WAIT_L(0); PG8_MMA(0, 1, At, B1); PG8_BAR;
            PG8_LDA(At, 1, 1); PG8_STAGE(PG8_SA(1, 0), a3, voffA);
            PG8_BAR; PG8_WAIT_L(0); PG8_MMA(1, 0, At, B0); PG8_BAR; PG8_SCHED;
            PG8_STAGE(PG8_SB(1, 1), b3 + hstep, voffB);
            PG8_WAIT_V(6); PG8_BAR; PG8_MMA(1, 1, At, B1); PG8_BAR;
            }
        }
        if constexpr (ALIGN_EPI) { if (wr == 0) PG8_BAR; }
        if constexpr (!Epi::AFTER_DRAIN) { E(acc, cur, wr, wc, fr, fq); S.done(cur);
#ifdef EPI_DRAIN
        PG8_WAIT_V(0);
#endif
        }
        if (!has_next) break;
#pragma unroll
        for (int a = 0; a < 2; ++a)
#pragma unroll
            for (int b = 0; b < 2; ++b)
#pragma unroll
                for (int m = 0; m < 4; ++m)
#pragma unroll
                    for (int n = 0; n < 2; ++n) acc[a][b][m][n] = (f32x4){0.f, 0.f, 0.f, 0.f};
        cur = nxt; cA = nA; cB = nB; ++ui;
        if constexpr (ALIGN_EPI) { if (wr == 1) PG8_BAR; }
    }
    PG8_WAIT_V(0);
    if constexpr (!ALIGN_EPI) { if (wr == 0) PG8_BAR; }
    PG8_BAR;
    if constexpr (Epi::AFTER_DRAIN) { E.fused(acc, cur, wr, wc, fr, fq, lds, wid, lane); S.done(cur); }
#undef PG8_SA
#undef PG8_SB
#undef PG8_STAGE
#undef PG8_LDA
#undef PG8_LDB
#undef PG8_MMA
#undef PG8_WAIT_V
#undef PG8_WAIT_L
#undef PG8_BAR
#undef PG8_SCHED
}
}
#define LAS __attribute__((address_space(3)))
typedef unsigned short bf16;
typedef unsigned v4u __attribute__((ext_vector_type(4)));
typedef unsigned v2u __attribute__((ext_vector_type(2)));
typedef float F4 __attribute__((ext_vector_type(4)));
typedef float F16 __attribute__((ext_vector_type(16)));
typedef short B8 __attribute__((ext_vector_type(8)));
typedef short S4 __attribute__((ext_vector_type(4)));
typedef LAS unsigned char* lptr;

constexpr int NT = 512, NWAVES = 8;
constexpr int D = 1024, SEQ = 8192, NLAT = 16384, CTXL = 256, R = 16896, FF = 4096;
constexpr int LDS_BYTES = 155648;
constexpr size_t MiB = 1u << 20;
constexpr size_t WS_MV = 0, WS_CST = 512 * 1024, WS_D64 = 576 * 1024, WS_D128 = 640 * 1024, WS_TW = 704 * 1024;
constexpr size_t WS_BAR = 1 * MiB;
constexpr size_t WS_XS = 4 * MiB, WS_H = 70 * MiB, WS_Y = 103 * MiB;
constexpr size_t WS_SSDIN = 136 * MiB, WS_SSDOUT = WS_SSDIN + 6400ull * 1024 * 2, WS_W1_0 = WS_SSDOUT + 4 * MiB, WS_W2_0 = WS_W1_0 + 8 * MiB;
constexpr size_t WS_WL = WS_W2_0 + 8 * MiB;
#ifdef SWAP_W
constexpr size_t WS_W1L = WS_WL, WS_W2L = WS_W1L + 24 * MiB, WS_SCIN = WS_W2L + 24 * MiB, WS_NAOUT = WS_SCIN + 6 * MiB, WS_QKVW = WS_NAOUT + 2 * MiB;
#define WS_SCIN_END (WS_QKVW + 6 * MiB)
#else
constexpr size_t WS_W1L = WS_WL, WS_W2L = WS_W1L + 24 * MiB, WS_QKVW = WS_W2L + 24 * MiB, WS_NAOUT = WS_QKVW + 6 * MiB, WS_SCIN = WS_NAOUT + 2 * MiB;
#define WS_SCIN_END (WS_SCIN + 6 * MiB)
#endif

    constexpr size_t WS_SCOUT = WS_SCIN_END, WS_FNW = WS_SCOUT + 2 * MiB;
constexpr size_t WS_G = WS_FNW + 2 * MiB;
constexpr size_t WS_ZX = WS_WL;
constexpr size_t WS_DT = WS_G + 132 * MiB;
constexpr size_t WS_END = WS_DT + (size_t)R * 64 * 4;
constexpr size_t WS_ACT = WS_XS;
constexpr size_t WS_YN = WS_XS;
static_assert(WS_ACT + (size_t)R * 4096 * 2 == WS_SSDIN, "ACT fills XS|H|Y exactly");
static_assert(WS_WL == 168 * MiB + MiB / 2 && WS_G == 234 * MiB + MiB / 2, "map");
static_assert(WS_ZX + (size_t)R * 6144 * 2 == WS_DT, "ZX fills later-weights + G");
static_assert(WS_H + (size_t)R * D * 2 == WS_Y && WS_Y + (size_t)R * D * 2 == WS_SSDIN && WS_XS + (size_t)R * D * 4 == WS_H, "map2");

struct Args { const float* in[24]; float* out; unsigned char* ws; };

__device__ __forceinline__ unsigned pk2(float lo, float hi) { return pg8::cvt_pk_bf16(lo, hi); }
__device__ __forceinline__ float bflo(unsigned w) { return __builtin_bit_cast(float, w << 16); }
__device__ __forceinline__ float bfhi(unsigned w) { return __builtin_bit_cast(float, w & 0xffff0000u); }
__device__ __forceinline__ float bf2f(unsigned short b) { return __builtin_bit_cast(float, (unsigned)b << 16); }
__device__ __forceinline__ unsigned short f2bf(float f) { return (unsigned short)(pk2(f, 0.f) & 0xffffu); }
__device__ __forceinline__ float wave_sum(float v) {
#pragma unroll
    for (int o = 1; o < 64; o <<= 1) v += __shfl_xor(v, o);
    return v;
}
__device__ __forceinline__ float silu_f(float v) { return v * __builtin_amdgcn_rcpf(1.f + __expf(-v)); }
__device__ __forceinline__ int rowmap(int reg, int hf) { return (reg & 3) + 8 * (reg >> 2) + 4 * hf; }
#define LDS_WAIT() asm volatile("s_waitcnt lgkmcnt(0)" ::: "memory")

template <int KS> __device__ __forceinline__ void mma_lds(F16& acc, lptr A, int sa, lptr B, int sb, int lane) {
    const int r = lane & 31, h = lane >> 5;
    lptr pa = A + r * sa + h * 16; lptr pb = B + r * sb + h * 16;
    B8 a[KS], b[KS];
#pragma unroll
    for (int s = 0; s < KS; ++s) { a[s] = *(const LAS B8*)(pa + s * 32); b[s] = *(const LAS B8*)(pb + s * 32); }
#pragma unroll
    for (int s = 0; s < KS; ++s) acc = __builtin_amdgcn_mfma_f32_32x32x16_bf16(a[s], b[s], acc, 0, 0, 0);
}
template <int KS> __device__ __forceinline__ void mma_ldsB(F16& acc, const B8 (&a)[KS], lptr B, int sb, int lane) {
    const int r = lane & 31, h = lane >> 5; lptr pb = B + r * sb + h * 16;
    B8 b[KS];
#pragma unroll
    for (int s = 0; s < KS; ++s) b[s] = *(const LAS B8*)(pb + s * 32);
#pragma unroll
    for (int s = 0; s < KS; ++s) acc = __builtin_amdgcn_mfma_f32_32x32x16_bf16(a[s], b[s], acc, 0, 0, 0);
}
template <int KS> __device__ __forceinline__ void mma_lds_swz(F16& acc, lptr A, int sa, int zA0, int maskA, lptr B, int sb, int zB0, int maskB, int lane) {
    const int r = lane & 31, h = lane >> 5;
    lptr pa = A + r * sa; lptr pb = B + r * sb; const int za = (zA0 + (r >> 3)) & maskA, zb = (zB0 + (r >> 3)) & maskB;
    B8 a[KS], b[KS];
#pragma unroll
    for (int s = 0; s < KS; ++s) { a[s] = *(const LAS B8*)(pa + (((2 * s + h) ^ za) << 4)); b[s] = *(const LAS B8*)(pb + (((2 * s + h) ^ zb) << 4)); }
#pragma unroll
    for (int s = 0; s < KS; ++s) acc = __builtin_amdgcn_mfma_f32_32x32x16_bf16(a[s], b[s], acc, 0, 0, 0);
}
__device__ __forceinline__ void mma_lds_swz_rt(F16& acc, lptr A, int sa, int zA0, int maskA, lptr B, int sb, int zB0, int maskB, int lane, int ks) {
    const int r = lane & 31, h = lane >> 5;
    lptr pa = A + r * sa; lptr pb = B + r * sb; const int za = (zA0 + (r >> 3)) & maskA, zb = (zB0 + (r >> 3)) & maskB;
#pragma unroll 2
    for (int s = 0; s < ks; ++s) { const B8 a = *(const LAS B8*)(pa + (((2 * s + h) ^ za) << 4)); const B8 b = *(const LAS B8*)(pb + (((2 * s + h) ^ zb) << 4)); acc = __builtin_amdgcn_mfma_f32_32x32x16_bf16(a, b, acc, 0, 0, 0); }
}
template <int KS> __device__ __forceinline__ void mma_gA(F16& acc, const bf16* A, int lda, lptr B, int sb, int lane) {
    const int r = lane & 31, h = lane >> 5;
    const bf16* pa = A + (size_t)r * lda + h * 8; lptr pb = B + r * sb + h * 16;
#pragma unroll
    for (int s = 0; s < KS; ++s) { const B8 a = *(const B8*)(pa + s * 16); const B8 b = *(const LAS B8*)(pb + s * 32); acc = __builtin_amdgcn_mfma_f32_32x32x16_bf16(a, b, acc, 0, 0, 0); }
}

#define XB_TMO      128
#define XB_XCNT(j)  (256  + 64 * (j))
#define XB_XSUB(j)  (1280 + 64 * (j))
#define XB_XGEN(j)  (2304 + 64 * (j))
#define XB_TOP      3328
#define XB_TOPGEN   3392
#define XCD_BAR_WORDS 3456
#define XB_SPIN_CAP (1u << 18)

__device__ __forceinline__ unsigned xb_ld(unsigned* p)              { return __hip_atomic_load(p, __ATOMIC_RELAXED, __HIP_MEMORY_SCOPE_AGENT); }
__device__ __forceinline__ unsigned xb_add(unsigned* p, unsigned v) { return __hip_atomic_fetch_add(p, v, __ATOMIC_RELAXED, __HIP_MEMORY_SCOPE_AGENT); }
__device__ __forceinline__ unsigned xb_xcc_id() { return (unsigned)__builtin_amdgcn_s_getreg((3 << 11) | 20) & 0xFu; }
#define XB_SPIN(cond, bar) do { unsigned _sp = 0; while (cond) { __builtin_amdgcn_s_sleep(1); \
    if ((++_sp & 255u) == 0u) { if (xb_ld(&(bar)[XB_TMO])) break; if (_sp > XB_SPIN_CAP) { atomicAdd(&(bar)[XB_TMO], 1u); break; } } } } while (0)

struct XcdBarrier {
    unsigned* bar; unsigned x;
    volatile LAS unsigned* st;
};

__device__ __forceinline__ XcdBarrier xcd_barrier_post(unsigned* bar, volatile LAS unsigned* st) {
    XcdBarrier b; b.bar = bar; b.x = xb_xcc_id(); b.st = st;
    if (threadIdx.x == 0) (void)xb_add(&bar[XB_XCNT(b.x)], 1u);
    return b;
}
__device__ __forceinline__ void xcd_barrier_complete(unsigned* bar, unsigned x, unsigned& nloc, unsigned& nx) {
    const unsigned G = gridDim.x * gridDim.y * gridDim.z;
    unsigned sum, cnt, mine, sp = 0u;
    for (;;) {
        sum = 0u; cnt = 0u; mine = 0u;
#pragma unroll
        for (unsigned j = 0; j < 16; ++j) { const unsigned c = xb_ld(&bar[XB_XCNT(j)]); sum += c; cnt += (c > 0u) ? 1u : 0u; mine = (j == x) ? c : mine; }
        if (sum == G) break;
        __builtin_amdgcn_s_sleep(1);
        if ((++sp & 255u) == 0u) { if (xb_ld(&bar[XB_TMO])) break; if (sp > XB_SPIN_CAP) { atomicAdd(&bar[XB_TMO], 1u); break; } }
    }
    nloc = mine > 0u ? mine : 1u; nx = cnt > 0u ? cnt : 1u;
}

__device__ __forceinline__ void xcd_barrier(const XcdBarrier& b) {
    asm volatile("s_waitcnt vmcnt(0)" ::: "memory");
    __syncthreads();
    if (threadIdx.x == 0) {
        unsigned* bar = b.bar;
        __builtin_amdgcn_s_waitcnt(0);
        unsigned nloc = b.st[0], nx = b.st[1];
        if (nloc == 0u) { xcd_barrier_complete(bar, b.x, nloc, nx); b.st[0] = nloc; b.st[1] = nx; }
        const unsigned old = xb_add(&bar[XB_XSUB(b.x)], 1u);
        const unsigned gen = old / nloc;
        if (old + 1u == (gen + 1u) * nloc) {
            __builtin_amdgcn_fence(__ATOMIC_RELEASE, "agent");
            asm volatile("s_waitcnt vmcnt(0)" ::: "memory");
            const unsigned og = xb_add(&bar[XB_TOP], 1u);
            const unsigned tg = og / nx;
            if (og + 1u == (tg + 1u) * nx) xb_add(&bar[XB_TOPGEN], 1u);
            else XB_SPIN(xb_ld(&bar[XB_TOPGEN]) == tg, bar);
            __builtin_amdgcn_fence(__ATOMIC_ACQUIRE, "agent");
            xb_add(&bar[XB_XGEN(b.x)], 1u);
            asm volatile("s_waitcnt vmcnt(0)" ::: "memory");
        } else {
            XB_SPIN(xb_ld(&bar[XB_XGEN(b.x)]) == gen, bar);
            __builtin_amdgcn_fence(__ATOMIC_ACQUIRE, "agent");
            asm volatile("s_waitcnt vmcnt(0)" ::: "memory");
        }
    }
    __syncthreads();
}

__device__ __forceinline__ void transpose_item(const float* W, int K, int N, bf16* WT, LAS float* scr, int item, int lane) {
    const int nblk = N / 32, kb = item / nblk, nb = item % nblk, k0 = 64 * kb, n0 = 32 * nb;
    float wv_[32];
#pragma unroll
    for (int i = 0; i < 32; ++i) wv_[i] = W[(size_t)(k0 + 2 * i + (lane >> 5)) * N + n0 + (lane & 31)];
#pragma unroll
    for (int i = 0; i < 32; ++i) scr[(2 * i + (lane >> 5)) * 33 + (lane & 31)] = wv_[i];
    LDS_WAIT(); asm volatile("" ::: "memory");
    const int c = lane & 7;
#pragma unroll
    for (int j = 0; j < 4; ++j) { const int n = (lane >> 3) + 8 * j; const LAS float* s = scr + (8 * c) * 33 + n;
        v4u o; o.x = pk2(s[0 * 33], s[1 * 33]); o.y = pk2(s[2 * 33], s[3 * 33]); o.z = pk2(s[4 * 33], s[5 * 33]); o.w = pk2(s[6 * 33], s[7 * 33]);
        *(v4u*)(WT + (size_t)(n0 + n) * K + k0 + 8 * c) = o; }
    LDS_WAIT(); asm volatile("" ::: "memory");
}
#define TJOB(W_, K_, N_, WT_) { const int ni_ = ((K_) / 64) * ((N_) / 32); if (r < ni_) { transpose_item((W_), (K_), (N_), (WT_), scr, r, lane); continue; } r -= ni_; }

struct RowArgs { const bf16* Yp; const float* tA; const float* tB; const bf16* tS; const bf16* Y; const float* gate; const float* gY; float* oA; bf16* oS; bf16* H; const float* gH; const float* shift; const float* scale; int nrows; };
__device__ __forceinline__ void rowpass(const RowArgs& a, int gw, int NGW, int lane) {
    F4 tfn[4]; v2u tsn[4], yn[4];
#define ROW_LOAD(row_) { const int r_ = (row_); \
        if (a.tA) { const float* tp = r_ < NLAT ? a.tA + (size_t)r_ * D : a.tB + (size_t)(r_ - NLAT) * D; _Pragma("unroll") for (int j = 0; j < 4; ++j) tfn[j] = ((const F4*)tp)[lane + 64 * j]; } \
        else { _Pragma("unroll") for (int j = 0; j < 4; ++j) tsn[j] = ((const v2u*)(a.tS + (size_t)r_ * D))[lane + 64 * j]; } \
        if (a.Y) { _Pragma("unroll") for (int j = 0; j < 4; ++j) yn[j] = ((const v2u*)(a.Y + (size_t)r_ * D))[lane + 64 * j]; } }
    int row = gw;
    if (row < a.nrows) ROW_LOAD(row)
    while (row < a.nrows) {
        const int set = row < SEQ ? 0 : (row < NLAT ? 1 : 2);
        F4 t[4]; v2u yw[4];
        if (a.tA) {
#pragma unroll
            for (int j = 0; j < 4; ++j) t[j] = tfn[j];
        } else {
#pragma unroll
            for (int j = 0; j < 4; ++j) t[j] = (F4){bflo(tsn[j].x), bfhi(tsn[j].x), bflo(tsn[j].y), bfhi(tsn[j].y)}; }
#pragma unroll
        for (int j = 0; j < 4; ++j) yw[j] = yn[j];
        const int nrow = row + NGW;
        if (nrow < a.nrows) ROW_LOAD(nrow)
        if (a.Y) {
            F4 y[4]; float ss = 0.f;
#pragma unroll
            for (int j = 0; j < 4; ++j) { const v2u w = yw[j]; y[j] = (F4){bflo(w.x), bfhi(w.x), bflo(w.y), bfhi(w.y)}; }
            if (a.Yp && row >= NLAT) {
#pragma unroll
                for (int j = 0; j < 4; ++j) { y[j] = (F4){0.f, 0.f, 0.f, 0.f};
#pragma unroll
                    for (int s4 = 0; s4 < 4; ++s4) { const v2u w = ((const v2u*)(a.Yp + ((size_t)s4 * 512 + (row - NLAT)) * D))[lane + 64 * j]; y[j] += (F4){bflo(w.x), bfhi(w.x), bflo(w.y), bfhi(w.y)}; } } }
#pragma unroll
            for (int j = 0; j < 4; ++j) ss += (y[j].x * y[j].x + y[j].y * y[j].y) + (y[j].z * y[j].z + y[j].w * y[j].w);
            const float rstd = rsqrtf(wave_sum(ss) * (1.f / D) + 1e-6f);
#pragma unroll
            for (int j = 0; j < 4; ++j) { const F4 g4 = ((const F4*)(a.gate + set * 6144))[lane + 64 * j]; const F4 gy = ((const F4*)a.gY)[lane + 64 * j]; t[j] = t[j] + g4 * ((y[j] * rstd) * gy); }
        }
        if (a.oA) { float* op = a.oA + (size_t)row * D;
#pragma unroll
            for (int j = 0; j < 4; ++j) ((F4*)op)[lane + 64 * j] = t[j]; }
        if (a.oS) {
#pragma unroll
            for (int j = 0; j < 4; ++j) { v2u w; w.x = pk2(t[j].x, t[j].y); w.y = pk2(t[j].z, t[j].w); ((v2u*)(a.oS + (size_t)row * D))[lane + 64 * j] = w;
                t[j] = (F4){bflo(w.x), bfhi(w.x), bflo(w.y), bfhi(w.y)}; } }
        if (a.H) {
            float ss = 0.f;
#pragma unroll
            for (int j = 0; j < 4; ++j) ss += (t[j].x * t[j].x + t[j].y * t[j].y) + (t[j].z * t[j].z + t[j].w * t[j].w);
            const float rstd = rsqrtf(wave_sum(ss) * (1.f / D) + 1e-6f);
#pragma unroll
            for (int j = 0; j < 4; ++j) { const F4 g = ((const F4*)a.gH)[lane + 64 * j]; const F4 sh = ((const F4*)(a.shift + set * 6144))[lane + 64 * j]; const F4 sc = ((const F4*)(a.scale + set * 6144))[lane + 64 * j];
                const F4 hv = ((t[j] * rstd) * g) * (sc + 1.f) + sh; v2u w; w.x = pk2(hv.x, hv.y); w.y = pk2(hv.z, hv.w);
                ((v2u*)(a.H + (size_t)row * D))[lane + 64 * j] = w; }
        }
        row = nrow;
    }
#undef ROW_LOAD
}

__device__ __forceinline__ void p0_prologue(const Args& A, lptr lds, int tid, int lane, int wave, const int part) {
    unsigned char* ws = A.ws;
    LAS float* cv = (LAS float*)(lds + 131072);
    LAS float* red = (LAS float*)(lds + 131072 + 12288);
    float* MV = (float*)(ws + WS_MV);
    if (part == 0) {
    for (int i = tid; i < 3 * D; i += NT) { const float v = i < 2 * D ? A.in[1][i] : A.in[3][i - 2 * D]; cv[i] = silu_f(v); }
    __syncthreads();
    for (int it = blockIdx.x; it < 4 * 192; it += gridDim.x) {
        const int layer = it / 192, n0 = (it % 192) * 32, c4 = tid & 7, kk = tid >> 3;
        const float* w = A.in[4] + (size_t)layer * D * 6144 + n0 + 4 * c4;
        F4 a0 = {0.f, 0.f, 0.f, 0.f}, a1 = a0, a2 = a0;
#pragma unroll 16
        for (int i = 0; i < 16; ++i) { const int k = kk + 64 * i; const F4 wv = *(const F4*)(w + (size_t)k * 6144); a0 += wv * cv[k]; a1 += wv * cv[D + k]; a2 += wv * cv[2 * D + k]; }
#pragma unroll
        for (int o = 8; o < 64; o <<= 1) {
#pragma unroll
            for (int e = 0; e < 4; ++e) { a0[e] += __shfl_xor(a0[e], o); a1[e] += __shfl_xor(a1[e], o); a2[e] += __shfl_xor(a2[e], o); } }
        if (lane < 8) { *(LAS F4*)(red + (wave * 3 + 0) * 32 + 4 * lane) = a0; *(LAS F4*)(red + (wave * 3 + 1) * 32 + 4 * lane) = a1; *(LAS F4*)(red + (wave * 3 + 2) * 32 + 4 * lane) = a2; }
        __syncthreads();
        if (tid < 96) { const int s = tid >> 5, c = tid & 31; float v = A.in[5][layer * 6144 + n0 + c];
#pragma unroll
            for (int w8 = 0; w8 < 8; ++w8) v += red[(w8 * 3 + s) * 32 + c];
            MV[((size_t)layer * 3 + s) * 6144 + n0 + c] = v; }
        __syncthreads();
    }
    return; }
    const int gt = blockIdx.x * NT + tid, NGT = gridDim.x * NT;
    const float TWO_PI = 6.283185307179586f;
    {
        bf16* CST = (bf16*)(ws + WS_CST); bf16* D64 = (bf16*)(ws + WS_D64); bf16* D128 = (bf16*)(ws + WS_D128); float* TW = (float*)(ws + WS_TW);
        for (int i = gt; i < 256 * 128; i += NGT) { const int rr = i >> 7, n = i & 127, m = rr & 127; const float ang = TWO_PI * (float)((m * n) & 127) * (1.f / 128.f);
            CST[i] = f2bf(rr < 128 ? cosf(ang) : -sinf(ang)); }
        for (int i = gt; i < 128 * 128; i += NGT) { const int rr = i >> 7, cc = i & 127, k1 = rr & 63, t1 = cc & 63, co = rr >> 6, ci = cc >> 6; const float ang = TWO_PI * (float)((k1 * t1) & 63) * (1.f / 64.f);
            const float cs = cosf(ang), sn = sinf(ang); D64[i] = f2bf(co == ci ? cs : (co == 0 ? sn : -sn)); }
        for (int i = gt; i < 128 * 256; i += NGT) { const int k2 = i >> 8, cc = i & 255, t2 = cc & 127, ci = cc >> 7; const float ang = TWO_PI * (float)((k2 * t2) & 127) * (1.f / 128.f);
            D128[i] = f2bf(ci == 0 ? cosf(ang) : sinf(ang)); }
        for (int i = gt; i < 64 * 128; i += NGT) { const int k1 = i >> 7, t2 = i & 127; const float ang = TWO_PI * (float)(k1 * t2) * (1.f / 8192.f); TW[2 * i] = cosf(ang); TW[2 * i + 1] = sinf(ang); }
    }
    {
        v4u* z = (v4u*)(ws + WS_SSDIN + (size_t)6208 * 1024 * 2); const v4u zero = {0u, 0u, 0u, 0u};
        for (int i = gt; i < 192 * 1024 * 2 / 16; i += NGT) z[i] = zero;
    }
    LAS float* scr = (LAS float*)(lds + wave * 16384);
    const int gw = blockIdx.x * NWAVES + wave, NGW = gridDim.x * NWAVES;
    constexpr int NIT0 = 16 * 194 + 32 * 32 + 16 * 128 + 64 * 32;
    for (int it = gw; it < NIT0; it += NGW) {
        int r = it;
        TJOB(A.in[9], 1024, 6208, (bf16*)(ws + WS_SSDIN))
        TJOB(A.in[16], 2048, 1024, (bf16*)(ws + WS_SSDOUT))
        TJOB(A.in[7], 1024, 4096, (bf16*)(ws + WS_W1_0))
        TJOB(A.in[8], 4096, 1024, (bf16*)(ws + WS_W2_0))
    }
}
__device__ __forceinline__ void late_weights(const Args& A, lptr lds, int lane, int wave) {
    unsigned char* ws = A.ws;
    LAS float* scr = (LAS float*)(lds + wave * 16384);
    const int gw = blockIdx.x * NWAVES + wave, NGW = gridDim.x * NWAVES;
    constexpr int NIT = 6 * 2048 + 1536 + 512 + 1536 + 512 + 512;
    for (int it = gw; it < NIT; it += NGW) {
        int r = it;
        TJOB(A.in[7] + (size_t)1 * D * FF, 1024, 4096, (bf16*)(ws + WS_W1L))
        TJOB(A.in[7] + (size_t)2 * D * FF, 1024, 4096, (bf16*)(ws + WS_W1L + 8 * MiB))
        TJOB(A.in[7] + (size_t)3 * D * FF, 1024, 4096, (bf16*)(ws + WS_W1L + 16 * MiB))
        TJOB(A.in[8] + (size_t)1 * D * FF, 4096, 1024, (bf16*)(ws + WS_W2L))
        TJOB(A.in[8] + (size_t)2 * D * FF, 4096, 1024, (bf16*)(ws + WS_W2L + 8 * MiB))
        TJOB(A.in[8] + (size_t)3 * D * FF, 4096, 1024, (bf16*)(ws + WS_W2L + 16 * MiB))
        TJOB(A.in[17], 1024, 3072, (bf16*)(ws + WS_QKVW))
        TJOB(A.in[19], 1024, 1024, (bf16*)(ws + WS_NAOUT))
        TJOB(A.in[20], 1024, 3072, (bf16*)(ws + WS_SCIN))
        TJOB(A.in[22], 1024, 1024, (bf16*)(ws + WS_SCOUT))
        TJOB(A.in[23], 1024, 1024, (bf16*)(ws + WS_FNW))
    }
}
template <int NTOK> struct RawRun { v4u r[NTOK + 2]; };
template <int NTOK> __device__ __forceinline__ RawRun<NTOK> load_run(const bf16* zx, int rowbase, int tlo, int seqlen, int col) {
    const v4u zero = {0u, 0u, 0u, 0u}; RawRun<NTOK> rr;
#pragma unroll
    for (int q = 0; q < NTOK + 2; ++q) { const int t = tlo - 1 + q; rr.r[q] = (t >= 0 && t < seqlen) ? *(const v4u*)(zx + (size_t)(rowbase + t) * 6144 + col) : zero; }
    return rr;
}
__device__ __forceinline__ void conv_tok(const v4u& rp, const v4u& rc, const v4u& rn, const LAS float* w, int W, int c0, float (&o)[8]) {
    const unsigned pc[4] = {rc.x, rc.y, rc.z, rc.w}, pp[4] = {rp.x, rp.y, rp.z, rp.w}, pn[4] = {rn.x, rn.y, rn.z, rn.w};
#pragma unroll
    for (int e = 0; e < 8; ++e) {
        const float xc = (e & 1) ? bfhi(pc[e >> 1]) : bflo(pc[e >> 1]), xp = (e & 1) ? bfhi(pp[e >> 1]) : bflo(pp[e >> 1]), xn = (e & 1) ? bfhi(pn[e >> 1]) : bflo(pn[e >> 1]);
        const float v = w[0 * W + c0 + e] * xp + w[1 * W + c0 + e] * xc + w[2 * W + c0 + e] * xn + w[3 * W + c0 + e];
        o[e] = silu_f(v);
    }
}
template <int DUMMY> __device__ __forceinline__ void mma_lds_rt(F16& acc, lptr A, int sa, lptr B, int sb, int lane, int ks) {
    const int r = lane & 31, h = lane >> 5;
    lptr pa = A + r * sa + h * 16; lptr pb = B + r * sb + h * 16;
#pragma unroll 2
    for (int s = 0; s < ks; ++s) { const B8 a = *(const LAS B8*)(pa + s * 32); const B8 b = *(const LAS B8*)(pb + s * 32); acc = __builtin_amdgcn_mfma_f32_32x32x16_bf16(a, b, acc, 0, 0, 0); }
}

__device__ __forceinline__ void ssd_act_phase(const Args& A, int gt, int NGT) {
    unsigned char* ws = A.ws;
    const bf16* ZX = (const bf16*)(ws + WS_ZX); bf16* ACT = (bf16*)(ws + WS_ACT);
    const float* cw = A.in[10]; const float* cb = A.in[11];
    for (int it = gt; it < (R / 8) * 512; it += NGT) {
        const int cg = it & 511, run = it >> 9, row0 = run * 8;
        const int seq0 = row0 < NLAT ? (row0 & ~(SEQ - 1)) : NLAT + ((row0 - NLAT) & ~(CTXL - 1)), seqlen = row0 < NLAT ? SEQ : CTXL, tl = row0 - seq0;
        const v4u zero = {0u, 0u, 0u, 0u};
        v4u r[10];
#pragma unroll
        for (int q = 0; q < 10; ++q) { const int t_ = tl - 1 + q; r[q] = (t_ >= 0 && t_ < seqlen) ? *(const v4u*)(ZX + (size_t)(seq0 + t_) * 6144 + 2048 + 8 * cg) : zero; }
        float w0[8], w1[8], w2[8], bb[8];
#pragma unroll
        for (int e = 0; e < 8; ++e) { w0[e] = cw[8 * cg + e]; w1[e] = cw[4096 + 8 * cg + e]; w2[e] = cw[8192 + 8 * cg + e]; bb[e] = cb[8 * cg + e]; }
#pragma unroll
        for (int q = 0; q < 8; ++q) {
            const unsigned pp[4] = {r[q].x, r[q].y, r[q].z, r[q].w}, pc[4] = {r[q + 1].x, r[q + 1].y, r[q + 1].z, r[q + 1].w}, pn[4] = {r[q + 2].x, r[q + 2].y, r[q + 2].z, r[q + 2].w};
            float o[8];
#pragma unroll
            for (int e = 0; e < 8; ++e) { const float xp = (e & 1) ? bfhi(pp[e >> 1]) : bflo(pp[e >> 1]), xc = (e & 1) ? bfhi(pc[e >> 1]) : bflo(pc[e >> 1]), xn = (e & 1) ? bfhi(pn[e >> 1]) : bflo(pn[e >> 1]);
                o[e] = silu_f(w0[e] * xp + w1[e] * xc + w2[e] * xn + bb[e]); }
            v4u w; w.x = pk2(o[0], o[1]); w.y = pk2(o[2], o[3]); w.z = pk2(o[4], o[5]); w.w = pk2(o[6], o[7]);
            *(v4u*)(ACT + (size_t)(row0 + q) * 4096 + 8 * cg) = w;
        }
    }
}
__device__ __forceinline__ void ssd_scan_phase(const Args& A, lptr lds, int tid, int lane, int wave) {
    unsigned char* ws = A.ws;
    const bf16* ZX = (const bf16*)(ws + WS_ZX); const float* DT = (const float*)(ws + WS_DT); const bf16* ACT = (const bf16*)(ws + WS_ACT);
    constexpr int SR = 272;
    lptr Cm = lds, Bm = lds + 34816, BTw = lds + 69632, XT = lds + 104448, St = lds + 121856;
    LAS float* cumL = (LAS float*)(lds + 139264); LAS float* dtL = cumL + 128; LAS float* wendL = cumL + 256; LAS float* ecumL = cumL + 384;
    LAS float* wX = (LAS float*)(lds + 141312); LAS float* wB = wX + 256; LAS float* wC = wB + 512;
    const int hf = lane >> 5, l31 = lane & 31;
    for (int unit = blockIdx.x; unit < 256; unit += gridDim.x) {
        int hv, u7;
        if (gridDim.x == 256) { const int x = unit & 7, j = unit >> 3, combo = x * 4 + (j >> 3), e8 = j & 7; hv = combo >> 4; u7 = (((combo >> 3) & 1) << 6) | (((combo >> 2) & 1) << 5) | ((combo & 3) << 3) | e8; }
        else { hv = unit >> 7; u7 = unit & 127; }
        const int sBeg = hv ? 34 : 0, sEnd = hv ? 66 : 34;
        const int b = u7 >> 6, d = (u7 >> 5) & 1, h = u7 & 31, g = h >> 3;
        bf16* SM = (bf16*)(ws + 371 * MiB) + (size_t)u7 * 8192;
        const int chX = h * 64, chB = 2048 + ((d * 2 + 0) * 4 + g) * 128, chC = 2048 + ((d * 2 + 1) * 4 + g) * 128;
        const float a_neg = -__expf(A.in[13][d * 32 + h]);
        const float Dtot = A.in[14][h] + A.in[14][32 + h];
        const float dtb = A.in[12][d * 32 + h];
        bf16* Yout = (bf16*)(ws + WS_ZX) + (d ? 4096 : 2048);
        __syncthreads();
        for (int i = tid; i < 64 * SR / 4; i += NT) ((LAS unsigned*)St)[i] = 0u;
        F16 acc_st;
#pragma unroll
        for (int e = 0; e < 16; ++e) acc_st[e] = 0.f;
        __syncthreads();
        const int cgx = tid & 7, jrx = tid >> 3, cgb = tid & 15, jrb = tid >> 4;
        v4u px[2], pb[4], pc_[4];
#define SCAN_LOAD(s_) { const int s3 = (s_), ph3 = s3 >= 2, ci3 = ph3 ? s3 - 2 : s3, nch3 = ph3 ? 64 : 2, rb3 = ph3 ? b * SEQ : NLAT + b * CTXL, t03 = (d ? nch3 - 1 - ci3 : ci3) * 128; \
            const int tlx = d ? t03 + 128 - 2 * (jrx + 1) : t03 + 2 * jrx, tlb = d ? t03 + 128 - 4 * (jrb + 1) : t03 + 4 * jrb; \
            _Pragma("unroll") for (int q = 0; q < 2; ++q) px[q] = *(const v4u*)(ACT + (size_t)(rb3 + tlx + q) * 4096 + chX + 8 * cgx); \
            _Pragma("unroll") for (int q = 0; q < 4; ++q) { pb[q] = *(const v4u*)(ACT + (size_t)(rb3 + tlb + q) * 4096 + chB + 8 * cgb); pc_[q] = *(const v4u*)(ACT + (size_t)(rb3 + tlb + q) * 4096 + chC + 8 * cgb); } }
        SCAN_LOAD(sBeg)
        float dtp0 = 0.f, dtp1 = 0.f;
#define SCAN_DT_LOAD(s_) { const int s2 = (s_), ph2 = s2 >= 2, ci2 = ph2 ? s2 - 2 : s2, nch2 = ph2 ? 64 : 2, rb2 = ph2 ? b * SEQ : NLAT + b * CTXL, t02 = (d ? nch2 - 1 - ci2 : ci2) * 128; \
            const int tA = d ? t02 + 127 - lane : t02 + lane, tB = d ? t02 + 63 - lane : t02 + 64 + lane; \
            dtp0 = DT[(size_t)(rb2 + tA) * 64 + d * 32 + h]; dtp1 = DT[(size_t)(rb2 + tB) * 64 + d * 32 + h]; }
#define SCAN_STEP1(sN) { LAS float* cb_ = (LAS float*)(lds + 139264 + (((sN) & 1) ? 2048 : 0)); \
            const float xr0 = dtp0 + dtb, xr1 = dtp1 + dtb; const float dt0 = xr0 > 20.f ? xr0 : log1pf(__expf(xr0)), dt1 = xr1 > 20.f ? xr1 : log1pf(__expf(xr1)); \
            if ((sN) + 1 < 66) SCAN_DT_LOAD((sN) + 1) \
            float v0 = dt0 * a_neg, v1 = dt1 * a_neg; \
            _Pragma("unroll") for (int o = 1; o < 64; o <<= 1) { const float u0 = __shfl_up(v0, o), u1 = __shfl_up(v1, o); if (lane >= o) { v0 += u0; v1 += u1; } } \
            v1 += __shfl(v0, 63); const float cend = __shfl(v1, 63); \
            if (hv && lane == 0) ((float*)(ws + 373 * MiB))[u7 * 32 + ((sN) - 34)] = cend; \
            cb_[lane] = v0; cb_[lane + 64] = v1; cb_[128 + lane] = dt0; cb_[192 + lane] = dt1; \
            cb_[256 + lane] = __expf(cend - v0) * dt0; cb_[320 + lane] = __expf(cend - v1) * dt1; \
            cb_[384 + lane] = __expf(v0); cb_[448 + lane] = __expf(v1); }
        if (wave == 1) { SCAN_DT_LOAD(sBeg) SCAN_STEP1(sBeg) }
        __syncthreads();
        {
            for (int s = sBeg; s < sEnd; ++s) {
                const int ph = s >= 2, ci = ph ? s - 2 : s;
                const int nch = ph ? 64 : 2, rowbase = ph ? b * SEQ : NLAT + b * CTXL, seqlen = ph ? SEQ : CTXL; (void)seqlen;
                const int c = d ? nch - 1 - ci : ci, t0 = c * 128;
                const int cbo = (s & 1) ? 2048 : 0;
                const int rstep = d ? -1 : 1;
                const size_t row0 = (size_t)(rowbase + (d ? t0 + 127 - ((wave >> 1) * 32 + 4 * hf) : t0 + (wave >> 1) * 32 + 4 * hf));
                const bf16* zp = ZX + row0 * 6144 + h * 64 + (wave & 1) * 32 + l31; bf16* yp = Yout + row0 * 6144 + h * 64 + (wave & 1) * 32 + l31;
                unsigned short zv[16];
#pragma unroll
                for (int e = 0; e < 16; ++e) { const int io = (e & 3) + 8 * (e >> 2); zv[e] = zp[(ptrdiff_t)(io * rstep) * 6144]; }
                int wof = 0; asm volatile("" : "+v"(wof));
                lptr ldsc = lds + wof;
                { lptr xtw = ldsc + 104448 + (8 * cgx) * SR + ((((jrx >> 2) ^ cgx) & 15) << 4) + ((4 * jrx) & 15); asm volatile("" : "+v"(xtw));
                  const unsigned a0[4] = {px[0].x, px[0].y, px[0].z, px[0].w}, a1[4] = {px[1].x, px[1].y, px[1].z, px[1].w};
#pragma unroll
                  for (int e = 0; e < 8; ++e) { const unsigned lo0 = (e & 1) ? (a0[e >> 1] >> 16) : (a0[e >> 1] & 0xffffu), lo1 = (e & 1) ? (a1[e >> 1] >> 16) : (a1[e >> 1] & 0xffffu);
                      *(LAS unsigned*)(xtw + e * SR) = d ? (lo1 | (lo0 << 16)) : (lo0 | (lo1 << 16)); } }
                lptr cmw = ldsc + (4 * jrb + (d ? 3 : 0)) * SR + cgb * 16; asm volatile("" : "+v"(cmw)); const int qstep = d ? -SR : SR;
#pragma unroll
                for (int q = 0; q < 4; ++q) *(LAS v4u*)(cmw + q * qstep) = pc_[q];
                { lptr bmw = cmw + 34816; lptr btw = ldsc + 69632 + (8 * cgb) * SR + ((((jrb >> 1) ^ cgb) & 15) << 4) + ((8 * jrb) & 15); asm volatile("" : "+v"(btw));
#pragma unroll
                  for (int q = 0; q < 4; ++q) *(LAS v4u*)(bmw + q * qstep) = pb[q];
                  const F4 we = *(const LAS F4*)((const LAS float*)(ldsc + 139264 + cbo) + 256 + 4 * jrb);
                  const unsigned b0[4] = {pb[0].x, pb[0].y, pb[0].z, pb[0].w}, b1[4] = {pb[1].x, pb[1].y, pb[1].z, pb[1].w}, b2[4] = {pb[2].x, pb[2].y, pb[2].z, pb[2].w}, b3[4] = {pb[3].x, pb[3].y, pb[3].z, pb[3].w};
#pragma unroll
                  for (int e = 0; e < 8; ++e) { const int q2 = e >> 1;
                      const float f0 = (e & 1) ? bfhi(b0[q2]) : bflo(b0[q2]), f1 = (e & 1) ? bfhi(b1[q2]) : bflo(b1[q2]), f2 = (e & 1) ? bfhi(b2[q2]) : bflo(b2[q2]), f3 = (e & 1) ? bfhi(b3[q2]) : bflo(b3[q2]);
                      v2u w;
                      if (d) { w.x = pk2(f3 * we.x, f2 * we.y); w.y = pk2(f1 * we.z, f0 * we.w); }
                      else   { w.x = pk2(f0 * we.x, f1 * we.y); w.y = pk2(f2 * we.z, f3 * we.w); }
                      *(LAS v2u*)(btw + e * SR) = w; } }
                if (s + 1 < sEnd) SCAN_LOAD(s + 1)
                __syncthreads();
                F16 cb0, cb1, acc2;
#pragma unroll
                for (int e = 0; e < 16; ++e) { cb0[e] = 0.f; cb1[e] = 0.f; acc2[e] = 0.f; }
                const int ti0 = (2 * wave) >> 2, tj0 = (2 * wave) & 3, tj1 = tj0 + 1;
                const int ti2 = wave >> 1, tp = wave & 1;
                { B8 af[8]; { lptr pa = Cm + ti0 * 32 * SR + l31 * SR + hf * 16;
#pragma unroll
                    for (int q = 0; q < 8; ++q) af[q] = *(const LAS B8*)(pa + q * 32); }
                  mma_ldsB<8>(acc2, af, St + tp * 32 * SR, SR, lane);
                  if (tj0 <= ti0) mma_ldsB<8>(cb0, af, Bm + tj0 * 32 * SR, SR, lane);
                  if (tj1 <= ti0) mma_ldsB<8>(cb1, af, Bm + tj1 * 32 * SR, SR, lane); }
                if (wave == 1 && s + 1 < sEnd) SCAN_STEP1(s + 1)
                __syncthreads();
                { const LAS float* cumI = (const LAS float*)(ldsc + 139264 + cbo) + ti0 * 32 + 4 * hf; const LAS float* cumJ = (const LAS float*)(ldsc + 139264 + cbo);
                  if (tj0 <= ti0) { const int j = tj0 * 32 + l31; const float cj = cumJ[j], dj = cumJ[128 + j]; lptr sw = ldsc + 34816 + (ti0 * 32 + 4 * hf) * SR + j * 2; asm volatile("" : "+v"(sw));
#pragma unroll
                    for (int e = 0; e < 16; ++e) { const int io = (e & 3) + 8 * (e >> 2); const int i = ti0 * 32 + 4 * hf + io;
                        const float v = (j <= i) ? cb0[e] * __expf(cumI[io] - cj) * dj : 0.f; *(LAS bf16*)(sw + io * SR) = f2bf(v); } }
                  if (tj1 <= ti0) { const int j = tj1 * 32 + l31; const float cj = cumJ[j], dj = cumJ[128 + j]; lptr sw = ldsc + 34816 + (ti0 * 32 + 4 * hf) * SR + j * 2; asm volatile("" : "+v"(sw));
#pragma unroll
                    for (int e = 0; e < 16; ++e) { const int io = (e & 3) + 8 * (e >> 2); const int i = ti0 * 32 + 4 * hf + io;
                        const float v = (j <= i) ? cb1[e] * __expf(cumI[io] - cj) * dj : 0.f; *(LAS bf16*)(sw + io * SR) = f2bf(v); } } }
                __syncthreads();
                F16 acc1;
#pragma unroll
                for (int e = 0; e < 16; ++e) acc1[e] = 0.f;
                mma_lds_swz_rt(acc1, Bm + ti2 * 32 * SR, SR, 0, 0, XT + tp * 32 * SR, SR, 4 * tp, 7, lane, 2 * (ti2 + 1));
                { const LAS float* ecI = (const LAS float*)(ldsc + 139264 + cbo) + 384 + ti2 * 32 + 4 * hf; const int zx_ = (4 * tp + (l31 >> 3)) & 7; lptr xd = ldsc + 104448 + (tp * 32 + l31) * SR + (8 * hf); asm volatile("" : "+v"(xd));
#pragma unroll
                  for (int e = 0; e < 16; ++e) { const int io = (e & 3) + 8 * (e >> 2);
                    float y = acc1[e] + ecI[io] * acc2[e];
                    if (d == 0) y += Dtot * bf2f(*(const LAS bf16*)(xd + ((((4 * ti2 + (e >> 2)) ^ zx_)) << 4) + (e & 3) * 2));
                    const float z = bf2f(zv[e]);
                    yp[(ptrdiff_t)(io * rstep) * 6144] = f2bf(y * silu_f(z)); } }
                const int tps = wave >> 2, tn = wave & 3; const float decay = __expf(((const LAS float*)(ldsc + 139264 + cbo))[127]);
#pragma unroll
                for (int e = 0; e < 16; ++e) acc_st[e] *= decay;
                mma_lds_swz<8>(acc_st, XT + tps * 32 * SR, SR, 4 * tps, 7, BTw + tn * 32 * SR, SR, 4 * tn, 15, lane);
                { lptr stw = ldsc + 121856 + (tps * 32 + 4 * hf) * SR + (tn * 32 + l31) * 2; asm volatile("" : "+v"(stw));
#pragma unroll
                  for (int e = 0; e < 16; ++e) { const int io = (e & 3) + 8 * (e >> 2); *(LAS bf16*)(stw + io * SR) = f2bf(acc_st[e]); } }
                __syncthreads();
            }
        }
        if (hv == 0) {
            const int tps_ = wave >> 2, tn_ = wave & 3;
            bf16* smb = SM + (size_t)(tps_ * 32 + 4 * hf) * 128 + tn_ * 32 + l31;
#pragma unroll
            for (int e = 0; e < 16; ++e) { const int io = (e & 3) + 8 * (e >> 2); smb[io * 128] = f2bf(acc_st[e]); }
        }
    }
}

__device__ __forceinline__ void ssd_corr_phase(const Args& A, lptr lds, int tid, int lane, int wave) {
    unsigned char* ws = A.ws;
    const bf16* ZX = (const bf16*)(ws + WS_ZX); const float* DT = (const float*)(ws + WS_DT); const bf16* ACT = (const bf16*)(ws + WS_ACT);
    constexpr int SR = 272;
    lptr Cm = lds, St = lds + 34816; LAS float* fac = (LAS float*)(lds + 34816 + 17408);
    const int hf = lane >> 5, l31 = lane & 31;
    for (int cu0 = blockIdx.x; cu0 < 256; cu0 += gridDim.x) {
        int cu = cu0; asm volatile("" : "+v"(cu));
        int u7, k0;
        if (gridDim.x == 256) { const int x = cu & 7, j = cu >> 3, combo = x * 4 + (j >> 3), e8 = j & 7; u7 = (((combo >> 4) & 1) << 6) | (((combo >> 3) & 1) << 5) | (((combo >> 1) & 3) << 3) | e8; k0 = (combo & 1) * 16; }
        else { u7 = cu >> 1; k0 = (cu & 1) * 16; }
        const int b = u7 >> 6, d = (u7 >> 5) & 1, h = u7 & 31, g = h >> 3;
        const int chC = 2048 + ((d * 2 + 1) * 4 + g) * 128, rowbase = b * SEQ;
        const bf16* SM = (const bf16*)(ws + 371 * MiB) + (size_t)u7 * 8192; const float* CE = (const float*)(ws + 373 * MiB) + u7 * 32;
        bf16* Yout = (bf16*)(ws + WS_ZX) + (d ? 4096 : 2048);
        const float a_neg = -__expf(A.in[13][d * 32 + h]), dtb = A.in[12][d * 32 + h];
        const int cgb = tid & 15, jrb = tid >> 4;
        __syncthreads();
#pragma unroll
        for (int q = 0; q < 2; ++q) { const int pcs = tid + NT * q, prow = pcs >> 4, pch = pcs & 15; *(LAS v4u*)(St + prow * SR + pch * 16) = *(const v4u*)(SM + prow * 128 + pch * 8); }
        v4u pc_[4]; float dr0 = 0.f, dr1 = 0.f;
#define CORR_LOAD(k_) { const int c3 = (d ? 63 - (32 + (k_)) : 32 + (k_)), t03 = c3 * 128; const int tlb = d ? t03 + 128 - 4 * (jrb + 1) : t03 + 4 * jrb; \
            _Pragma("unroll") for (int q = 0; q < 4; ++q) pc_[q] = *(const v4u*)(ACT + (size_t)(rowbase + tlb + q) * 4096 + chC + 8 * cgb); \
            if (wave == 1) { const int tA = d ? t03 + 127 - lane : t03 + lane, tB = d ? t03 + 63 - lane : t03 + 64 + lane; \
                dr0 = DT[(size_t)(rowbase + tA) * 64 + d * 32 + h]; dr1 = DT[(size_t)(rowbase + tB) * 64 + d * 32 + h]; } }
        CORR_LOAD(k0)
        for (int i = 0; i < 16; ++i) {
            const int k = k0 + i, ci = 32 + k, c = d ? 63 - ci : ci, t0 = c * 128;
            __syncthreads();
            if (wave == 1) {
                const float xr0 = dr0 + dtb, xr1 = dr1 + dtb;
                const float dt0 = xr0 > 20.f ? xr0 : log1pf(__expf(xr0)), dt1 = xr1 > 20.f ? xr1 : log1pf(__expf(xr1));
                float pre = (lane < k) ? CE[lane] : 0.f; pre = wave_sum(pre);
                float v0 = dt0 * a_neg, v1 = dt1 * a_neg;
#pragma unroll
                for (int o = 1; o < 64; o <<= 1) { const float u0 = __shfl_up(v0, o), u1 = __shfl_up(v1, o); if (lane >= o) { v0 += u0; v1 += u1; } }
                v1 += __shfl(v0, 63);
                fac[lane] = __expf(v0 + pre); fac[lane + 64] = __expf(v1 + pre);
            }
            { lptr cmw = Cm + (4 * jrb + (d ? 3 : 0)) * SR + cgb * 16; const int qstep = d ? -SR : SR;
#pragma unroll
              for (int q = 0; q < 4; ++q) *(LAS v4u*)(cmw + q * qstep) = pc_[q]; }
            const int ti2 = wave >> 1, tp = wave & 1, rstep = d ? -1 : 1;
            const size_t row0 = (size_t)(rowbase + (d ? t0 + 127 - (ti2 * 32 + 4 * hf) : t0 + ti2 * 32 + 4 * hf));
            const bf16* zp = ZX + row0 * 6144 + h * 64 + tp * 32 + l31; bf16* yp = Yout + row0 * 6144 + h * 64 + tp * 32 + l31;
            unsigned short zv[16], yv[16];
#pragma unroll
            for (int e = 0; e < 16; ++e) { const int io = (e & 3) + 8 * (e >> 2); zv[e] = zp[(ptrdiff_t)(io * rstep) * 6144]; yv[e] = yp[(ptrdiff_t)(io * rstep) * 6144]; }
            if (i < 15) CORR_LOAD(k + 1)
            __syncthreads();
            F16 acc2;
#pragma unroll
            for (int e = 0; e < 16; ++e) acc2[e] = 0.f;
            mma_lds<8>(acc2, Cm + ti2 * 32 * SR, SR, St + tp * 32 * SR, SR, lane);
#pragma unroll
            for (int e = 0; e < 16; ++e) { const int io = (e & 3) + 8 * (e >> 2);
                yp[(ptrdiff_t)(io * rstep) * 6144] = f2bf(bf2f(yv[e]) + fac[ti2 * 32 + 4 * hf + io] * acc2[e] * silu_f(bf2f(zv[e]))); }
        }
#undef CORR_LOAD
    }
}

__device__ __forceinline__ void ssd_combine(const Args& A, int gw, int NGW, int lane) {
    unsigned char* ws = A.ws;
    const bf16* YF = (const bf16*)(ws + WS_ZX) + 2048; const bf16* YB = (const bf16*)(ws + WS_ZX) + 4096; bf16* YN = (bf16*)(ws + WS_YN);
    v2u fn[8], bn[8];
#define CMB_LOAD(r_) { _Pragma("unroll") for (int j = 0; j < 8; ++j) { fn[j] = ((const v2u*)(YF + (size_t)(r_) * 6144))[lane + 64 * j]; bn[j] = ((const v2u*)(YB + (size_t)(r_) * 6144))[lane + 64 * j]; } }
    int row = gw;
    if (row < R) CMB_LOAD(row)
    while (row < R) {
        F4 s[8]; float ss = 0.f;
#pragma unroll
        for (int j = 0; j < 8; ++j) { const v2u f = fn[j], bk = bn[j];
            s[j] = (F4){bflo(f.x) + bflo(bk.x), bfhi(f.x) + bfhi(bk.x), bflo(f.y) + bflo(bk.y), bfhi(f.y) + bfhi(bk.y)};
            ss += (s[j].x * s[j].x + s[j].y * s[j].y) + (s[j].z * s[j].z + s[j].w * s[j].w); }
        const int nrow = row + NGW;
        if (nrow < R) CMB_LOAD(nrow)
        const float rstd = rsqrtf(wave_sum(ss) * (1.f / 2048.f) + 1e-6f);
#pragma unroll
        for (int j = 0; j < 8; ++j) { const F4 g = ((const F4*)A.in[15])[lane + 64 * j]; const F4 o = (s[j] * rstd) * g; v2u w; w.x = pk2(o.x, o.y); w.y = pk2(o.z, o.w);
            ((v2u*)(YN + (size_t)row * 2048))[lane + 64 * j] = w; }
        row = nrow;
    }
#undef CMB_LOAD
}

__device__ __forceinline__ void na_phase(const Args& A, lptr lds, int tid, int lane, int wave) {
    unsigned char* ws = A.ws;
    const bf16* QKV = (const bf16*)(ws + WS_G); bf16* O = (bf16*)(ws + WS_H);
    constexpr int KSR = 528, VSR = 136;
    constexpr int NABUF = 64 * KSR + 256 * VSR;
    LAS float* rp = (LAS float*)(lds + 2 * NABUF);
    const int hf = lane >> 5, l31 = lane & 31, hl = wave >> 1, qh = wave & 1;
    const int nIterNA = gridDim.x == 256 ? 4 : (1024 + (int)gridDim.x - 1) / (int)gridDim.x;
    for (int ui = 0; ui < nIterNA; ++ui) {
        int unit;
        if (gridDim.x == 256) { const int x = blockIdx.x & 7, j = blockIdx.x >> 3; unit = ((x >> 2) << 9) | ((j * 4 + ui) << 2) | (x & 3); }
        else { unit = blockIdx.x + ui * gridDim.x; if (unit >= 1024) break; }
        const int b = unit >> 9, r = (unit >> 2) & 127, hq = unit & 3;
        const int r0 = min(max(r - 4, 0), 120), hh = 4 * hq + hl;
        __syncthreads();
        for (int i = tid; i < 4 * 465; i += NT) rp[i] = A.in[18][(4 * hq) * 465 + i] * 1.4426950408889634f;
        const size_t qrow = (size_t)b * SEQ + r * 64 + 32 * qh + l31;
        B8 qf[4];
#pragma unroll
        for (int s = 0; s < 4; ++s) qf[s] = *(const B8*)(QKV + qrow * 3072 + hh * 64 + 16 * s + 8 * hf);
        const int qc = 32 * qh + l31, c0 = min(max(qc - 8, 0), 48);
        float m = -1e30f, l = 0.f; F16 o0, o1;
#pragma unroll
        for (int e = 0; e < 16; ++e) { o0[e] = 0.f; o1[e] = 0.f; }
#define NA_LOAD(it_) { const int it2_ = (it_); const size_t keybase = it2_ < 8 ? (size_t)b * SEQ + (r0 + it2_) * 64 : (size_t)NLAT + b * CTXL + (it2_ - 8) * 64; \
            _Pragma("unroll") for (int k = 0; k < 4; ++k) { const bf16* src = QKV + (keybase + 4 * kq + k) * 3072 + 1024 + hq * 256 + 8 * c8; \
                kr[k] = *(const v4u*)src; vr[k] = *(const v4u*)(src + 1024); } }
        const int kq = tid & 15, c8 = tid >> 4;
        v4u kr[4], vr[4];
#define NA_STORE(buf_) { lptr Kt_ = lds + (buf_) * NABUF; lptr VT_ = Kt_ + 64 * KSR; \
            _Pragma("unroll") for (int k = 0; k < 4; ++k) *(LAS v4u*)(Kt_ + (4 * kq + k) * KSR + c8 * 16) = kr[k]; \
            const unsigned v0[4] = {vr[0].x, vr[0].y, vr[0].z, vr[0].w}, v1[4] = {vr[1].x, vr[1].y, vr[1].z, vr[1].w}, v2[4] = {vr[2].x, vr[2].y, vr[2].z, vr[2].w}, v3[4] = {vr[3].x, vr[3].y, vr[3].z, vr[3].w}; \
            lptr vtw = VT_ + (8 * c8) * VSR + kq * 8; \
            _Pragma("unroll") for (int e = 0; e < 8; ++e) { const int q2 = e >> 1; v2u w; \
                if (e & 1) { w.x = (v0[q2] >> 16) | (v1[q2] & 0xffff0000u); w.y = (v2[q2] >> 16) | (v3[q2] & 0xffff0000u); } \
                else       { w.x = (v0[q2] & 0xffffu) | (v1[q2] << 16);     w.y = (v2[q2] & 0xffffu) | (v3[q2] << 16); } \
                *(LAS v2u*)(vtw + e * VSR) = w; } }
        NA_LOAD(0)
        NA_STORE(0)
        NA_LOAD(1)
        __syncthreads();
        for (int it = 0; it < 12; ++it) {
            lptr Kt = lds + (it & 1) * NABUF; lptr VT = Kt + 64 * KSR;
            F16 s0, s1;
#pragma unroll
            for (int e = 0; e < 16; ++e) { s0[e] = 0.f; s1[e] = 0.f; }
#pragma unroll
            for (int s = 0; s < 4; ++s) { const B8 a0 = *(const LAS B8*)(Kt + l31 * KSR + hl * 128 + s * 32 + hf * 16); const B8 a1 = *(const LAS B8*)(Kt + (32 + l31) * KSR + hl * 128 + s * 32 + hf * 16);
                s0 = __builtin_amdgcn_mfma_f32_32x32x16_bf16(a0, qf[s], s0, 0, 0, 0); s1 = __builtin_amdgcn_mfma_f32_32x32x16_bf16(a1, qf[s], s1, 0, 0, 0); }
            const int dq = it < 8 ? (qh ? 1 : 2) : 0;
            if (it < 8) {
                const LAS float* rph = rp + hl * 465 + (r0 + it - r + 7) * 31 + 15 - qc;
#pragma unroll
                for (int e = 0; e < 16; ++e) { const int k0 = rowmap(e, hf), k1 = k0 + 32;
                    if (e < 8 && dq == 1) s0[e] = -1e30f; else s0[e] = (k0 >= c0 && k0 < c0 + 16) ? s0[e] * 0.18033688011112042f + rph[k0] : -1e30f;
                    if (e >= 8 && dq == 2) s1[e] = -1e30f; else s1[e] = (k1 >= c0 && k1 < c0 + 16) ? s1[e] * 0.18033688011112042f + rph[k1] : -1e30f; }
            } else {
#pragma unroll
                for (int e = 0; e < 16; ++e) { s0[e] *= 0.18033688011112042f; s1[e] *= 0.18033688011112042f; }
            }
            float mx = -1e30f;
#pragma unroll
            for (int e = 0; e < 16; ++e) mx = fmaxf(mx, fmaxf(s0[e], s1[e]));
            mx = fmaxf(mx, __shfl_xor(mx, 32));
            const float mn = fmaxf(m, mx), alpha = __builtin_amdgcn_exp2f(m - mn); m = mn;
            float ls = 0.f;
#pragma unroll
            for (int e = 0; e < 16; ++e) { s0[e] = (e < 8 && dq == 1) ? 0.f : __builtin_amdgcn_exp2f(s0[e] - mn); s1[e] = (e >= 8 && dq == 2) ? 0.f : __builtin_amdgcn_exp2f(s1[e] - mn); ls += s0[e] + s1[e]; o0[e] *= alpha; o1[e] *= alpha; }
            l = l * alpha + ls;
#pragma unroll
            for (int kt = 0; kt < 2; ++kt)
#pragma unroll
                for (int s = 0; s < 2; ++s) {
                    if ((kt == 0 && s == 0 && dq == 1) || (kt == 1 && s == 1 && dq == 2)) continue;
                    const F16& pp = kt ? s1 : s0;
                    v4u pw; pw.x = pk2(pp[8 * s + 0], pp[8 * s + 1]); pw.y = pk2(pp[8 * s + 2], pp[8 * s + 3]); pw.z = pk2(pp[8 * s + 4], pp[8 * s + 5]); pw.w = pk2(pp[8 * s + 6], pp[8 * s + 7]);
                    const B8 pb = __builtin_bit_cast(B8, pw);
                    const int koff = (kt * 32 + 16 * s + 4 * hf) * 2;
                    { lptr vrp = VT + (hl * 64 + l31) * VSR + koff; const v2u x0 = *(const LAS v2u*)vrp, x1 = *(const LAS v2u*)(vrp + 16); const v4u aw = {x0.x, x0.y, x1.x, x1.y};
                      o0 = __builtin_amdgcn_mfma_f32_32x32x16_bf16(__builtin_bit_cast(B8, aw), pb, o0, 0, 0, 0); }
                    { lptr vrp = VT + (hl * 64 + 32 + l31) * VSR + koff; const v2u x0 = *(const LAS v2u*)vrp, x1 = *(const LAS v2u*)(vrp + 16); const v4u aw = {x0.x, x0.y, x1.x, x1.y};
                      o1 = __builtin_amdgcn_mfma_f32_32x32x16_bf16(__builtin_bit_cast(B8, aw), pb, o1, 0, 0, 0); }
                }
            if (it < 11) { NA_STORE((it + 1) & 1) if (it < 10) NA_LOAD(it + 2) }
            __syncthreads();
        }
        const float inv = 1.f / (l + __shfl_xor(l, 32));
        bf16* op = O + qrow * D + hh * 64;
#pragma unroll
        for (int gq = 0; gq < 4; ++gq) { const int dd = 8 * gq + 4 * hf;
            v2u w0; w0.x = pk2(o0[4 * gq] * inv, o0[4 * gq + 1] * inv); w0.y = pk2(o0[4 * gq + 2] * inv, o0[4 * gq + 3] * inv); *(v2u*)(op + dd) = w0;
            v2u w1; w1.x = pk2(o1[4 * gq] * inv, o1[4 * gq + 1] * inv); w1.y = pk2(o1[4 * gq + 2] * inv, o1[4 * gq + 3] * inv); *(v2u*)(op + 32 + dd) = w1; }
    }
}

__device__ __forceinline__ void sc_conv_phase(const Args& A, int gt, int NGT) {
    unsigned char* ws = A.ws;
    const bf16* P = (const bf16*)(ws + WS_G); bf16* V = (bf16*)(ws + WS_H); const float* cw = A.in[21];
    for (int it = gt; it < NLAT * 128; it += NGT) {
        const int row = it >> 7, c8 = it & 127, t = row & (SEQ - 1);
        const bf16* pr = P + (size_t)row * 3072 + 8 * c8;
        const v4u zero = {0u, 0u, 0u, 0u};
        const v4u bg = *(const v4u*)pr, cc = *(const v4u*)(pr + 1024), uc = *(const v4u*)(pr + 2048);
#ifdef CONV_NO_NEIGH
        const v4u cp = zero, up = zero, cn = zero, un = zero; (void)t;
#else
        const v4u cp = t > 0 ? *(const v4u*)(pr - 3072 + 1024) : zero, up = t > 0 ? *(const v4u*)(pr - 3072 + 2048) : zero;
        const v4u cn = t < SEQ - 1 ? *(const v4u*)(pr + 3072 + 1024) : zero, un = t < SEQ - 1 ? *(const v4u*)(pr + 3072 + 2048) : zero;
#endif
        const unsigned abg[4] = {bg.x, bg.y, bg.z, bg.w}, acc_[4] = {cc.x, cc.y, cc.z, cc.w}, auc[4] = {uc.x, uc.y, uc.z, uc.w}, acp[4] = {cp.x, cp.y, cp.z, cp.w}, aup[4] = {up.x, up.y, up.z, up.w},
                       acn[4] = {cn.x, cn.y, cn.z, cn.w}, aun[4] = {un.x, un.y, un.z, un.w};
        float o[8];
#pragma unroll
        for (int e = 0; e < 8; ++e) { const int q = e >> 1;
#define SEL(a) ((e & 1) ? bfhi(a[q]) : bflo(a[q]))
            const float v = cw[0 * D + 8 * c8 + e] * (SEL(acp) * SEL(aup)) + cw[1 * D + 8 * c8 + e] * (SEL(acc_) * SEL(auc)) + cw[2 * D + 8 * c8 + e] * (SEL(acn) * SEL(aun));
            o[e] = SEL(abg) * v;
#undef SEL
        }
        v4u w; w.x = pk2(o[0], o[1]); w.y = pk2(o[2], o[3]); w.z = pk2(o[4], o[5]); w.w = pk2(o[6], o[7]);
        *(v4u*)(V + (size_t)row * D + 8 * c8) = w;
    }
}

__device__ __forceinline__ void fn_stage2(const Args& A, lptr lds, int tid, int lane, int wave) {
    unsigned char* ws = A.ws;
    const bf16* Wc = (const bf16*)(ws + WS_G); bf16* U = (bf16*)(ws + WS_G + 64 * MiB); const bf16* D64 = (const bf16*)(ws + WS_D64); const float* TW = (const float*)(ws + WS_TW);
    constexpr int SR = 272;
    lptr Bl = lds; LAS float* twc = (LAS float*)(lds + 128 * SR);
    const int hf = lane >> 5, l31 = lane & 31;
    const int a = wave >> 2, bt = wave & 3;
    B8 fr_[8], fi_[8];
#pragma unroll
    for (int s = 0; s < 8; ++s) { fr_[s] = *(const B8*)(D64 + (size_t)(32 * a + l31) * 128 + hf * 8 + s * 16); fi_[s] = *(const B8*)(D64 + (size_t)(64 + 32 * a + l31) * 128 + hf * 8 + s * 16); }
    const int tq = tid & 15, pc = tid >> 4, comp = pc >> 4, m0 = (pc & 15) * 8;
    v4u rr[4];
#define F2_LOAD(u_) { const int u2 = (u_); const int b2 = u2 >> 10, t22 = (u2 >> 3) & 127, g2 = u2 & 7; \
        _Pragma("unroll") for (int q = 0; q < 4; ++q) rr[q] = *(const v4u*)(Wc + ((size_t)b2 * SEQ + 128 * (4 * tq + q) + t22) * 2048 + g2 * 256 + 8 * pc); }
    if ((int)blockIdx.x < 2048) F2_LOAD((int)blockIdx.x)
    for (int unit = blockIdx.x; unit < 2048; unit += gridDim.x) {
        const int b = unit >> 10, t2 = (unit >> 3) & 127, g = unit & 7;
        __syncthreads();
        { const unsigned v0[4] = {rr[0].x, rr[0].y, rr[0].z, rr[0].w}, v1[4] = {rr[1].x, rr[1].y, rr[1].z, rr[1].w}, v2[4] = {rr[2].x, rr[2].y, rr[2].z, rr[2].w}, v3[4] = {rr[3].x, rr[3].y, rr[3].z, rr[3].w};
          lptr bw = Bl + m0 * SR + (comp * 64 + 4 * tq) * 2;
#pragma unroll
          for (int e = 0; e < 8; ++e) { const int q2 = e >> 1; v2u w;
              if (e & 1) { w.x = (v0[q2] >> 16) | (v1[q2] & 0xffff0000u); w.y = (v2[q2] >> 16) | (v3[q2] & 0xffff0000u); }
              else       { w.x = (v0[q2] & 0xffffu) | (v1[q2] << 16);     w.y = (v2[q2] & 0xffffu) | (v3[q2] << 16); }
              *(LAS v2u*)(bw + e * SR) = w; } }
        if (tid < 128) twc[tid] = TW[((tid >> 1) * 128 + t2) * 2 + (tid & 1)];
        if (unit + (int)gridDim.x < 2048) F2_LOAD(unit + (int)gridDim.x)
        __syncthreads();
        F16 ar, ai;
#pragma unroll
        for (int e = 0; e < 16; ++e) { ar[e] = 0.f; ai[e] = 0.f; }
        mma_ldsB<8>(ar, fr_, Bl + bt * 32 * SR, SR, lane);
        mma_ldsB<8>(ai, fi_, Bl + bt * 32 * SR, SR, lane);
#pragma unroll
        for (int e = 0; e < 16; ++e) { const int k1 = 32 * a + rowmap(e, hf), m = bt * 32 + l31; const float cs = twc[2 * k1], sn = twc[2 * k1 + 1];
            const float ur = ar[e] * cs + ai[e] * sn, ui = ai[e] * cs - ar[e] * sn;
            bf16* dst = U + (((size_t)b * 64 + k1) * 128 + t2) * 2048 + g * 256 + m;
            dst[0] = f2bf(ur); dst[128] = f2bf(ui); }
    }
#undef F2_LOAD
}
__device__ __forceinline__ void fn_stage3(const Args& A, lptr lds, int tid, int lane, int wave) {
    unsigned char* ws = A.ws;
    const bf16* U = (const bf16*)(ws + WS_G + 64 * MiB); bf16* Fr = (bf16*)(ws + WS_H); const bf16* D128 = (const bf16*)(ws + WS_D128);
    constexpr int SR = 528;
    lptr Bl = lds;
    const int hf = lane >> 5, l31 = lane & 31;
    const int a = wave >> 1, bt0 = (wave & 1) * 2;
    B8 fa_[16];
#pragma unroll
    for (int s = 0; s < 16; ++s) fa_[s] = *(const B8*)(D128 + (size_t)(32 * a + l31) * 256 + hf * 8 + s * 16);
    v4u rr[2][4];
#define F3_LOAD(u_) { const int u2 = (u_); const int b2 = u2 >> 9, k12 = (u2 >> 3) & 63, g2 = u2 & 7; \
        _Pragma("unroll") for (int k = 0; k < 2; ++k) { const int idx = tid + NT * k, tq = idx & 31, pc = idx >> 5; \
            _Pragma("unroll") for (int q = 0; q < 4; ++q) rr[k][q] = *(const v4u*)(U + (((size_t)b2 * 64 + k12) * 128 + 4 * tq + q) * 2048 + g2 * 256 + 8 * pc); } }
    if ((int)blockIdx.x < 1024) F3_LOAD((int)blockIdx.x)
    for (int unit = blockIdx.x; unit < 1024; unit += gridDim.x) {
        const int b = unit >> 9, k1 = (unit >> 3) & 63, g = unit & 7;
        __syncthreads();
#pragma unroll
        for (int k = 0; k < 2; ++k) { const int idx = tid + NT * k, tq = idx & 31, pc = idx >> 5, comp = pc >> 4, m0 = (pc & 15) * 8;
          const unsigned v0[4] = {rr[k][0].x, rr[k][0].y, rr[k][0].z, rr[k][0].w}, v1[4] = {rr[k][1].x, rr[k][1].y, rr[k][1].z, rr[k][1].w}, v2[4] = {rr[k][2].x, rr[k][2].y, rr[k][2].z, rr[k][2].w}, v3[4] = {rr[k][3].x, rr[k][3].y, rr[k][3].z, rr[k][3].w};
          lptr bw = Bl + m0 * SR + (comp * 128 + 4 * tq) * 2;
#pragma unroll
          for (int e = 0; e < 8; ++e) { const int q2 = e >> 1; v2u w;
              if (e & 1) { w.x = (v0[q2] >> 16) | (v1[q2] & 0xffff0000u); w.y = (v2[q2] >> 16) | (v3[q2] & 0xffff0000u); }
              else       { w.x = (v0[q2] & 0xffffu) | (v1[q2] << 16);     w.y = (v2[q2] & 0xffffu) | (v3[q2] << 16); }
              *(LAS v2u*)(bw + e * SR) = w; } }
        if (unit + (int)gridDim.x < 1024) F3_LOAD(unit + (int)gridDim.x)
        __syncthreads();
        F16 c0, c1;
#pragma unroll
        for (int e = 0; e < 16; ++e) { c0[e] = 0.f; c1[e] = 0.f; }
        mma_ldsB<16>(c0, fa_, Bl + bt0 * 32 * SR, SR, lane);
        mma_ldsB<16>(c1, fa_, Bl + (bt0 + 1) * 32 * SR, SR, lane);
#pragma unroll
        for (int e = 0; e < 16; ++e) { const int k2 = 32 * a + rowmap(e, hf); bf16* dst = Fr + ((size_t)b * SEQ + k1 + 64 * k2) * D + g * 128 + bt0 * 32 + l31;
            dst[0] = f2bf(c0[e]); dst[32] = f2bf(c1[e]); }
    }
#undef F3_LOAD
}

#ifdef PROBE_L
#define PROBE_ONE(q, ptr, n) { const unsigned* rp_ = (ptr); const size_t n_ = (n); unsigned long long s = 0ull; for (size_t i = gt; i < n_; i += NGT) s += (unsigned long long)__hip_atomic_load(rp_ + i, __ATOMIC_RELAXED, __HIP_MEMORY_SCOPE_AGENT) * (unsigned long long)(2 * (i & 1023) + 1); atomicAdd(&SV[q], s); }
#define PROBE_CMP(q) { const unsigned long long cur = __hip_atomic_load(&SV[q], __ATOMIC_RELAXED, __HIP_MEMORY_SCOPE_AGENT); if (valid && cur != SV[8 + q]) fl |= (1ull << q); SV[8 + q] = cur; }
#define PROBE_RUN() { FRESH() \
            unsigned long long* SV = (unsigned long long*)(ws + 372 * MiB); \
            PROBE_ONE(0, PROBE_R0, PROBE_N0) PROBE_ONE(1, PROBE_R1, PROBE_N1) PROBE_ONE(2, PROBE_R2, PROBE_N2) PROBE_ONE(3, PROBE_R3, PROBE_N3) \
            GSYNC(); \
            if (blockIdx.x == 0 && tid == 0) { unsigned long long fl = 0ull; const bool valid = (SV[16] == 0x1234567887654321ull); \
                if (valid) fl = SV[17]; \
                PROBE_CMP(0) PROBE_CMP(1) PROBE_CMP(2) PROBE_CMP(3) \
                SV[16] = 0x1234567887654321ull; SV[17] = fl; } \
            GSYNC(); \
            const float scale = 1.f + 0.1f * (float)__hip_atomic_load(&SV[17], __ATOMIC_RELAXED, __HIP_MEMORY_SCOPE_AGENT); \
            for (int row = gw; row < NLAT; row += NGW) for (int j = 0; j < 16; ++j) A.out[(size_t)row * D + lane + 64 * j] = scale * (float)((row * 1024 + lane + 64 * j) % 977) * 0.01f; \
            return; }
#else
#define PROBE_POS -1
#define PROBE_L -1
#define PROBE_RUN() {}
#endif
__global__ void __launch_bounds__(NT, 2) mega_fwd(Args A) {
    extern __shared__ __attribute__((aligned(16))) unsigned char lds_raw[];
    cg::grid_group grid = cg::this_grid();
    lptr lds_raw_l = (lptr)lds_raw;
#ifdef TS_A
    int nts_ = 0; unsigned long long* tsb_ = (unsigned long long*)(A.ws + 373 * MiB + 524288);
    if (blockIdx.x == 0 && threadIdx.x == 0) tsb_[63] = __builtin_amdgcn_s_memrealtime();
#define TSTAMP() do { if (blockIdx.x == 0 && threadIdx.x == 0) tsb_[nts_] = __builtin_amdgcn_s_memrealtime(); ++nts_; } while (0)
#else
#define TSTAMP() do {} while (0)
#endif
    if (threadIdx.x < 4) ((volatile LAS unsigned*)(lds_raw_l + LDS_BYTES - 16))[threadIdx.x] = 0u;
    __syncthreads();
    XcdBarrier xbar = xcd_barrier_post((unsigned*)(A.ws + WS_BAR), (volatile LAS unsigned*)(lds_raw_l + LDS_BYTES - 16));
    grid.sync();
#define GSYNC() do { xcd_barrier(xbar); TSTAMP(); } while (0)
    lptr lds = (lptr)lds_raw;
    const int G = gridDim.x, NGW = G * NWAVES, NGT = G * NT;
#define FRESH() int tid = threadIdx.x; asm volatile("" : "+v"(tid)); const int lane = tid & 63, wave = __builtin_amdgcn_readfirstlane(tid >> 6); const int gw = blockIdx.x * NWAVES + wave, gt = blockIdx.x * NT + tid; (void)gw; (void)gt; (void)lane;
    unsigned char* ws = A.ws;
    const float* MV = (const float*)(ws + WS_MV);
    bf16* XS = (bf16*)(ws + WS_XS); bf16* H = (bf16*)(ws + WS_H); bf16* Y = (bf16*)(ws + WS_Y); bf16* GB = (bf16*)(ws + WS_G);
    const float* norm_g = A.in[6];


#ifndef NO_P0
    { FRESH() p0_prologue(A, lds, tid, lane, wave, 0); }
#ifdef PROBE_L
    if (blockIdx.x == 0 && threadIdx.x < 8) ((unsigned long long*)(ws + 372 * MiB))[threadIdx.x] = 0ull;
#endif
#endif

    GSYNC();
    { FRESH() RowArgs ra{nullptr, A.in[0], A.in[2], nullptr, nullptr, nullptr, nullptr, nullptr, nullptr, H, norm_g, MV, MV + 1024, R}; rowpass(ra, gw, NGW, lane);
      p0_prologue(A, lds, tid, lane, wave, 1); }
    GSYNC();

#pragma unroll 1
#ifndef NLAYERS
#define NLAYERS 4
#endif
    for (int L = 0; L < NLAYERS; ++L) {
        const float* MVL = MV + (size_t)L * 3 * 6144; const float* gL = norm_g + L * 4 * D;
        const int M = (L == 0) ? R : NLAT;
#ifdef SKIPMIX_L
        const bool skipmix = (L == SKIPMIX_L);
#else
        const bool skipmix = false;
#endif
        if (skipmix) {} else
        if (L == 0) {
            pg8::Gemm g{H, (const bf16*)(ws + WS_SSDIN), R, 6400, 1024}; pg8::StaticOrder S; S.init(R, 6400, G, (int)blockIdx.x);
            pg8::EpiSsdIn E{(bf16*)(ws + WS_ZX), (float*)(ws + WS_DT), A.in[12]};

#ifndef NO_GSSD
            pg8::gemm_phase<pg8::EpiSsdIn, pg8::StaticOrder, true, true>(lds, g, S, E);
#endif

        } else {
            pg8::Gemm g; pg8::EpiStore<0> E;
            if (L == 1) { g = pg8::Gemm{H, (const bf16*)(ws + WS_QKVW), R, 3072, 1024}; E = pg8::EpiStore<0>{GB, 3072}; }
            else if (L == 2) { g = pg8::Gemm{H, (const bf16*)(ws + WS_SCIN), NLAT, 3072, 1024}; E = pg8::EpiStore<0>{GB, 3072}; }
            else { g = pg8::Gemm{H, (const bf16*)(ws + WS_CST), NLAT * 8, 256, 128}; E = pg8::EpiStore<0>{GB, 256}; }
            pg8::StaticOrder S; S.init(g.M, g.N, G, (int)blockIdx.x);

#ifndef NO_GIN
            pg8::gemm_phase<pg8::EpiStore<0>, pg8::StaticOrder, true, true>(lds, g, S, E);
#endif

        }
        GSYNC();
#ifdef PROBE_L
        if (PROBE_POS == 0 && L == PROBE_L) PROBE_RUN()
#endif
#ifdef DUMP_P_L
        if (L == DUMP_P_L) { FRESH() const bf16* Pp = (const bf16*)(ws + DUMP_SRC) + DUMP_COL0;
            for (int row = gw; row < NLAT; row += NGW) for (int j = 0; j < 16; ++j) { const size_t ei = (size_t)row * DUMP_LD + lane + 64 * j; const unsigned wv = __hip_atomic_load((const unsigned*)Pp + (ei >> 1), __ATOMIC_RELAXED, __HIP_MEMORY_SCOPE_AGENT);
                A.out[(size_t)row * D + lane + 64 * j] = row < DUMP_ROWS ? ((ei & 1) ? bfhi(wv) : bflo(wv)) : 0.f; }
            return; }
#endif
        const bf16* oA = H; const bf16* oB; int oK = 1024;
        if (L == 0) {

#ifndef NO_SCAN
#ifdef SCAN_DELAY
            for (int q_ = 0; q_ < SCAN_DELAY; ++q_) __builtin_amdgcn_s_sleep(64);
            GSYNC();
#endif
            { FRESH() ssd_act_phase(A, gt, NGT); }
            GSYNC();
            { FRESH() ssd_scan_phase(A, lds, tid, lane, wave); }
            GSYNC();
            { FRESH() ssd_corr_phase(A, lds, tid, lane, wave); }
#endif

            GSYNC();
        if (PROBE_POS == 1 && L == PROBE_L) PROBE_RUN()


#ifndef NO_COMB
            { FRESH() ssd_combine(A, gw, NGW, lane); }
#endif

            GSYNC();
        if (PROBE_POS == 2 && L == PROBE_L) PROBE_RUN()

            oA = (const bf16*)(ws + WS_YN); oB = (const bf16*)(ws + WS_SSDOUT); oK = 2048;
        } else if (L == 1) {

#ifndef NO_NA
            { FRESH() na_phase(A, lds, tid, lane, wave); }
#endif

            GSYNC();
            oB = (const bf16*)(ws + WS_NAOUT);
        } else if (L == 2) {
            if (!skipmix)
#ifndef NO_CONV
            { FRESH() sc_conv_phase(A, gt, NGT); }
#endif

            GSYNC();
            oB = (const bf16*)(ws + WS_SCOUT);
        } else {

#ifndef NO_F2
            { FRESH() fn_stage2(A, lds, tid, lane, wave); }
#endif

            GSYNC();

#ifndef NO_F3
            { FRESH() fn_stage3(A, lds, tid, lane, wave); }
#endif

            GSYNC();
            oB = (const bf16*)(ws + WS_FNW);
        }
#pragma unroll 1
        for (int half = 0; half < 2; ++half) {
            if (half == 1) {
                const bf16* w1 = (const bf16*)(ws + (L == 0 ? WS_W1_0 : WS_W1L + (size_t)(L - 1) * 8 * MiB));
                pg8::Gemm g{H, w1, M, FF, 1024}; pg8::StaticOrder S; S.init(M, FF, G, (int)blockIdx.x); pg8::EpiStore<1> E{GB, FF};
#ifndef NO_MLP1
                pg8::gemm_phase<pg8::EpiStore<1>, pg8::StaticOrder, true, true>(lds, g, S, E);
#endif
                GSYNC();
            }
            const bf16* gA = half ? (const bf16*)GB : oA;
            const bf16* gB = half ? (const bf16*)(ws + (L == 0 ? WS_W2_0 : WS_W2L + (size_t)(L - 1) * 8 * MiB)) : oB;
            const int gK = half ? FF : oK;
            const float* gate = MVL + (half ? 5 : 2) * 1024; const float* gY = gL + (half ? 3 : 1) * D;
            const float* gH = gL + (half ? 4 : 2) * D; const float* shf = half ? MVL + 3 * 6144 : MVL + 3 * 1024; const float* scl = half ? MVL + 3 * 6144 + 1024 : MVL + 4 * 1024;
            const bool last = (L == 3 && half == 1);
            if (L == 0 || G != 256) {
                bf16* YP = (bf16*)(ws + 378 * MiB);
#pragma unroll 1
                for (int part = 0; part < (L == 0 ? 2 : 1); ++part) {
                  pg8::Gemm g{gA, gB, part ? R : NLAT, 1024, part ? gK / 4 : gK, gK}; pg8::StaticOrder S; S.init(g.M, 1024, G, (int)blockIdx.x); S.split = part; S.kbytes = (gK / 4) * 2;
                  pg8::EpiStore<0> E{part ? YP : Y, 1024, part ? (size_t)512 * 1024 : (size_t)0, part ? NLAT : 0};
#ifndef NO_GOUT
                  pg8::gemm_phase<pg8::EpiStore<0>, pg8::StaticOrder, true, true>(lds, g, S, E);
#endif
                }
                GSYNC();
                { FRESH() RowArgs ra{L == 0 ? YP : nullptr, (L == 0 && !half) ? A.in[0] : nullptr, (L == 0 && !half) ? A.in[2] : nullptr, XS, Y, gate, gY, last ? A.out : nullptr, last ? nullptr : XS, last ? nullptr : H, gH, shf, scl, M};
                  rowpass(ra, gw, NGW, lane);
                  if (L == 0 && half == 0) late_weights(A, lds, lane, wave); }
                if (!last) GSYNC();
            } else {
                const int bank = (((L - 1) * 2 + half) * 2);
                unsigned* cnt0 = (unsigned*)(ws + WS_BAR + 65536) + (size_t)bank * 4096; float* sl0 = (float*)(ws + 374 * MiB) + (size_t)bank * 65536;
                pg8::Gemm g{gA, gB, NLAT, 1024, gK}; pg8::StaticOrder S; S.init(NLAT, 1024, G, (int)blockIdx.x);
                pg8::EpiRowFuse E{XS, last ? A.out : nullptr, last ? nullptr : H, gate, gY, gH, shf, scl, pg8::RowStat{sl0, cnt0}, pg8::RowStat{sl0 + 65536, cnt0 + 4096}};
#ifndef NO_MLP2
                pg8::gemm_phase<pg8::EpiRowFuse, pg8::StaticOrder, false, true>(lds, g, S, E);
#endif
                if (!last) GSYNC();
            }
        }
    }
#ifdef TS_A
    GSYNC();
    { const float us_a = 0.01f * (float)(long long)(__hip_atomic_load(&tsb_[TS_B], __ATOMIC_RELAXED, __HIP_MEMORY_SCOPE_AGENT) - __hip_atomic_load(&tsb_[TS_A], __ATOMIC_RELAXED, __HIP_MEMORY_SCOPE_AGENT));
      const float us_c = 0.01f * (float)(long long)(__hip_atomic_load(&tsb_[TS_D], __ATOMIC_RELAXED, __HIP_MEMORY_SCOPE_AGENT) - __hip_atomic_load(&tsb_[TS_C], __ATOMIC_RELAXED, __HIP_MEMORY_SCOPE_AGENT));
      const bool warm_ = (__hip_atomic_load(&tsb_[62], __ATOMIC_RELAXED, __HIP_MEMORY_SCOPE_AGENT) == 0x5555aaaa12345678ull);
      const float sc_ = warm_ ? 1.f + us_a * (1.f / 2000.f) : 1.f; (void)us_c;
      for (size_t i = (size_t)blockIdx.x * NT + threadIdx.x; i < (size_t)NLAT * D; i += (size_t)gridDim.x * NT) { float v = A.out[i] * sc_; A.out[i] = v; } }
    GSYNC();
    if (blockIdx.x == 0 && threadIdx.x == 0) tsb_[62] = 0x5555aaaa12345678ull;
#endif
#if NLAYERS < 4
    { FRESH() for (int row = gw; row < NLAT; row += NGW) for (int j = 0; j < 4; ++j) ((F4*)(A.out + (size_t)row * D))[lane + 64 * j] = ((const F4*)(XS + (size_t)row * D))[lane + 64 * j]; }
#endif
}

extern "C" void kernel_launch(void* const* d_in, const int* in_sizes, int n_in, void* d_out, int out_size, void* d_ws, size_t ws_size, hipStream_t stream) {
    static int grid = 0;
    if (grid == 0) {
        if (n_in != 24 || ws_size < (size_t)382 * MiB) { fprintf(stderr, "kernel_launch: need 24 inputs and %zu bytes of workspace (got %d, %zu)\n", (size_t)WS_END, n_in, ws_size); grid = -1; return; }
        int dev = 0, cus = 0, per_cu = 0;
        hipGetDevice(&dev); hipDeviceGetAttribute(&cus, hipDeviceAttributeMultiprocessorCount, dev);
        if (hipFuncSetAttribute((const void*)mega_fwd, hipFuncAttributeMaxDynamicSharedMemorySize, LDS_BYTES) != hipSuccess) { fprintf(stderr, "kernel_launch: hipFuncSetAttribute failed\n"); grid = -1; return; }
        if (hipOccupancyMaxActiveBlocksPerMultiprocessor(&per_cu, (const void*)mega_fwd, NT, LDS_BYTES) != hipSuccess || per_cu < 1) { fprintf(stderr, "kernel_launch: occupancy query says %d\n", per_cu); per_cu = 1; }
        (void)hipGetLastError();
        grid = cus;
    }
    if (grid < 0) return;
    if (hipMemsetAsync((char*)d_ws + WS_BAR, 0, 262144, stream) != hipSuccess) { fprintf(stderr, "kernel_launch: memset failed\n"); return; }
    Args a{};
    for (int i = 0; i < 24; ++i) a.in[i] = (const float*)d_in[i];
    a.out = (float*)d_out; a.ws = (unsigned char*)d_ws;
    void* args[] = {&a};
    hipError_t e = hipLaunchCooperativeKernel((const void*)mega_fwd, dim3(grid), dim3(NT), args, LDS_BYTES, stream);
    if (e != hipSuccess) fprintf(stderr, "cooperative launch failed: %s (grid %d)\n", hipGetErrorString(e), grid);
}
```

```cpp
#include <hip/hip_runtime.h>
#include <hip/hip_cooperative_groups.h>
#include <cstdio>
#include <cstdint>
namespace cg = cooperative_groups;
namespace pg8 {
#define PG8_LAS __attribute__((address_space(3)))
typedef unsigned short bf16_t;
typedef short bf16x8 __attribute__((ext_vector_type(8)));
typedef float f32x4 __attribute__((ext_vector_type(4)));
typedef unsigned u32x4 __attribute__((ext_vector_type(4)));
constexpr int BM = 256, BK = 64, HALF = 128, HTB = HALF * BK * 2  , STAGE_BYTES = 8 * HTB, NXCD = 8, WGM = 4;

__host__ __device__ __forceinline__ int lds_byte(int r, int c) { const int st = (r >> 4) * 2 + (c >> 5), rr = r & 15, cc = c & 31, ob = rr * 64 + cc * 2; return st * 1024 + (ob ^ (((ob >> 9) & 1) << 5)); }
__host__ __device__ __forceinline__ void stage_rc(int b, int& R, int& C) { const int st = b / 1024, sb = b % 1024, swz = sb ^ (((sb >> 9) & 1) << 5); R = (st >> 1) * 16 + swz / 64; C = (st & 1) * 32 + (swz % 64) / 2; }
__host__ __device__ __forceinline__ int perm32(int rho) { const int n = rho >> 4, i = rho & 15; return 8 * (i >> 2) + 4 * n + (i & 3); }

struct Unit { int pm, pn, ko, ks; };
struct Gemm { const bf16_t* A; const bf16_t* Bt; int M, N, K, ld; };

struct StaticOrder {
    int nM, nN, nwg, G, c, split, kbytes;
    __host__ __device__ void init(int M, int N, int G_, int c_) { nM = M / BM; nN = N / BM; nwg = nM * nN; G = G_; c = c_; split = 0; kbytes = 0; }
    __host__ __device__ bool next(int i, Unit& u) const {
        const long L = (long)i * G + c;
        if (split) { if (L >= 32) return false; const int t = (int)L >> 2; u.ks = (int)L & 3; u.ko = u.ks * kbytes; u.pm = 64 + (t >> 2); u.pn = t & 3; return true; }
        if (L >= nwg) return false;
        u.ko = 0; u.ks = 0;
        int wgid = (int)L; { const int q = nwg / NXCD, r = nwg % NXCD, xcd = wgid % NXCD, off = wgid / NXCD; wgid = (xcd < r ? xcd * (q + 1) : r * (q + 1) + (xcd - r) * q) + off; }
        const int nig = WGM * nN, gid = wgid / nig, fm = gid * WGM, gsz = (nM - fm) < WGM ? (nM - fm) : WGM;
        u.pm = fm + ((wgid % nig) % gsz); u.pn = (wgid % nig) / gsz; return true;
    }
    __device__ __forceinline__ void a_ready(const Unit&) const {}
    __device__ __forceinline__ void done(const Unit&) const {}
};

typedef float f32x2_cv __attribute__((ext_vector_type(2))); typedef __bf16 bf16x2_cv __attribute__((ext_vector_type(2)));
__device__ __forceinline__ unsigned cvt_pk_bf16(float lo, float hi) { const f32x2_cv v = {lo, hi}; const bf16x2_cv b = __builtin_convertvector(v, bf16x2_cv); return __builtin_bit_cast(unsigned, b); }
typedef float f32x2 __attribute__((ext_vector_type(2)));
template <int ACT> struct EpiStore {
    static constexpr bool PERM = true, AFTER_DRAIN = false;
    bf16_t* O; int ldc; size_t kstride; int rowsub;
    __device__ __forceinline__ void operator()(const f32x4 (&acc)[2][2][4][2], const Unit& u, int wr, int wc, int fr, int fq) const {
        bf16_t* O = this->O + (size_t)u.ks * kstride;
        const int row0 = u.pm * BM + wr * 64 + fr - rowsub; const int col0 = u.pn * BM + wc * 32 + 8 * fq;
#pragma unroll
        for (int ai = 0; ai < 2; ++ai)
#pragma unroll
            for (int m = 0; m < 4; ++m) { bf16_t* rowp = O + (size_t)(row0 + ai * HALF + m * 16) * ldc + col0;
#pragma unroll
                for (int bj = 0; bj < 2; ++bj) { f32x4 v0 = acc[ai][bj][m][0], v1 = acc[ai][bj][m][1];
                    if (ACT == 1) {
#pragma unroll
                        for (int e = 0; e < 4; ++e) { float a = v0[e] > 0.f ? v0[e] : 0.f; v0[e] = a * a; float b = v1[e] > 0.f ? v1[e] : 0.f; v1[e] = b * b; } }
                    u32x4 w; w.x = cvt_pk_bf16(v0[0], v0[1]); w.y = cvt_pk_bf16(v0[2], v0[3]); w.z = cvt_pk_bf16(v1[0], v1[1]); w.w = cvt_pk_bf16(v1[2], v1[3]);
                    *(u32x4*)(rowp + bj * HALF) = w; } }
    }
};
struct EpiSsdIn {
    static constexpr bool PERM = true, AFTER_DRAIN = false;
    bf16_t* ZX; float* DT; const float* dt_bias;
    __device__ __forceinline__ void operator()(const f32x4 (&acc)[2][2][4][2], const Unit& u, int wr, int wc, int fr, int fq) const {
        const int row0 = u.pm * BM + wr * 64 + fr;
        if (u.pn < 24) {
            const int col0 = u.pn * BM + wc * 32 + 8 * fq;
#pragma unroll
            for (int ai = 0; ai < 2; ++ai)
#pragma unroll
                for (int m = 0; m < 4; ++m) { bf16_t* rowp = ZX + (size_t)(row0 + ai * HALF + m * 16) * 6144 + col0;
#pragma unroll
                    for (int bj = 0; bj < 2; ++bj) { const f32x4 v0 = acc[ai][bj][m][0], v1 = acc[ai][bj][m][1];
                        u32x4 w; w.x = cvt_pk_bf16(v0[0], v0[1]); w.y = cvt_pk_bf16(v0[2], v0[3]); w.z = cvt_pk_bf16(v1[0], v1[1]); w.w = cvt_pk_bf16(v1[2], v1[3]);
                        *(u32x4*)(rowp + bj * HALF) = w; } }
        } else if (wc < 2) {
            const int col0 = wc * 32 + 8 * fq;
#pragma unroll
            for (int ai = 0; ai < 2; ++ai)
#pragma unroll
                for (int m = 0; m < 4; ++m) { float* rowp = DT + (size_t)(row0 + ai * HALF + m * 16) * 64 + col0;
#pragma unroll
                    for (int n = 0; n < 2; ++n) { f32x4 v = acc[ai][0][m][n]; f32x4 o;
#pragma unroll
                        for (int e = 0; e < 4; ++e) o[e] = v[e];
                        *(f32x4*)(rowp + 4 * n) = o; } }
        }
    }
};

struct RowStat {
    float* slots; unsigned* cnt;
    __device__ __forceinline__ void run(const f32x4 (&v)[2][2][4][2], const Unit& u, int wr, int wc, int fr, int fq, PG8_LAS unsigned char* lds, int tid, int lane) const {
        PG8_LAS float* P = (PG8_LAS float*)lds;
        PG8_LAS float* S = (PG8_LAS float*)(lds + 4096);
#pragma unroll
        for (int ai = 0; ai < 2; ++ai)
#pragma unroll
            for (int m = 0; m < 4; ++m) { float q = 0.f;
#pragma unroll
                for (int bj = 0; bj < 2; ++bj)
#pragma unroll
                    for (int n = 0; n < 2; ++n) { const f32x4 x = v[ai][bj][m][n]; q += (x[0] * x[0] + x[1] * x[1]) + (x[2] * x[2] + x[3] * x[3]); }
                q += __shfl_xor(q, 16); q += __shfl_xor(q, 32);
                if (fq == 0) P[(ai * HALF + wr * 64 + m * 16 + fr) * 4 + wc] = q; }
        asm volatile("s_waitcnt lgkmcnt(0)" ::: "memory"); __builtin_amdgcn_s_barrier(); asm volatile("" ::: "memory");
        if (tid < 256) { const float q = (P[tid * 4 + 0] + P[tid * 4 + 1]) + (P[tid * 4 + 2] + P[tid * 4 + 3]);
            __hip_atomic_store(slots + (size_t)(u.pm * BM + tid) * 4 + u.pn, q, __ATOMIC_RELAXED, __HIP_MEMORY_SCOPE_AGENT);
            asm volatile("s_waitcnt vmcnt(0)" ::: "memory");
            if (lane == 0) __hip_atomic_fetch_add(cnt + 64 * u.pm, 1u, __ATOMIC_RELAXED, __HIP_MEMORY_SCOPE_AGENT); }
        if (tid < 64) { while ((unsigned)__builtin_amdgcn_readfirstlane(__hip_atomic_load(cnt + 64 * u.pm, __ATOMIC_RELAXED, __HIP_MEMORY_SCOPE_AGENT)) < 16u) __builtin_amdgcn_s_sleep(1);
            __builtin_amdgcn_fence(__ATOMIC_ACQUIRE, "agent"); }
        asm volatile("s_waitcnt vmcnt(0) lgkmcnt(0)" ::: "memory"); __builtin_amdgcn_s_barrier(); asm volatile("" ::: "memory");
        if (tid < 256) { const float* sl = slots + (size_t)(u.pm * BM + tid) * 4; float q = 0.f;
#pragma unroll
            for (int t4 = 0; t4 < 4; ++t4) q += __hip_atomic_load(sl + t4, __ATOMIC_RELAXED, __HIP_MEMORY_SCOPE_AGENT);
            S[tid] = rsqrtf(q * (1.f / 1024.f) + 1e-6f); }
        asm volatile("s_waitcnt vmcnt(0) lgkmcnt(0)" ::: "memory"); __builtin_amdgcn_s_barrier(); asm volatile("" ::: "memory");
    }
};
struct EpiRowFuse {
    static constexpr bool PERM = false, AFTER_DRAIN = true;
    bf16_t* XS; float* outF; bf16_t* H;
    const float* gate; const float* gY; const float* gH; const float* shift; const float* scale;
    RowStat st1, st2;
    __device__ __forceinline__ void fused(f32x4 (&acc)[2][2][4][2], const Unit& u, int wr, int wc, int fr, int fq, PG8_LAS unsigned char* lds, int wid, int lane) const {
        const int tid = wid * 64 + lane; const int set = u.pm >= 32 ? 1 : 0;
        const PG8_LAS float* S = (const PG8_LAS float*)(lds + 4096);
        const int col0 = u.pn * BM + wc * 32 + 4 * fq;
        st1.run(acc, u, wr, wc, fr, fq, lds, tid, lane);
        typedef unsigned u32x2v __attribute__((ext_vector_type(2)));
#pragma unroll
        for (int bj = 0; bj < 2; ++bj)
#pragma unroll
            for (int n = 0; n < 2; ++n) { const int c = col0 + bj * HALF + n * 16;
                const f32x4 g4 = *(const f32x4*)(gate + set * 6144 + c), gy = *(const f32x4*)(gY + c);
#pragma unroll
                for (int ai = 0; ai < 2; ++ai)
#pragma unroll
                    for (int m = 0; m < 4; ++m) { const int r = ai * HALF + wr * 64 + m * 16 + fr; const size_t off = (size_t)(u.pm * BM + r) * 1024 + c;
                        const u32x2v w = *(const u32x2v*)(XS + off);
                        f32x4 t; t[0] = __builtin_bit_cast(float, w.x << 16); t[1] = __builtin_bit_cast(float, w.x & 0xffff0000u); t[2] = __builtin_bit_cast(float, w.y << 16); t[3] = __builtin_bit_cast(float, w.y & 0xffff0000u);
                        t = t + g4 * ((acc[ai][bj][m][n] * S[r]) * gy);
                        if (outF) { *(f32x4*)(outF + off) = t; }
                        else { u32x2v o; o.x = cvt_pk_bf16(t[0], t[1]); o.y = cvt_pk_bf16(t[2], t[3]); *(u32x2v*)(XS + off) = o;
                            t[0] = __builtin_bit_cast(float, o.x << 16); t[1] = __builtin_bit_cast(float, o.x & 0xffff0000u); t[2] = __builtin_bit_cast(float, o.y << 16); t[3] = __builtin_bit_cast(float, o.y & 0xffff0000u); }
                        acc[ai][bj][m][n] = t; } }
        if (H) {
            st2.run(acc, u, wr, wc, fr, fq, lds, tid, lane);
#pragma unroll
            for (int bj = 0; bj < 2; ++bj)
#pragma unroll
                for (int n = 0; n < 2; ++n) { const int c = col0 + bj * HALF + n * 16;
                    const f32x4 g = *(const f32x4*)(gH + c), sh = *(const f32x4*)(shift + set * 6144 + c), sc = *(const f32x4*)(scale + set * 6144 + c);
#pragma unroll
                    for (int ai = 0; ai < 2; ++ai)
#pragma unroll
                        for (int m = 0; m < 4; ++m) { const int r = ai * HALF + wr * 64 + m * 16 + fr; const size_t off = (size_t)(u.pm * BM + r) * 1024 + c;
                            const f32x4 hv = ((acc[ai][bj][m][n] * S[r]) * g) * (sc + 1.f) + sh;
                            u32x2v o; o.x = cvt_pk_bf16(hv[0], hv[1]); o.y = cvt_pk_bf16(hv[2], hv[3]); *(u32x2v*)(H + off) = o; } }
        }
    }
};
#ifndef PG8_AUX
#define PG8_AUX 0
#endif

template <class Epi, class Sched, bool ALIGN_EPI = false, bool SP2 = false>
__device__ __forceinline__ void gemm_phase(PG8_LAS unsigned char* lds, const Gemm g, const Sched& S, const Epi& E) {
    int tid_l = threadIdx.x; asm volatile("" : "+v"(tid_l)); const int tid = tid_l, wid = __builtin_amdgcn_readfirstlane(tid >> 6), lane = tid & 63, wr = wid >> 2, wc = wid & 3, fr = lane & 15, fq = lane >> 4;
    const int K = g.K, nt = K / BK, LD = g.ld ? g.ld : g.K;
    unsigned voffA[2], voffB[2];
#pragma unroll
    for (int i = 0; i < 2; ++i) { int R, C; stage_rc(tid * 16 + i * 8192, R, C); const int Rb = Epi::PERM ? ((R & ~31) + perm32(R & 31)) : R;
        voffA[i] = (unsigned)(R * LD + C) * 2u; voffB[i] = (unsigned)(Rb * LD + C) * 2u; }
    const size_t kstep = (size_t)(BK * 2);
    const size_t hstep = (size_t)HALF * LD * 2;
    const size_t tstep = 2 * hstep;
    const unsigned ldsw = (unsigned)wid * 1024u;
    const int aoff = lds_byte(wr * 64 + fr, fq * 8), boff = lds_byte(wc * 32 + fr, fq * 8);
#define PG8_SA(b, h) (((b) * 2 + (h)) * HTB)
#define PG8_SB(b, h) ((4 + (b) * 2 + (h)) * HTB)
#define PG8_STAGE(bufoff, gbase, voff) do { _Pragma("unroll") for (int _i = 0; _i < 2; ++_i) \
        __builtin_amdgcn_global_load_lds((const unsigned*)((const char*)(gbase) + (voff)[_i]), (PG8_LAS unsigned*)(lds + (bufoff) + ldsw + _i * 8192), 16, 0, PG8_AUX); } while (0)
#define PG8_LDA(dst, b, h) do { _Pragma("unroll") for (int m = 0; m < 4; ++m) _Pragma("unroll") for (int k = 0; k < 2; ++k) dst[m][k] = *(const PG8_LAS bf16x8*)(lds + PG8_SA(b, h) + aoff + m * 2048 + k * 1024); } while (0)
#define PG8_LDB(dst, b, h) do { _Pragma("unroll") for (int n = 0; n < 2; ++n) _Pragma("unroll") for (int k = 0; k < 2; ++k) dst[n][k] = *(const PG8_LAS bf16x8*)(lds + PG8_SB(b, h) + boff + n * 2048 + k * 1024); } while (0)
#define PG8_MMA(ai, bj, At, Bt) do { __builtin_amdgcn_s_setprio(1); _Pragma("unroll") for (int m = 0; m < 4; ++m) _Pragma("unroll") for (int n = 0; n < 2; ++n) _Pragma("unroll") for (int k = 0; k < 2; ++k) \
        acc[ai][bj][m][n] = __builtin_amdgcn_mfma_f32_16x16x32_bf16(Bt[n][k], At[m][k], acc[ai][bj][m][n], 0, 0, 0); __builtin_amdgcn_s_setprio(0); } while (0)
#define PG8_WAIT_V(n) asm volatile("s_waitcnt vmcnt(" #n ")" ::: "memory")
#define PG8_WAIT_L(n) asm volatile("s_waitcnt lgkmcnt(" #n ")" ::: "memory")
#define PG8_BAR __builtin_amdgcn_s_barrier()
#define PG8_SCHED __builtin_amdgcn_sched_barrier(0)
    Unit cur, nxt; int ui = 0;
    if (!S.next(0, cur)) return;
    f32x4 acc[2][2][4][2];
#pragma unroll
    for (int a = 0; a < 2; ++a)
#pragma unroll
        for (int b = 0; b < 2; ++b)
#pragma unroll
            for (int m = 0; m < 4; ++m)
#pragma unroll
                for (int n = 0; n < 2; ++n) acc[a][b][m][n] = (f32x4){0.f, 0.f, 0.f, 0.f};
    bf16x8 At[4][2], B0[2][2], B1[2][2];
    const char* cA = (const char*)g.A + (size_t)cur.pm * tstep + cur.ko; const char* cB = (const char*)g.Bt + (size_t)cur.pn * tstep + cur.ko;
    S.a_ready(cur);
    if constexpr (SP2) {
        PG8_STAGE(PG8_SB(0, 0), cB, voffB); PG8_STAGE(PG8_SB(0, 1), cB + hstep, voffB); PG8_STAGE(PG8_SA(0, 0), cA, voffA); PG8_STAGE(PG8_SA(0, 1), cA + hstep, voffA);
        if (wr == 1) PG8_BAR;
        PG8_WAIT_V(2); PG8_BAR;
        PG8_STAGE(PG8_SB(1, 0), cB + kstep, voffB); PG8_STAGE(PG8_SA(1, 0), cA + kstep, voffA); PG8_STAGE(PG8_SB(1, 1), cB + hstep + kstep, voffB);
        PG8_WAIT_V(6); PG8_BAR;
    } else {
        PG8_STAGE(PG8_SB(0, 0), cB, voffB); PG8_STAGE(PG8_SA(0, 0), cA, voffA); PG8_STAGE(PG8_SB(0, 1), cB + hstep, voffB); PG8_STAGE(PG8_SA(0, 1), cA + hstep, voffA);
        if (wr == 1) PG8_BAR;
        PG8_WAIT_V(4); PG8_BAR;
        PG8_STAGE(PG8_SB(1, 0), cB + kstep, voffB); PG8_STAGE(PG8_SA(1, 0), cA + kstep, voffA); PG8_STAGE(PG8_SB(1, 1), cB + hstep + kstep, voffB);
        PG8_WAIT_V(6); PG8_BAR;
    }
    for (;;) {
        const bool has_next = S.next(ui + 1, nxt);
        const char* nA = has_next ? (const char*)g.A + (size_t)nxt.pm * tstep + nxt.ko : cA; const char* nB = has_next ? (const char*)g.Bt + (size_t)nxt.pn * tstep + nxt.ko : cB;
        for (int t = 0; t < nt; t += 2) {
            const bool last = (t == nt - 2);
            const char* a1 = cA + (size_t)(t + 1) * kstep;
            const char* a2 = last ? nA : cA + (size_t)(t + 2) * kstep; const char* b2 = last ? nB : cB + (size_t)(t + 2) * kstep;
            const char* a3 = a2 + kstep; const char* b3 = b2 + kstep;
            if (last && has_next) S.a_ready(nxt);
            if constexpr (SP2) {
            PG8_LDB(B0, 0, 0); PG8_LDB(B1, 0, 1); PG8_SCHED; PG8_LDA(At, 0, 0); PG8_STAGE(PG8_SA(1, 1), a1 + hstep, voffA);
            PG8_WAIT_V(8); PG8_WAIT_L(0); PG8_BAR; PG8_MMA(0, 0, At, B0); PG8_MMA(0, 1, At, B1); PG8_BAR; PG8_SCHED;
            PG8_LDA(At, 0, 1); PG8_STAGE(PG8_SB(0, 0), b2, voffB); PG8_STAGE(PG8_SB(0, 1), b2 + hstep, voffB); PG8_STAGE(PG8_SA(0, 0), a2, voffA);
            PG8_WAIT_V(8); PG8_WAIT_L(0); PG8_BAR; PG8_MMA(1, 0, At, B0); PG8_MMA(1, 1, At, B1); PG8_BAR; PG8_SCHED;
            PG8_LDB(B0, 1, 0); PG8_LDB(B1, 1, 1); PG8_SCHED; PG8_LDA(At, 1, 0); PG8_STAGE(PG8_SA(0, 1), a2 + hstep, voffA);
            PG8_WAIT_V(8); PG8_WAIT_L(0); PG8_BAR; PG8_MMA(0, 0, At, B0); PG8_MMA(0, 1, At, B1); PG8_BAR; PG8_SCHED;
            PG8_LDA(At, 1, 1); PG8_STAGE(PG8_SB(1, 0), b3, voffB); PG8_STAGE(PG8_SB(1, 1), b3 + hstep, voffB); PG8_STAGE(PG8_SA(1, 0), a3, voffA);
            PG8_WAIT_V(8); PG8_WAIT_L(0); PG8_BAR; PG8_MMA(1, 0, At, B0); PG8_MMA(1, 1, At, B1); PG8_BAR; PG8_SCHED;
            } else {
            PG8_LDB(B0, 0, 0); PG8_SCHED; PG8_LDA(At, 0, 0); PG8_STAGE(PG8_SA(1, 1), a1 + hstep, voffA);
            PG8_WAIT_L(8); PG8_BAR; PG8_WAIT_L(0); PG8_MMA(0, 0, At, B0); PG8_BAR; PG8_SCHED;
            PG8_LDB(B1, 0, 1); PG8_STAGE(PG8_SB(0, 0), b2, voffB);
            PG8_BAR; PG8_WAIT_L(0); PG8_MMA(0, 1, At, B1); PG8_BAR;
            PG8_LDA(At, 0, 1); PG8_STAGE(PG8_SA(0, 0), a2, voffA);
            PG8_BAR; PG8_WAIT_L(0); PG8_MMA(1, 0, At, B0); PG8_BAR; PG8_SCHED;
            PG8_STAGE(PG8_SB(0, 1), b2 + hstep, voffB);
            PG8_WAIT_V(6); PG8_BAR; PG8_MMA(1, 1, At, B1); PG8_BAR;
            PG8_LDB(B0, 1, 0); PG8_SCHED; PG8_LDA(At, 1, 0); PG8_STAGE(PG8_SA(0, 1), a2 + hstep, voffA);
            PG8_WAIT_L(8); PG8_BAR; PG8_WAIT_L(0); PG8_MMA(0, 0, At, B0); PG8_BAR; PG8_SCHED;
            PG8_LDB(B1, 1, 1); PG8_STAGE(PG8_SB(1, 0), b3, voffB);
            PG8_BAR; PG8_WAIT_L(0); PG8_MMA(0, 1, At, B1); PG8_BAR;
            PG8_LDA(At, 1, 1); PG8_STAGE(PG8_SA(1, 0), a3, voffA);
            PG8_BAR; PG8_WAIT_L(0); PG8_MMA(1, 0, At, B0); PG8_BAR; PG8_SCHED;
            PG8_STAGE(PG8_SB(1, 1), b3 + hstep, voffB);
            PG8_WAIT_V(6); PG8_BAR; PG8_MMA(1, 1, At, B1); PG8_BAR;
            }
        }
        if constexpr (ALIGN_EPI) { if (wr == 0) PG8_BAR; }
        if constexpr (!Epi::AFTER_DRAIN) { E(acc, cur, wr, wc, fr, fq); S.done(cur);
#ifdef EPI_DRAIN
        PG8_WAIT_V(0);
#endif
        }
        if (!has_next) break;
#pragma unroll
        for (int a = 0; a < 2; ++a)
#pragma unroll
            for (int b = 0; b < 2; ++b)
#pragma unroll
                for (int m = 0; m < 4; ++m)
#pragma unroll
                    for (int n = 0; n < 2; ++n) acc[a][b][m][n] = (f32x4){0.f, 0.f, 0.f, 0.f};
        cur = nxt; cA = nA; cB = nB; ++ui;
        if constexpr (ALIGN_EPI) { if (wr == 1) PG8_BAR; }
    }
    PG8_WAIT_V(0);
    if constexpr (!ALIGN_EPI) { if (wr == 0) PG8_BAR; }
    PG8_BAR;
    if constexpr (Epi::AFTER_DRAIN) { E.fused(acc, cur, wr, wc, fr, fq, lds, wid, lane); S.done(cur); }
#undef PG8_SA
#undef PG8_SB
#undef PG8_STAGE
#undef PG8_LDA
#undef PG8_LDB
#undef PG8_MMA
#undef PG8_WAIT_V
#undef PG8_WAIT_L
#undef PG8_BAR
#undef PG8_SCHED
}
}
#define LAS __attribute__((address_space(3)))
typedef unsigned short bf16;
typedef unsigned v4u __attribute__((ext_vector_type(4)));
typedef unsigned v2u __attribute__((ext_vector_type(2)));
typedef float F4 __attribute__((ext_vector_type(4)));
typedef float F16 __attribute__((ext_vector_type(16)));
typedef short B8 __attribute__((ext_vector_type(8)));
typedef short S4 __attribute__((ext_vector_type(4)));
typedef LAS unsigned char* lptr;

constexpr int NT = 512, NWAVES = 8;
constexpr int D = 1024, SEQ = 8192, NLAT = 16384, CTXL = 256, R = 16896, FF = 4096;
constexpr int LDS_BYTES = 155648;
constexpr size_t MiB = 1u << 20;
constexpr size_t WS_MV = 0, WS_CST = 512 * 1024, WS_D64 = 576 * 1024, WS_D128 = 640 * 1024, WS_TW = 704 * 1024;
constexpr size_t WS_BAR = 1 * MiB;
constexpr size_t WS_XS = 4 * MiB, WS_H = 70 * MiB, WS_Y = 103 * MiB;
constexpr size_t WS_SSDIN = 136 * MiB, WS_SSDOUT = WS_SSDIN + 6400ull * 1024 * 2, WS_W1_0 = WS_SSDOUT + 4 * MiB, WS_W2_0 = WS_W1_0 + 8 * MiB;
constexpr size_t WS_WL = WS_W2_0 + 8 * MiB;
#ifdef SWAP_W
constexpr size_t WS_W1L = WS_WL, WS_W2L = WS_W1L + 24 * MiB, WS_SCIN = WS_W2L + 24 * MiB, WS_NAOUT = WS_SCIN + 6 * MiB, WS_QKVW = WS_NAOUT + 2 * MiB;
#define WS_SCIN_END (WS_QKVW + 6 * MiB)
#else
constexpr size_t WS_W1L = WS_WL, WS_W2L = WS_W1L + 24 * MiB, WS_QKVW = WS_W2L + 24 * MiB, WS_NAOUT = WS_QKVW + 6 * MiB, WS_SCIN = WS_NAOUT + 2 * MiB;
#define WS_SCIN_END (WS_SCIN + 6 * MiB)
#endif

    constexpr size_t WS_SCOUT = WS_SCIN_END, WS_FNW = WS_SCOUT + 2 * MiB;
constexpr size_t WS_G = WS_FNW + 2 * MiB;
constexpr size_t WS_ZX = WS_WL;
constexpr size_t WS_DT = WS_G + 132 * MiB;
constexpr size_t WS_END = WS_DT + (size_t)R * 64 * 4;
constexpr size_t WS_ACT = WS_XS;
constexpr size_t WS_YN = WS_XS;
static_assert(WS_ACT + (size_t)R * 4096 * 2 == WS_SSDIN, "ACT fills XS|H|Y exactly");
static_assert(WS_WL == 168 * MiB + MiB / 2 && WS_G == 234 * MiB + MiB / 2, "map");
static_assert(WS_ZX + (size_t)R * 6144 * 2 == WS_DT, "ZX fills later-weights + G");
static_assert(WS_H + (size_t)R * D * 2 == WS_Y && WS_Y + (size_t)R * D * 2 == WS_SSDIN && WS_XS + (size_t)R * D * 4 == WS_H, "map2");

struct Args { const float* in[24]; float* out; unsigned char* ws; };

__device__ __forceinline__ unsigned pk2(float lo, float hi) { return pg8::cvt_pk_bf16(lo, hi); }
__device__ __forceinline__ float bflo(unsigned w) { return __builtin_bit_cast(float, w << 16); }
__device__ __forceinline__ float bfhi(unsigned w) { return __builtin_bit_cast(float, w & 0xffff0000u); }
__device__ __forceinline__ float bf2f(unsigned short b) { return __builtin_bit_cast(float, (unsigned)b << 16); }
__device__ __forceinline__ unsigned short f2bf(float f) { return (unsigned short)(pk2(f, 0.f) & 0xffffu); }
__device__ __forceinline__ float wave_sum(float v) {
#pragma unroll
    for (int o = 1; o < 64; o <<= 1) v += __shfl_xor(v, o);
    return v;
}
__device__ __forceinline__ float silu_f(float v) { return v * __builtin_amdgcn_rcpf(1.f + __expf(-v)); }
__device__ __forceinline__ int rowmap(int reg, int hf) { return (reg & 3) + 8 * (reg >> 2) + 4 * hf; }
#define LDS_WAIT() asm volatile("s_waitcnt lgkmcnt(0)" ::: "memory")

template <int KS> __device__ __forceinline__ void mma_lds(F16& acc, lptr A, int sa, lptr B, int sb, int lane) {
    const int r = lane & 31, h = lane >> 5;
    lptr pa = A + r * sa + h * 16; lptr pb = B + r * sb + h * 16;
    B8 a[KS], b[KS];
#pragma unroll
    for (int s = 0; s < KS; ++s) { a[s] = *(const LAS B8*)(pa + s * 32); b[s] = *(const LAS B8*)(pb + s * 32); }
#pragma unroll
    for (int s = 0; s < KS; ++s) acc = __builtin_amdgcn_mfma_f32_32x32x16_bf16(a[s], b[s], acc, 0, 0, 0);
}
template <int KS> __device__ __forceinline__ void mma_ldsB(F16& acc, const B8 (&a)[KS], lptr B, int sb, int lane) {
    const int r = lane & 31, h = lane >> 5; lptr pb = B + r * sb + h * 16;
    B8 b[KS];
#pragma unroll
    for (int s = 0; s < KS; ++s) b[s] = *(const LAS B8*)(pb + s * 32);
#pragma unroll
    for (int s = 0; s < KS; ++s) acc = __builtin_amdgcn_mfma_f32_32x32x16_bf16(a[s], b[s], acc, 0, 0, 0);
}
template <int KS> __device__ __forceinline__ void mma_lds_swz(F16& acc, lptr A, int sa, int zA0, int maskA, lptr B, int sb, int zB0, int maskB, int lane) {
    const int r = lane & 31, h = lane >> 5;
    lptr pa = A + r * sa; lptr pb = B + r * sb; const int za = (zA0 + (r >> 3)) & maskA, zb = (zB0 + (r >> 3)) & maskB;
    B8 a[KS], b[KS];
#pragma unroll
    for (int s = 0; s < KS; ++s) { a[s] = *(const LAS B8*)(pa + (((2 * s + h) ^ za) << 4)); b[s] = *(const LAS B8*)(pb + (((2 * s + h) ^ zb) << 4)); }
#pragma unroll
    for (int s = 0; s < KS; ++s) acc = __builtin_amdgcn_mfma_f32_32x32x16_bf16(a[s], b[s], acc, 0, 0, 0);
}
__device__ __forceinline__ void mma_lds_swz_rt(F16& acc, lptr A, int sa, int zA0, int maskA, lptr B, int sb, int zB0, int maskB, int lane, int ks) {
    const int r = lane & 31, h = lane >> 5;
    lptr pa = A + r * sa; lptr pb = B + r * sb; const int za = (zA0 + (r >> 3)) & maskA, zb = (zB0 + (r >> 3)) & maskB;
#pragma unroll 2
    for (int s = 0; s < ks; ++s) { const B8 a = *(const LAS B8*)(pa + (((2 * s + h) ^ za) << 4)); const B8 b = *(const LAS B8*)(pb + (((2 * s + h) ^ zb) << 4)); acc = __builtin_amdgcn_mfma_f32_32x32x16_bf16(a, b, acc, 0, 0, 0); }
}
template <int KS> __device__ __forceinline__ void mma_gA(F16& acc, const bf16* A, int lda, lptr B, int sb, int lane) {
    const int r = lane & 31, h = lane >> 5;
    const bf16* pa = A + (size_t)r * lda + h * 8; lptr pb = B + r * sb + h * 16;
#pragma unroll
    for (int s = 0; s < KS; ++s) { const B8 a = *(const B8*)(pa + s * 16); const B8 b = *(const LAS B8*)(pb + s * 32); acc = __builtin_amdgcn_mfma_f32_32x32x16_bf16(a, b, acc, 0, 0, 0); }
}

#define XB_TMO      128
#define XB_XCNT(j)  (256  + 64 * (j))
#define XB_XSUB(j)  (1280 + 64 * (j))
#define XB_XGEN(j)  (2304 + 64 * (j))
#define XB_TOP      3328
#define XB_TOPGEN   3392
#define XCD_BAR_WORDS 3456
#define XB_SPIN_CAP (1u << 18)

__device__ __forceinline__ unsigned xb_ld(unsigned* p)              { return __hip_atomic_load(p, __ATOMIC_RELAXED, __HIP_MEMORY_SCOPE_AGENT); }
__device__ __forceinline__ unsigned xb_add(unsigned* p, unsigned v) { return __hip_atomic_fetch_add(p, v, __ATOMIC_RELAXED, __HIP_MEMORY_SCOPE_AGENT); }
__device__ __forceinline__ unsigned xb_xcc_id() { return (unsigned)__builtin_amdgcn_s_getreg((3 << 11) | 20) & 0xFu; }
#define XB_SPIN(cond, bar) do { unsigned _sp = 0; while (cond) { __builtin_amdgcn_s_sleep(1); \
    if ((++_sp & 255u) == 0u) { if (xb_ld(&(bar)[XB_TMO])) break; if (_sp > XB_SPIN_CAP) { atomicAdd(&(bar)[XB_TMO], 1u); break; } } } } while (0)

struct XcdBarrier {
    unsigned* bar; unsigned x;
    volatile LAS unsigned* st;
};

__device__ __forceinline__ XcdBarrier xcd_barrier_post(unsigned* bar, volatile LAS unsigned* st) {
    XcdBarrier b; b.bar = bar; b.x = xb_xcc_id(); b.st = st;
    if (threadIdx.x == 0) (void)xb_add(&bar[XB_XCNT(b.x)], 1u);
    return b;
}
__device__ __forceinline__ void xcd_barrier_complete(unsigned* bar, unsigned x, unsigned& nloc, unsigned& nx) {
    const unsigned G = gridDim.x * gridDim.y * gridDim.z;
    unsigned sum, cnt, mine, sp = 0u;
    for (;;) {
        sum = 0u; cnt = 0u; mine = 0u;
#pragma unroll
        for (unsigned j = 0; j < 16; ++j) { const unsigned c = xb_ld(&bar[XB_XCNT(j)]); sum += c; cnt += (c > 0u) ? 1u : 0u; mine = (j == x) ? c : mine; }
        if (sum == G) break;
        __builtin_amdgcn_s_sleep(1);
        if ((++sp & 255u) == 0u) { if (xb_ld(&bar[XB_TMO])) break; if (sp > XB_SPIN_CAP) { atomicAdd(&bar[XB_TMO], 1u); break; } }
    }
    nloc = mine > 0u ? mine : 1u; nx = cnt > 0u ? cnt : 1u;
}

__device__ __forceinline__ void xcd_barrier(const XcdBarrier& b) {
    asm volatile("s_waitcnt vmcnt(0)" ::: "memory");
    __syncthreads();
    if (threadIdx.x == 0) {
        unsigned* bar = b.bar;
        __builtin_amdgcn_s_waitcnt(0);
        unsigned nloc = b.st[0], nx = b.st[1];
        if (nloc == 0u) { xcd_barrier_complete(bar, b.x, nloc, nx); b.st[0] = nloc; b.st[1] = nx; }
        const unsigned old = xb_add(&bar[XB_XSUB(b.x)], 1u);
        const unsigned gen = old / nloc;
        if (old + 1u == (gen + 1u) * nloc) {
            __builtin_amdgcn_fence(__ATOMIC_RELEASE, "agent");
            asm volatile("s_waitcnt vmcnt(0)" ::: "memory");
            const unsigned og = xb_add(&bar[XB_TOP], 1u);
            const unsigned tg = og / nx;
            if (og + 1u == (tg + 1u) * nx) xb_add(&bar[XB_TOPGEN], 1u);
            else XB_SPIN(xb_ld(&bar[XB_TOPGEN]) == tg, bar);
            __builtin_amdgcn_fence(__ATOMIC_ACQUIRE, "agent");
            xb_add(&bar[XB_XGEN(b.x)], 1u);
            asm volatile("s_waitcnt vmcnt(0)" ::: "memory");
        } else {
            XB_SPIN(xb_ld(&bar[XB_XGEN(b.x)]) == gen, bar);
            __builtin_amdgcn_fence(__ATOMIC_ACQUIRE, "agent");
            asm volatile("s_waitcnt vmcnt(0)" ::: "memory");
        }
    }
    __syncthreads();
}

__device__ __forceinline__ void transpose_item(const float* W, int K, int N, bf16* WT, LAS float* scr, int item, int lane) {
    const int nblk = N / 32, kb = item / nblk, nb = item % nblk, k0 = 64 * kb, n0 = 32 * nb;
    float wv_[32];
#pragma unroll
    for (int i = 0; i < 32; ++i) wv_[i] = W[(size_t)(k0 + 2 * i + (lane >> 5)) * N + n0 + (lane & 31)];
#pragma unroll
    for (int i = 0; i < 32; ++i) scr[(2 * i + (lane >> 5)) * 33 + (lane & 31)] = wv_[i];
    LDS_WAIT(); asm volatile("" ::: "memory");
    const int c = lane & 7;
#pragma unroll
    for (int j = 0; j < 4; ++j) { const int n = (lane >> 3) + 8 * j; const LAS float* s = scr + (8 * c) * 33 + n;
        v4u o; o.x = pk2(s[0 * 33], s[1 * 33]); o.y = pk2(s[2 * 33], s[3 * 33]); o.z = pk2(s[4 * 33], s[5 * 33]); o.w = pk2(s[6 * 33], s[7 * 33]);
        *(v4u*)(WT + (size_t)(n0 + n) * K + k0 + 8 * c) = o; }
    LDS_WAIT(); asm volatile("" ::: "memory");
}
#define TJOB(W_, K_, N_, WT_) { const int ni_ = ((K_) / 64) * ((N_) / 32); if (r < ni_) { transpose_item((W_), (K_), (N_), (WT_), scr, r, lane); continue; } r -= ni_; }

struct RowArgs { const bf16* Yp; const float* tA; const float* tB; const bf16* tS; const bf16* Y; const float* gate; const float* gY; float* oA; bf16* oS; bf16* H; const float* gH; const float* shift; const float* scale; int nrows; };
__device__ __forceinline__ void rowpass(const RowArgs& a, int gw, int NGW, int lane) {
    F4 tfn[4]; v2u tsn[4], yn[4];
#define ROW_LOAD(row_) { const int r_ = (row_); \
        if (a.tA) { const float* tp = r_ < NLAT ? a.tA + (size_t)r_ * D : a.tB + (size_t)(r_ - NLAT) * D; _Pragma("unroll") for (int j = 0; j < 4; ++j) tfn[j] = ((const F4*)tp)[lane + 64 * j]; } \
        else { _Pragma("unroll") for (int j = 0; j < 4; ++j) tsn[j] = ((const v2u*)(a.tS + (size_t)r_ * D))[lane + 64 * j]; } \
        if (a.Y) { _Pragma("unroll") for (int j = 0; j < 4; ++j) yn[j] = ((const v2u*)(a.Y + (size_t)r_ * D))[lane + 64 * j]; } }
    int row = gw;
    if (row < a.nrows) ROW_LOAD(row)
    while (row < a.nrows) {
        const int set = row < SEQ ? 0 : (row < NLAT ? 1 : 2);
        F4 t[4]; v2u yw[4];
        if (a.tA) {
#pragma unroll
            for (int j = 0; j < 4; ++j) t[j] = tfn[j];
        } else {
#pragma unroll
            for (int j = 0; j < 4; ++j) t[j] = (F4){bflo(tsn[j].x), bfhi(tsn[j].x), bflo(tsn[j].y), bfhi(tsn[j].y)}; }
#pragma unroll
        for (int j = 0; j < 4; ++j) yw[j] = yn[j];
        const int nrow = row + NGW;
        if (nrow < a.nrows) ROW_LOAD(nrow)
        if (a.Y) {
            F4 y[4]; float ss = 0.f;
#pragma unroll
            for (int j = 0; j < 4; ++j) { const v2u w = yw[j]; y[j] = (F4){bflo(w.x), bfhi(w.x), bflo(w.y), bfhi(w.y)}; }
            if (a.Yp && row >= NLAT) {
#pragma unroll
                for (int j = 0; j < 4; ++j) { y[j] = (F4){0.f, 0.f, 0.f, 0.f};
#pragma unroll
                    for (int s4 = 0; s4 < 4; ++s4) { const v2u w = ((const v2u*)(a.Yp + ((size_t)s4 * 512 + (row - NLAT)) * D))[lane + 64 * j]; y[j] += (F4){bflo(w.x), bfhi(w.x), bflo(w.y), bfhi(w.y)}; } } }
#pragma unroll
            for (int j = 0; j < 4; ++j) ss += (y[j].x * y[j].x + y[j].y * y[j].y) + (y[j].z * y[j].z + y[j].w * y[j].w);
            const float rstd = rsqrtf(wave_sum(ss) * (1.f / D) + 1e-6f);
#pragma unroll
            for (int j = 0; j < 4; ++j) { const F4 g4 = ((const F4*)(a.gate + set * 6144))[lane + 64 * j]; const F4 gy = ((const F4*)a.gY)[lane + 64 * j]; t[j] = t[j] + g4 * ((y[j] * rstd) * gy); }
        }
        if (a.oA) { float* op = a.oA + (size_t)row * D;
#pragma unroll
            for (int j = 0; j < 4; ++j) ((F4*)op)[lane + 64 * j] = t[j]; }
        if (a.oS) {
#pragma unroll
            for (int j = 0; j < 4; ++j) { v2u w; w.x = pk2(t[j].x, t[j].y); w.y = pk2(t[j].z, t[j].w); ((v2u*)(a.oS + (size_t)row * D))[lane + 64 * j] = w;
                t[j] = (F4){bflo(w.x), bfhi(w.x), bflo(w.y), bfhi(w.y)}; } }
        if (a.H) {
            float ss = 0.f;
#pragma unroll
            for (int j = 0; j < 4; ++j) ss += (t[j].x * t[j].x + t[j].y * t[j].y) + (t[j].z * t[j].z + t[j].w * t[j].w);
            const float rstd = rsqrtf(wave_sum(ss) * (1.f / D) + 1e-6f);
#pragma unroll
            for (int j = 0; j < 4; ++j) { const F4 g = ((const F4*)a.gH)[lane + 64 * j]; const F4 sh = ((const F4*)(a.shift + set * 6144))[lane + 64 * j]; const F4 sc = ((const F4*)(a.scale + set * 6144))[lane + 64 * j];
                const F4 hv = ((t[j] * rstd) * g) * (sc + 1.f) + sh; v2u w; w.x = pk2(hv.x, hv.y); w.y = pk2(hv.z, hv.w);
                ((v2u*)(a.H + (size_t)row * D))[lane + 64 * j] = w; }
        }
        row = nrow;
    }
#undef ROW_LOAD
}

__device__ __forceinline__ void p0_prologue(const Args& A, lptr lds, int tid, int lane, int wave, const int part) {
    unsigned char* ws = A.ws;
    LAS float* cv = (LAS float*)(lds + 131072);
    LAS float* red = (LAS float*)(lds + 131072 + 12288);
    float* MV = (float*)(ws + WS_MV);
    if (part == 0) {
    for (int i = tid; i < 3 * D; i += NT) { const float v = i < 2 * D ? A.in[1][i] : A.in[3][i - 2 * D]; cv[i] = silu_f(v); }
    __syncthreads();
    for (int it = blockIdx.x; it < 4 * 192; it += gridDim.x) {
        const int layer = it / 192, n0 = (it % 192) * 32, c4 = tid & 7, kk = tid >> 3;
        const float* w = A.in[4] + (size_t)layer * D * 6144 + n0 + 4 * c4;
        F4 a0 = {0.f, 0.f, 0.f, 0.f}, a1 = a0, a2 = a0;
#pragma unroll 16
        for (int i = 0; i < 16; ++i) { const int k = kk + 64 * i; const F4 wv = *(const F4*)(w + (size_t)k * 6144); a0 += wv * cv[k]; a1 += wv * cv[D + k]; a2 += wv * cv[2 * D + k]; }
#pragma unroll
        for (int o = 8; o < 64; o <<= 1) {
#pragma unroll
            for (int e = 0; e < 4; ++e) { a0[e] += __shfl_xor(a0[e], o); a1[e] += __shfl_xor(a1[e], o); a2[e] += __shfl_xor(a2[e], o); } }
        if (lane < 8) { *(LAS F4*)(red + (wave * 3 + 0) * 32 + 4 * lane) = a0; *(LAS F4*)(red + (wave * 3 + 1) * 32 + 4 * lane) = a1; *(LAS F4*)(red + (wave * 3 + 2) * 32 + 4 * lane) = a2; }
        __syncthreads();
        if (tid < 96) { const int s = tid >> 5, c = tid & 31; float v = A.in[5][layer * 6144 + n0 + c];
#pragma unroll
            for (int w8 = 0; w8 < 8; ++w8) v += red[(w8 * 3 + s) * 32 + c];
            MV[((size_t)layer * 3 + s) * 6144 + n0 + c] = v; }
        __syncthreads();
    }
    return; }
    const int gt = blockIdx.x * NT + tid, NGT = gridDim.x * NT;
    const float TWO_PI = 6.283185307179586f;
    {
        bf16* CST = (bf16*)(ws + WS_CST); bf16* D64 = (bf16*)(ws + WS_D64); bf16* D128 = (bf16*)(ws + WS_D128); float* TW = (float*)(ws + WS_TW);
        for (int i = gt; i < 256 * 128; i += NGT) { const int rr = i >> 7, n = i & 127, m = rr & 127; const float ang = TWO_PI * (float)((m * n) & 127) * (1.f / 128.f);
            CST[i] = f2bf(rr < 128 ? cosf(ang) : -sinf(ang)); }
        for (int i = gt; i < 128 * 128; i += NGT) { const int rr = i >> 7, cc = i & 127, k1 = rr & 63, t1 = cc & 63, co = rr >> 6, ci = cc >> 6; const float ang = TWO_PI * (float)((k1 * t1) & 63) * (1.f / 64.f);
            const float cs = cosf(ang), sn = sinf(ang); D64[i] = f2bf(co == ci ? cs : (co == 0 ? sn : -sn)); }
        for (int i = gt; i < 128 * 256; i += NGT) { const int k2 = i >> 8, cc = i & 255, t2 = cc & 127, ci = cc >> 7; const float ang = TWO_PI * (float)((k2 * t2) & 127) * (1.f / 128.f);
            D128[i] = f2bf(ci == 0 ? cosf(ang) : sinf(ang)); }
        for (int i = gt; i < 64 * 128; i += NGT) { const int k1 = i >> 7, t2 = i & 127; const float ang = TWO_PI * (float)(k1 * t2) * (1.f / 8192.f); TW[2 * i] = cosf(ang); TW[2 * i + 1] = sinf(ang); }
    }
    {
        v4u* z = (v4u*)(ws + WS_SSDIN + (size_t)6208 * 1024 * 2); const v4u zero = {0u, 0u, 0u, 0u};
        for (int i = gt; i < 192 * 1024 * 2 / 16; i += NGT) z[i] = zero;
    }
    LAS float* scr = (LAS float*)(lds + wave * 16384);
    const int gw = blockIdx.x * NWAVES + wave, NGW = gridDim.x * NWAVES;
    constexpr int NIT0 = 16 * 194 + 32 * 32 + 16 * 128 + 64 * 32;
    for (int it = gw; it < NIT0; it += NGW) {
        int r = it;
        TJOB(A.in[9], 1024, 6208, (bf16*)(ws + WS_SSDIN))
        TJOB(A.in[16], 2048, 1024, (bf16*)(ws + WS_SSDOUT))
        TJOB(A.in[7], 1024, 4096, (bf16*)(ws + WS_W1_0))
        TJOB(A.in[8], 4096, 1024, (bf16*)(ws + WS_W2_0))
    }
}
__device__ __forceinline__ void late_weights(const Args& A, lptr lds, int lane, int wave) {
    unsigned char* ws = A.ws;
    LAS float* scr = (LAS float*)(lds + wave * 16384);
    const int gw = blockIdx.x * NWAVES + wave, NGW = gridDim.x * NWAVES;
    constexpr int NIT = 6 * 2048 + 1536 + 512 + 1536 + 512 + 512;
    for (int it = gw; it < NIT; it += NGW) {
        int r = it;
        TJOB(A.in[7] + (size_t)1 * D * FF, 1024, 4096, (bf16*)(ws + WS_W1L))
        TJOB(A.in[7] + (size_t)2 * D * FF, 1024, 4096, (bf16*)(ws + WS_W1L + 8 * MiB))
        TJOB(A.in[7] + (size_t)3 * D * FF, 1024, 4096, (bf16*)(ws + WS_W1L + 16 * MiB))
        TJOB(A.in[8] + (size_t)1 * D * FF, 4096, 1024, (bf16*)(ws + WS_W2L))
        TJOB(A.in[8] + (size_t)2 * D * FF, 4096, 1024, (bf16*)(ws + WS_W2L + 8 * MiB))
        TJOB(A.in[8] + (size_t)3 * D * FF, 4096, 1024, (bf16*)(ws + WS_W2L + 16 * MiB))
        TJOB(A.in[17], 1024, 3072, (bf16*)(ws + WS_QKVW))
        TJOB(A.in[19], 1024, 1024, (bf16*)(ws + WS_NAOUT))
        TJOB(A.in[20], 1024, 3072, (bf16*)(ws + WS_SCIN))
        TJOB(A.in[22], 1024, 1024, (bf16*)(ws + WS_SCOUT))
        TJOB(A.in[23], 1024, 1024, (bf16*)(ws + WS_FNW))
    }
}
template <int NTOK> struct RawRun { v4u r[NTOK + 2]; };
template <int NTOK> __device__ __forceinline__ RawRun<NTOK> load_run(const bf16* zx, int rowbase, int tlo, int seqlen, int col) {
    const v4u zero = {0u, 0u, 0u, 0u}; RawRun<NTOK> rr;
#pragma unroll
    for (int q = 0; q < NTOK + 2; ++q) { const int t = tlo - 1 + q; rr.r[q] = (t >= 0 && t < seqlen) ? *(const v4u*)(zx + (size_t)(rowbase + t) * 6144 + col) : zero; }
    return rr;
}
__device__ __forceinline__ void conv_tok(const v4u& rp, const v4u& rc, const v4u& rn, const LAS float* w, int W, int c0, float (&o)[8]) {
    const unsigned pc[4] = {rc.x, rc.y, rc.z, rc.w}, pp[4] = {rp.x, rp.y, rp.z, rp.w}, pn[4] = {rn.x, rn.y, rn.z, rn.w};
#pragma unroll
    for (int e = 0; e < 8; ++e) {
        const float xc = (e & 1) ? bfhi(pc[e >> 1]) : bflo(pc[e >> 1]), xp = (e & 1) ? bfhi(pp[e >> 1]) : bflo(pp[e >> 1]), xn = (e & 1) ? bfhi(pn[e >> 1]) : bflo(pn[e >> 1]);
        const float v = w[0 * W + c0 + e] * xp + w[1 * W + c0 + e] * xc + w[2 * W + c0 + e] * xn + w[3 * W + c0 + e];
        o[e] = silu_f(v);
    }
}
template <int DUMMY> __device__ __forceinline__ void mma_lds_rt(F16& acc, lptr A, int sa, lptr B, int sb, int lane, int ks) {
    const int r = lane & 31, h = lane >> 5;
    lptr pa = A + r * sa + h * 16; lptr pb = B + r * sb + h * 16;
#pragma unroll 2
    for (int s = 0; s < ks; ++s) { const B8 a = *(const LAS B8*)(pa + s * 32); const B8 b = *(const LAS B8*)(pb + s * 32); acc = __builtin_amdgcn_mfma_f32_32x32x16_bf16(a, b, acc, 0, 0, 0); }
}

__device__ __forceinline__ void ssd_act_phase(const Args& A, int gt, int NGT) {
    unsigned char* ws = A.ws;
    const bf16* ZX = (const bf16*)(ws + WS_ZX); bf16* ACT = (bf16*)(ws + WS_ACT);
    const float* cw = A.in[10]; const float* cb = A.in[11];
    for (int it = gt; it < (R / 8) * 512; it += NGT) {
        const int cg = it & 511, run = it >> 9, row0 = run * 8;
        const int seq0 = row0 < NLAT ? (row0 & ~(SEQ - 1)) : NLAT + ((row0 - NLAT) & ~(CTXL - 1)), seqlen = row0 < NLAT ? SEQ : CTXL, tl = row0 - seq0;
        const v4u zero = {0u, 0u, 0u, 0u};
        v4u r[10];
#pragma unroll
        for (int q = 0; q < 10; ++q) { const int t_ = tl - 1 + q; r[q] = (t_ >= 0 && t_ < seqlen) ? *(const v4u*)(ZX + (size_t)(seq0 + t_) * 6144 + 2048 + 8 * cg) : zero; }
        float w0[8], w1[8], w2[8], bb[8];
#pragma unroll
        for (int e = 0; e < 8; ++e) { w0[e] = cw[8 * cg + e]; w1[e] = cw[4096 + 8 * cg + e]; w2[e] = cw[8192 + 8 * cg + e]; bb[e] = cb[8 * cg + e]; }
#pragma unroll
        for (int q = 0; q < 8; ++q) {
            const unsigned pp[4] = {r[q].x, r[q].y, r[q].z, r[q].w}, pc[4] = {r[q + 1].x, r[q + 1].y, r[q + 1].z, r[q + 1].w}, pn[4] = {r[q + 2].x, r[q + 2].y, r[q + 2].z, r[q + 2].w};
            float o[8];
#pragma unroll
            for (int e = 0; e < 8; ++e) { const float xp = (e & 1) ? bfhi(pp[e >> 1]) : bflo(pp[e >> 1]), xc = (e & 1) ? bfhi(pc[e >> 1]) : bflo(pc[e >> 1]), xn = (e & 1) ? bfhi(pn[e >> 1]) : bflo(pn[e >> 1]);
                o[e] = silu_f(w0[e] * xp + w1[e] * xc + w2[e] * xn + bb[e]); }
            v4u w; w.x = pk2(o[0], o[1]); w.y = pk2(o[2], o[3]); w.z = pk2(o[4], o[5]); w.w = pk2(o[6], o[7]);
            *(v4u*)(ACT + (size_t)(row0 + q) * 4096 + 8 * cg) = w;
        }
    }
}
__device__ __forceinline__ void ssd_scan_phase(const Args& A, lptr lds, int tid, int lane, int wave) {
    unsigned char* ws = A.ws;
    const bf16* ZX = (const bf16*)(ws + WS_ZX); const float* DT = (const float*)(ws + WS_DT); const bf16* ACT = (const bf16*)(ws + WS_ACT);
    constexpr int SR = 272;
    lptr Cm = lds, Bm = lds + 34816, BTw = lds + 69632, XT = lds + 104448, St = lds + 121856;
    LAS float* cumL = (LAS float*)(lds + 139264); LAS float* dtL = cumL + 128; LAS float* wendL = cumL + 256; LAS float* ecumL = cumL + 384;
    LAS float* wX = (LAS float*)(lds + 141312); LAS float* wB = wX + 256; LAS float* wC = wB + 512;
    const int hf = lane >> 5, l31 = lane & 31;
    for (int unit = blockIdx.x; unit < 256; unit += gridDim.x) {
        int hv, u7;
        if (gridDim.x == 256) { const int x = unit & 7, j = unit >> 3, combo = x * 4 + (j >> 3), e8 = j & 7; hv = combo >> 4; u7 = (((combo >> 3) & 1) << 6) | (((combo >> 2) & 1) << 5) | ((combo & 3) << 3) | e8; }
        else { hv = unit >> 7; u7 = unit & 127; }
        const int sBeg = hv ? 34 : 0, sEnd = hv ? 66 : 34;
        const int b = u7 >> 6, d = (u7 >> 5) & 1, h = u7 & 31, g = h >> 3;
        bf16* SM = (bf16*)(ws + 371 * MiB) + (size_t)u7 * 8192;
        const int chX = h * 64, chB = 2048 + ((d * 2 + 0) * 4 + g) * 128, chC = 2048 + ((d * 2 + 1) * 4 + g) * 128;
        const float a_neg = -__expf(A.in[13][d * 32 + h]);
        const float Dtot = A.in[14][h] + A.in[14][32 + h];
        const float dtb = A.in[12][d * 32 + h];
        bf16* Yout = (bf16*)(ws + WS_ZX) + (d ? 4096 : 2048);
        __syncthreads();
        for (int i = tid; i < 64 * SR / 4; i += NT) ((LAS unsigned*)St)[i] = 0u;
        F16 acc_st;
#pragma unroll
        for (int e = 0; e < 16; ++e) acc_st[e] = 0.f;
        __syncthreads();
        const int cgx = tid & 7, jrx = tid >> 3, cgb = tid & 15, jrb = tid >> 4;
        v4u px[2], pb[4], pc_[4];
#define SCAN_LOAD(s_) { const int s3 = (s_), ph3 = s3 >= 2, ci3 = ph3 ? s3 - 2 : s3, nch3 = ph3 ? 64 : 2, rb3 = ph3 ? b * SEQ : NLAT + b * CTXL, t03 = (d ? nch3 - 1 - ci3 : ci3) * 128; \
            const int tlx = d ? t03 + 128 - 2 * (jrx + 1) : t03 + 2 * jrx, tlb = d ? t03 + 128 - 4 * (jrb + 1) : t03 + 4 * jrb; \
            _Pragma("unroll") for (int q = 0; q < 2; ++q) px[q] = *(const v4u*)(ACT + (size_t)(rb3 + tlx + q) * 4096 + chX + 8 * cgx); \
            _Pragma("unroll") for (int q = 0; q < 4; ++q) { pb[q] = *(const v4u*)(ACT + (size_t)(rb3 + tlb + q) * 4096 + chB + 8 * cgb); pc_[q] = *(const v4u*)(ACT + (size_t)(rb3 + tlb + q) * 4096 + chC + 8 * cgb); } }
        SCAN_LOAD(sBeg)
        float dtp0 = 0.f, dtp1 = 0.f;
#define SCAN_DT_LOAD(s_) { const int s2 = (s_), ph2 = s2 >= 2, ci2 = ph2 ? s2 - 2 : s2, nch2 = ph2 ? 64 : 2, rb2 = ph2 ? b * SEQ : NLAT + b * CTXL, t02 = (d ? nch2 - 1 - ci2 : ci2) * 128; \
            const int tA = d ? t02 + 127 - lane : t02 + lane, tB = d ? t02 + 63 - lane : t02 + 64 + lane; \
            dtp0 = DT[(size_t)(rb2 + tA) * 64 + d * 32 + h]; dtp1 = DT[(size_t)(rb2 + tB) * 64 + d * 32 + h]; }
#define SCAN_STEP1(sN) { LAS float* cb_ = (LAS float*)(lds + 139264 + (((sN) & 1) ? 2048 : 0)); \
            const float xr0 = dtp0 + dtb, xr1 = dtp1 + dtb; const float dt0 = xr0 > 20.f ? xr0 : log1pf(__expf(xr0)), dt1 = xr1 > 20.f ? xr1 : log1pf(__expf(xr1)); \
            if ((sN) + 1 < 66) SCAN_DT_LOAD((sN) + 1) \
            float v0 = dt0 * a_neg, v1 = dt1 * a_neg; \
            _Pragma("unroll") for (int o = 1; o < 64; o <<= 1) { const float u0 = __shfl_up(v0, o), u1 = __shfl_up(v1, o); if (lane >= o) { v0 += u0; v1 += u1; } } \
            v1 += __shfl(v0, 63); const float cend = __shfl(v1, 63); \
            if (hv && lane == 0) ((float*)(ws + 373 * MiB))[u7 * 32 + ((sN) - 34)] = cend; \
            cb_[lane] = v0; cb_[lane + 64] = v1; cb_[128 + lane] = dt0; cb_[192 + lane] = dt1; \
            cb_[256 + lane] = __expf(cend - v0) * dt0; cb_[320 + lane] = __expf(cend - v1) * dt1; \
            cb_[384 + lane] = __expf(v0); cb_[448 + lane] = __expf(v1); }
        if (wave == 1) { SCAN_DT_LOAD(sBeg) SCAN_STEP1(sBeg) }
        __syncthreads();
        {
            for (int s = sBeg; s < sEnd; ++s) {
                const int ph = s >= 2, ci = ph ? s - 2 : s;
                const int nch = ph ? 64 : 2, rowbase = ph ? b * SEQ : NLAT + b * CTXL, seqlen = ph ? SEQ : CTXL; (void)seqlen;
                const int c = d ? nch - 1 - ci : ci, t0 = c * 128;
                const int cbo = (s & 1) ? 2048 : 0;
                const int rstep = d ? -1 : 1;
                const size_t row0 = (size_t)(rowbase + (d ? t0 + 127 - ((wave >> 1) * 32 + 4 * hf) : t0 + (wave >> 1) * 32 + 4 * hf));
                const bf16* zp = ZX + row0 * 6144 + h * 64 + (wave & 1) * 32 + l31; bf16* yp = Yout + row0 * 6144 + h * 64 + (wave & 1) * 32 + l31;
                unsigned short zv[16];
#pragma unroll
                for (int e = 0; e < 16; ++e) { const int io = (e & 3) + 8 * (e >> 2); zv[e] = zp[(ptrdiff_t)(io * rstep) * 6144]; }
                int wof = 0; asm volatile("" : "+v"(wof));
                lptr ldsc = lds + wof;
                { lptr xtw = ldsc + 104448 + (8 * cgx) * SR + ((((jrx >> 2) ^ cgx) & 15) << 4) + ((4 * jrx) & 15); asm volatile("" : "+v"(xtw));
                  const unsigned a0[4] = {px[0].x, px[0].y, px[0].z, px[0].w}, a1[4] = {px[1].x, px[1].y, px[1].z, px[1].w};
#pragma unroll
                  for (int e = 0; e < 8; ++e) { const unsigned lo0 = (e & 1) ? (a0[e >> 1] >> 16) : (a0[e >> 1] & 0xffffu), lo1 = (e & 1) ? (a1[e >> 1] >> 16) : (a1[e >> 1] & 0xffffu);
                      *(LAS unsigned*)(xtw + e * SR) = d ? (lo1 | (lo0 << 16)) : (lo0 | (lo1 << 16)); } }
                lptr cmw = ldsc + (4 * jrb + (d ? 3 : 0)) * SR + cgb * 16; asm volatile("" : "+v"(cmw)); const int qstep = d ? -SR : SR;
#pragma unroll
                for (int q = 0; q < 4; ++q) *(LAS v4u*)(cmw + q * qstep) = pc_[q];
                { lptr bmw = cmw + 34816; lptr btw = ldsc + 69632 + (8 * cgb) * SR + ((((jrb >> 1) ^ cgb) & 15) << 4) + ((8 * jrb) & 15); asm volatile("" : "+v"(btw));
#pragma unroll
                  for (int q = 0; q < 4; ++q) *(LAS v4u*)(bmw + q * qstep) = pb[q];
                  const F4 we = *(const LAS F4*)((const LAS float*)(ldsc + 139264 + cbo) + 256 + 4 * jrb);
                  const unsigned b0[4] = {pb[0].x, pb[0].y, pb[0].z, pb[0].w}, b1[4] = {pb[1].x, pb[1].y, pb[1].z, pb[1].w}, b2[4] = {pb[2].x, pb[2].y, pb[2].z, pb[2].w}, b3[4] = {pb[3].x, pb[3].y, pb[3].z, pb[3].w};
#pragma unroll
                  for (int e = 0; e < 8; ++e) { const int q2 = e >> 1;
                      const float f0 = (e & 1) ? bfhi(b0[q2]) : bflo(b0[q2]), f1 = (e & 1) ? bfhi(b1[q2]) : bflo(b1[q2]), f2 = (e & 1) ? bfhi(b2[q2]) : bflo(b2[q2]), f3 = (e & 1) ? bfhi(b3[q2]) : bflo(b3[q2]);
                      v2u w;
                      if (d) { w.x = pk2(f3 * we.x, f2 * we.y); w.y = pk2(f1 * we.z, f0 * we.w); }
                      else   { w.x = pk2(f0 * we.x, f1 * we.y); w.y = pk2(f2 * we.z, f3 * we.w); }
                      *(LAS v2u*)(btw + e * SR) = w; } }
                if (s + 1 < sEnd) SCAN_LOAD(s + 1)
                __syncthreads();
                F16 cb0, cb1, acc2;
#pragma unroll
                for (int e = 0; e < 16; ++e) { cb0[e] = 0.f; cb1[e] = 0.f; acc2[e] = 0.f; }
                const int ti0 = (2 * wave) >> 2, tj0 = (2 * wave) & 3, tj1 = tj0 + 1;
                const int ti2 = wave >> 1, tp = wave & 1;
                { B8 af[8]; { lptr pa = Cm + ti0 * 32 * SR + l31 * SR + hf * 16;
#pragma unroll
                    for (int q = 0; q < 8; ++q) af[q] = *(const LAS B8*)(pa + q * 32); }
                  mma_ldsB<8>(acc2, af, St + tp * 32 * SR, SR, lane);
                  if (tj0 <= ti0) mma_ldsB<8>(cb0, af, Bm + tj0 * 32 * SR, SR, lane);
                  if (tj1 <= ti0) mma_ldsB<8>(cb1, af, Bm + tj1 * 32 * SR, SR, lane); }
                if (wave == 1 && s + 1 < sEnd) SCAN_STEP1(s + 1)
                __syncthreads();
                { const LAS float* cumI = (const LAS float*)(ldsc + 139264 + cbo) + ti0 * 32 + 4 * hf; const LAS float* cumJ = (const LAS float*)(ldsc + 139264 + cbo);
                  if (tj0 <= ti0) { const int j = tj0 * 32 + l31; const float cj = cumJ[j], dj = cumJ[128 + j]; lptr sw = ldsc + 34816 + (ti0 * 32 + 4 * hf) * SR + j * 2; asm volatile("" : "+v"(sw));
#pragma unroll
                    for (int e = 0; e < 16; ++e) { const int io = (e & 3) + 8 * (e >> 2); const int i = ti0 * 32 + 4 * hf + io;
                        const float v = (j <= i) ? cb0[e] * __expf(cumI[io] - cj) * dj : 0.f; *(LAS bf16*)(sw + io * SR) = f2bf(v); } }
                  if (tj1 <= ti0) { const int j = tj1 * 32 + l31; const float cj = cumJ[j], dj = cumJ[128 + j]; lptr sw = ldsc + 34816 + (ti0 * 32 + 4 * hf) * SR + j * 2; asm volatile("" : "+v"(sw));
#pragma unroll
                    for (int e = 0; e < 16; ++e) { const int io = (e & 3) + 8 * (e >> 2); const int i = ti0 * 32 + 4 * hf + io;
                        const float v = (j <= i) ? cb1[e] * __expf(cumI[io] - cj) * dj : 0.f; *(LAS bf16*)(sw + io * SR) = f2bf(v); } } }
                __syncthreads();
                F16 acc1;
#pragma unroll
                for (int e = 0; e < 16; ++e) acc1[e] = 0.f;
                mma_lds_swz_rt(acc1, Bm + ti2 * 32 * SR, SR, 0, 0, XT + tp * 32 * SR, SR, 4 * tp, 7, lane, 2 * (ti2 + 1));
                { const LAS float* ecI = (const LAS float*)(ldsc + 139264 + cbo) + 384 + ti2 * 32 + 4 * hf; const int zx_ = (4 * tp + (l31 >> 3)) & 7; lptr xd = ldsc + 104448 + (tp * 32 + l31) * SR + (8 * hf); asm volatile("" : "+v"(xd));
#pragma unroll
                  for (int e = 0; e < 16; ++e) { const int io = (e & 3) + 8 * (e >> 2);
                    float y = acc1[e] + ecI[io] * acc2[e];
                    if (d == 0) y += Dtot * bf2f(*(const LAS bf16*)(xd + ((((4 * ti2 + (e >> 2)) ^ zx_)) << 4) + (e & 3) * 2));
                    const float z = bf2f(zv[e]);
                    yp[(ptrdiff_t)(io * rstep) * 6144] = f2bf(y * silu_f(z)); } }
                const int tps = wave >> 2, tn = wave & 3; const float decay = __expf(((const LAS float*)(ldsc + 139264 + cbo))[127]);
#pragma unroll
                for (int e = 0; e < 16; ++e) acc_st[e] *= decay;
                mma_lds_swz<8>(acc_st, XT + tps * 32 * SR, SR, 4 * tps, 7, BTw + tn * 32 * SR, SR, 4 * tn, 15, lane);
                { lptr stw = ldsc + 121856 + (tps * 32 + 4 * hf) * SR + (tn * 32 + l31) * 2; asm volatile("" : "+v"(stw));
#pragma unroll
                  for (int e = 0; e < 16; ++e) { const int io = (e & 3) + 8 * (e >> 2); *(LAS bf16*)(stw + io * SR) = f2bf(acc_st[e]); } }
                __syncthreads();
            }
        }
        if (hv == 0) {
            const int tps_ = wave >> 2, tn_ = wave & 3;
            bf16* smb = SM + (size_t)(tps_ * 32 + 4 * hf) * 128 + tn_ * 32 + l31;
#pragma unroll
            for (int e = 0; e < 16; ++e) { const int io = (e & 3) + 8 * (e >> 2); smb[io * 128] = f2bf(acc_st[e]); }
        }
    }
}

__device__ __forceinline__ void ssd_corr_phase(const Args& A, lptr lds, int tid, int lane, int wave) {
    unsigned char* ws = A.ws;
    const bf16* ZX = (const bf16*)(ws + WS_ZX); const float* DT = (const float*)(ws + WS_DT); const bf16* ACT = (const bf16*)(ws + WS_ACT);
    constexpr int SR = 272;
    lptr Cm = lds, St = lds + 34816; LAS float* fac = (LAS float*)(lds + 34816 + 17408);
    const int hf = lane >> 5, l31 = lane & 31;
    for (int cu0 = blockIdx.x; cu0 < 256; cu0 += gridDim.x) {
        int cu = cu0; asm volatile("" : "+v"(cu));
        int u7, k0;
        if (gridDim.x == 256) { const int x = cu & 7, j = cu >> 3, combo = x * 4 + (j >> 3), e8 = j & 7; u7 = (((combo >> 4) & 1) << 6) | (((combo >> 3) & 1) << 5) | (((combo >> 1) & 3) << 3) | e8; k0 = (combo & 1) * 16; }
        else { u7 = cu >> 1; k0 = (cu & 1) * 16; }
        const int b = u7 >> 6, d = (u7 >> 5) & 1, h = u7 & 31, g = h >> 3;
        const int chC = 2048 + ((d * 2 + 1) * 4 + g) * 128, rowbase = b * SEQ;
        const bf16* SM = (const bf16*)(ws + 371 * MiB) + (size_t)u7 * 8192; const float* CE = (const float*)(ws + 373 * MiB) + u7 * 32;
        bf16* Yout = (bf16*)(ws + WS_ZX) + (d ? 4096 : 2048);
        const float a_neg = -__expf(A.in[13][d * 32 + h]), dtb = A.in[12][d * 32 + h];
        const int cgb = tid & 15, jrb = tid >> 4;
        __syncthreads();
#pragma unroll
        for (int q = 0; q < 2; ++q) { const int pcs = tid + NT * q, prow = pcs >> 4, pch = pcs & 15; *(LAS v4u*)(St + prow * SR + pch * 16) = *(const v4u*)(SM + prow * 128 + pch * 8); }
        v4u pc_[4]; float dr0 = 0.f, dr1 = 0.f;
#define CORR_LOAD(k_) { const int c3 = (d ? 63 - (32 + (k_)) : 32 + (k_)), t03 = c3 * 128; const int tlb = d ? t03 + 128 - 4 * (jrb + 1) : t03 + 4 * jrb; \
            _Pragma("unroll") for (int q = 0; q < 4; ++q) pc_[q] = *(const v4u*)(ACT + (size_t)(rowbase + tlb + q) * 4096 + chC + 8 * cgb); \
            if (wave == 1) { const int tA = d ? t03 + 127 - lane : t03 + lane, tB = d ? t03 + 63 - lane : t03 + 64 + lane; \
                dr0 = DT[(size_t)(rowbase + tA) * 64 + d * 32 + h]; dr1 = DT[(size_t)(rowbase + tB) * 64 + d * 32 + h]; } }
        CORR_LOAD(k0)
        for (int i = 0; i < 16; ++i) {
            const int k = k0 + i, ci = 32 + k, c = d ? 63 - ci : ci, t0 = c * 128;
            __syncthreads();
            if (wave == 1) {
                const float xr0 = dr0 + dtb, xr1 = dr1 + dtb;
                const float dt0 = xr0 > 20.f ? xr0 : log1pf(__expf(xr0)), dt1 = xr1 > 20.f ? xr1 : log1pf(__expf(xr1));
                float pre = (lane < k) ? CE[lane] : 0.f; pre = wave_sum(pre);
                float v0 = dt0 * a_neg, v1 = dt1 * a_neg;
#pragma unroll
                for (int o = 1; o < 64; o <<= 1) { const float u0 = __shfl_up(v0, o), u1 = __shfl_up(v1, o); if (lane >= o) { v0 += u0; v1 += u1; } }
                v1 += __shfl(v0, 63);
                fac[lane] = __expf(v0 + pre); fac[lane + 64] = __expf(v1 + pre);
            }
            { lptr cmw = Cm + (4 * jrb + (d ? 3 : 0)) * SR + cgb * 16; const int qstep = d ? -SR : SR;
#pragma unroll
              for (int q = 0; q < 4; ++q) *(LAS v4u*)(cmw + q * qstep) = pc_[q]; }
            const int ti2 = wave >> 1, tp = wave & 1, rstep = d ? -1 : 1;
            const size_t row0 = (size_t)(rowbase + (d ? t0 + 127 - (ti2 * 32 + 4 * hf) : t0 + ti2 * 32 + 4 * hf));
            const bf16* zp = ZX + row0 * 6144 + h * 64 + tp * 32 + l31; bf16* yp = Yout + row0 * 6144 + h * 64 + tp * 32 + l31;
            unsigned short zv[16], yv[16];
#pragma unroll
            for (int e = 0; e < 16; ++e) { const int io = (e & 3) + 8 * (e >> 2); zv[e] = zp[(ptrdiff_t)(io * rstep) * 6144]; yv[e] = yp[(ptrdiff_t)(io * rstep) * 6144]; }
            if (i < 15) CORR_LOAD(k + 1)
            __syncthreads();
            F16 acc2;
#pragma unroll
            for (int e = 0; e < 16; ++e) acc2[e] = 0.f;
            mma_lds<8>(acc2, Cm + ti2 * 32 * SR, SR, St + tp * 32 * SR, SR, lane);
#pragma unroll
            for (int e = 0; e < 16; ++e) { const int io = (e & 3) + 8 * (e >> 2);
                yp[(ptrdiff_t)(io * rstep) * 6144] = f2bf(bf2f(yv[e]) + fac[ti2 * 32 + 4 * hf + io] * acc2[e] * silu_f(bf2f(zv[e]))); }
        }
#undef CORR_LOAD
    }
}

__device__ __forceinline__ void ssd_combine(const Args& A, int gw, int NGW, int lane) {
    unsigned char* ws = A.ws;
    const bf16* YF = (const bf16*)(ws + WS_ZX) + 2048; const bf16* YB = (const bf16*)(ws + WS_ZX) + 4096; bf16* YN = (bf16*)(ws + WS_YN);
    v2u fn[8], bn[8];
#define CMB_LOAD(r_) { _Pragma("unroll") for (int j = 0; j < 8; ++j) { fn[j] = ((const v2u*)(YF + (size_t)(r_) * 6144))[lane + 64 * j]; bn[j] = ((const v2u*)(YB + (size_t)(r_) * 6144))[lane + 64 * j]; } }
    int row = gw;
    if (row < R) CMB_LOAD(row)
    while (row < R) {
        F4 s[8]; float ss = 0.f;
#pragma unroll
        for (int j = 0; j < 8; ++j) { const v2u f = fn[j], bk = bn[j];
            s[j] = (F4){bflo(f.x) + bflo(bk.x), bfhi(f.x) + bfhi(bk.x), bflo(f.y) + bflo(bk.y), bfhi(f.y) + bfhi(bk.y)};
            ss += (s[j].x * s[j].x + s[j].y * s[j].y) + (s[j].z * s[j].z + s[j].w * s[j].w); }
        const int nrow = row + NGW;
        if (nrow < R) CMB_LOAD(nrow)
        const float rstd = rsqrtf(wave_sum(ss) * (1.f / 2048.f) + 1e-6f);
#pragma unroll
        for (int j = 0; j < 8; ++j) { const F4 g = ((const F4*)A.in[15])[lane + 64 * j]; const F4 o = (s[j] * rstd) * g; v2u w; w.x = pk2(o.x, o.y); w.y = pk2(o.z, o.w);
            ((v2u*)(YN + (size_t)row * 2048))[lane + 64 * j] = w; }
        row = nrow;
    }
#undef CMB_LOAD
}

__device__ __forceinline__ void na_phase(const Args& A, lptr lds, int tid, int lane, int wave) {
    unsigned char* ws = A.ws;
    const bf16* QKV = (const bf16*)(ws + WS_G); bf16* O = (bf16*)(ws + WS_H);
    constexpr int KSR = 528, VSR = 136;
    constexpr int NABUF = 64 * KSR + 256 * VSR;
    LAS float* rp = (LAS float*)(lds + 2 * NABUF);
    const int hf = lane >> 5, l31 = lane & 31, hl = wave >> 1, qh = wave & 1;
    const int nIterNA = gridDim.x == 256 ? 4 : (1024 + (int)gridDim.x - 1) / (int)gridDim.x;
    for (int ui = 0; ui < nIterNA; ++ui) {
        int unit;
        if (gridDim.x == 256) { const int x = blockIdx.x & 7, j = blockIdx.x >> 3; unit = ((x >> 2) << 9) | ((j * 4 + ui) << 2) | (x & 3); }
        else { unit = blockIdx.x + ui * gridDim.x; if (unit >= 1024) break; }
        const int b = unit >> 9, r = (unit >> 2) & 127, hq = unit & 3;
        const int r0 = min(max(r - 4, 0), 120), hh = 4 * hq + hl;
        __syncthreads();
        for (int i = tid; i < 4 * 465; i += NT) rp[i] = A.in[18][(4 * hq) * 465 + i] * 1.4426950408889634f;
        const size_t qrow = (size_t)b * SEQ + r * 64 + 32 * qh + l31;
        B8 qf[4];
#pragma unroll
        for (int s = 0; s < 4; ++s) qf[s] = *(const B8*)(QKV + qrow * 3072 + hh * 64 + 16 * s + 8 * hf);
        const int qc = 32 * qh + l31, c0 = min(max(qc - 8, 0), 48);
        float m = -1e30f, l = 0.f; F16 o0, o1;
#pragma unroll
        for (int e = 0; e < 16; ++e) { o0[e] = 0.f; o1[e] = 0.f; }
#define NA_LOAD(it_) { const int it2_ = (it_); const size_t keybase = it2_ < 8 ? (size_t)b * SEQ + (r0 + it2_) * 64 : (size_t)NLAT + b * CTXL + (it2_ - 8) * 64; \
            _Pragma("unroll") for (int k = 0; k < 4; ++k) { const bf16* src = QKV + (keybase + 4 * kq + k) * 3072 + 1024 + hq * 256 + 8 * c8; \
                kr[k] = *(const v4u*)src; vr[k] = *(const v4u*)(src + 1024); } }
        const int kq = tid & 15, c8 = tid >> 4;
        v4u kr[4], vr[4];
#define NA_STORE(buf_) { lptr Kt_ = lds + (buf_) * NABUF; lptr VT_ = Kt_ + 64 * KSR; \
            _Pragma("unroll") for (int k = 0; k < 4; ++k) *(LAS v4u*)(Kt_ + (4 * kq + k) * KSR + c8 * 16) = kr[k]; \
            const unsigned v0[4] = {vr[0].x, vr[0].y, vr[0].z, vr[0].w}, v1[4] = {vr[1].x, vr[1].y, vr[1].z, vr[1].w}, v2[4] = {vr[2].x, vr[2].y, vr[2].z, vr[2].w}, v3[4] = {vr[3].x, vr[3].y, vr[3].z, vr[3].w}; \
            lptr vtw = VT_ + (8 * c8) * VSR + kq * 8; \
            _Pragma("unroll") for (int e = 0; e < 8; ++e) { const int q2 = e >> 1; v2u w; \
                if (e & 1) { w.x = (v0[q2] >> 16) | (v1[q2] & 0xffff0000u); w.y = (v2[q2] >> 16) | (v3[q2] & 0xffff0000u); } \
                else       { w.x = (v0[q2] & 0xffffu) | (v1[q2] << 16);     w.y = (v2[q2] & 0xffffu) | (v3[q2] << 16); } \
                *(LAS v2u*)(vtw + e * VSR) = w; } }
        NA_LOAD(0)
        NA_STORE(0)
        NA_LOAD(1)
        __syncthreads();
        for (int it = 0; it < 12; ++it) {
            lptr Kt = lds + (it & 1) * NABUF; lptr VT = Kt + 64 * KSR;
            F16 s0, s1;
#pragma unroll
            for (int e = 0; e < 16; ++e) { s0[e] = 0.f; s1[e] = 0.f; }
#pragma unroll
            for (int s = 0; s < 4; ++s) { const B8 a0 = *(const LAS B8*)(Kt + l31 * KSR + hl * 128 + s * 32 + hf * 16); const B8 a1 = *(const LAS B8*)(Kt + (32 + l31) * KSR + hl * 128 + s * 32 + hf * 16);
                s0 = __builtin_amdgcn_mfma_f32_32x32x16_bf16(a0, qf[s], s0, 0, 0, 0); s1 = __builtin_amdgcn_mfma_f32_32x32x16_bf16(a1, qf[s], s1, 0, 0, 0); }
            const int dq = it < 8 ? (qh ? 1 : 2) : 0;
            if (it < 8) {
                const LAS float* rph = rp + hl * 465 + (r0 + it - r + 7) * 31 + 15 - qc;
#pragma unroll
                for (int e = 0; e < 16; ++e) { const int k0 = rowmap(e, hf), k1 = k0 + 32;
                    if (e < 8 && dq == 1) s0[e] = -1e30f; else s0[e] = (k0 >= c0 && k0 < c0 + 16) ? s0[e] * 0.18033688011112042f + rph[k0] : -1e30f;
                    if (e >= 8 && dq == 2) s1[e] = -1e30f; else s1[e] = (k1 >= c0 && k1 < c0 + 16) ? s1[e] * 0.18033688011112042f + rph[k1] : -1e30f; }
            } else {
#pragma unroll
                for (int e = 0; e < 16; ++e) { s0[e] *= 0.18033688011112042f; s1[e] *= 0.18033688011112042f; }
            }
            float mx = -1e30f;
#pragma unroll
            for (int e = 0; e < 16; ++e) mx = fmaxf(mx, fmaxf(s0[e], s1[e]));
            mx = fmaxf(mx, __shfl_xor(mx, 32));
            const float mn = fmaxf(m, mx), alpha = __builtin_amdgcn_exp2f(m - mn); m = mn;
            float ls = 0.f;
#pragma unroll
            for (int e = 0; e < 16; ++e) { s0[e] = (e < 8 && dq == 1) ? 0.f : __builtin_amdgcn_exp2f(s0[e] - mn); s1[e] = (e >= 8 && dq == 2) ? 0.f : __builtin_amdgcn_exp2f(s1[e] - mn); ls += s0[e] + s1[e]; o0[e] *= alpha; o1[e] *= alpha; }
            l = l * alpha + ls;
#pragma unroll
            for (int kt = 0; kt < 2; ++kt)
#pragma unroll
                for (int s = 0; s < 2; ++s) {
                    if ((kt == 0 && s == 0 && dq == 1) || (kt == 1 && s == 1 && dq == 2)) continue;
                    const F16& pp = kt ? s1 : s0;
                    v4u pw; pw.x = pk2(pp[8 * s + 0], pp[8 * s + 1]); pw.y = pk2(pp[8 * s + 2], pp[8 * s + 3]); pw.z = pk2(pp[8 * s + 4], pp[8 * s + 5]); pw.w = pk2(pp[8 * s + 6], pp[8 * s + 7]);
                    const B8 pb = __builtin_bit_cast(B8, pw);
                    const int koff = (kt * 32 + 16 * s + 4 * hf) * 2;
                    { lptr vrp = VT + (hl * 64 + l31) * VSR + koff; const v2u x0 = *(const LAS v2u*)vrp, x1 = *(const LAS v2u*)(vrp + 16); const v4u aw = {x0.x, x0.y, x1.x, x1.y};
                      o0 = __builtin_amdgcn_mfma_f32_32x32x16_bf16(__builtin_bit_cast(B8, aw), pb, o0, 0, 0, 0); }
                    { lptr vrp = VT + (hl * 64 + 32 + l31) * VSR + koff; const v2u x0 = *(const LAS v2u*)vrp, x1 = *(const LAS v2u*)(vrp + 16); const v4u aw = {x0.x, x0.y, x1.x, x1.y};
                      o1 = __builtin_amdgcn_mfma_f32_32x32x16_bf16(__builtin_bit_cast(B8, aw), pb, o1, 0, 0, 0); }
                }
            if (it < 11) { NA_STORE((it + 1) & 1) if (it < 10) NA_LOAD(it + 2) }
            __syncthreads();
        }
        const float inv = 1.f / (l + __shfl_xor(l, 32));
        bf16* op = O + qrow * D + hh * 64;
#pragma unroll
        for (int gq = 0; gq < 4; ++gq) { const int dd = 8 * gq + 4 * hf;
            v2u w0; w0.x = pk2(o0[4 * gq] * inv, o0[4 * gq + 1] * inv); w0.y = pk2(o0[4 * gq + 2] * inv, o0[4 * gq + 3] * inv); *(v2u*)(op + dd) = w0;
            v2u w1; w1.x = pk2(o1[4 * gq] * inv, o1[4 * gq + 1] * inv); w1.y = pk2(o1[4 * gq + 2] * inv, o1[4 * gq + 3] * inv); *(v2u*)(op + 32 + dd) = w1; }
    }
}

__device__ __forceinline__ void sc_conv_phase(const Args& A, int gt, int NGT) {
    unsigned char* ws = A.ws;
    const bf16* P = (const bf16*)(ws + WS_G); bf16* V = (bf16*)(ws + WS_H); const float* cw = A.in[21];
    for (int it = gt; it < NLAT * 128; it += NGT) {
        const int row = it >> 7, c8 = it & 127, t = row & (SEQ - 1);
        const bf16* pr = P + (size_t)row * 3072 + 8 * c8;
        const v4u zero = {0u, 0u, 0u, 0u};
        const v4u bg = *(const v4u*)pr, cc = *(const v4u*)(pr + 1024), uc = *(const v4u*)(pr + 2048);
#ifdef CONV_NO_NEIGH
        const v4u cp = zero, up = zero, cn = zero, un = zero; (void)t;
#else
        const v4u cp = t > 0 ? *(const v4u*)(pr - 3072 + 1024) : zero, up = t > 0 ? *(const v4u*)(pr - 3072 + 2048) : zero;
        const v4u cn = t < SEQ - 1 ? *(const v4u*)(pr + 3072 + 1024) : zero, un = t < SEQ - 1 ? *(const v4u*)(pr + 3072 + 2048) : zero;
#endif
        const unsigned abg[4] = {bg.x, bg.y, bg.z, bg.w}, acc_[4] = {cc.x, cc.y, cc.z, cc.w}, auc[4] = {uc.x, uc.y, uc.z, uc.w}, acp[4] = {cp.x, cp.y, cp.z, cp.w}, aup[4] = {up.x, up.y, up.z, up.w},
                       acn[4] = {cn.x, cn.y, cn.z, cn.w}, aun[4] = {un.x, un.y, un.z, un.w};
        float o[8];
#pragma unroll
        for (int e = 0; e < 8; ++e) { const int q = e >> 1;
#define SEL(a) ((e & 1) ? bfhi(a[q]) : bflo(a[q]))
            const float v = cw[0 * D + 8 * c8 + e] * (SEL(acp) * SEL(aup)) + cw[1 * D + 8 * c8 + e] * (SEL(acc_) * SEL(auc)) + cw[2 * D + 8 * c8 + e] * (SEL(acn) * SEL(aun));
            o[e] = SEL(abg) * v;
#undef SEL
        }
        v4u w; w.x = pk2(o[0], o[1]); w.y = pk2(o[2], o[3]); w.z = pk2(o[4], o[5]); w.w = pk2(o[6], o[7]);
        *(v4u*)(V + (size_t)row * D + 8 * c8) = w;
    }
}

__device__ __forceinline__ void fn_stage2(const Args& A, lptr lds, int tid, int lane, int wave) {
    unsigned char* ws = A.ws;
    const bf16* Wc = (const bf16*)(ws + WS_G); bf16* U = (bf16*)(ws + WS_G + 64 * MiB); const bf16* D64 = (const bf16*)(ws + WS_D64); const float* TW = (const float*)(ws + WS_TW);
    constexpr int SR = 272;
    lptr Bl = lds; LAS float* twc = (LAS float*)(lds + 128 * SR);
    const int hf = lane >> 5, l31 = lane & 31;
    const int a = wave >> 2, bt = wave & 3;
    B8 fr_[8], fi_[8];
#pragma unroll
    for (int s = 0; s < 8; ++s) { fr_[s] = *(const B8*)(D64 + (size_t)(32 * a + l31) * 128 + hf * 8 + s * 16); fi_[s] = *(const B8*)(D64 + (size_t)(64 + 32 * a + l31) * 128 + hf * 8 + s * 16); }
    const int tq = tid & 15, pc = tid >> 4, comp = pc >> 4, m0 = (pc & 15) * 8;
    v4u rr[4];
#define F2_LOAD(u_) { const int u2 = (u_); const int b2 = u2 >> 10, t22 = (u2 >> 3) & 127, g2 = u2 & 7; \
        _Pragma("unroll") for (int q = 0; q < 4; ++q) rr[q] = *(const v4u*)(Wc + ((size_t)b2 * SEQ + 128 * (4 * tq + q) + t22) * 2048 + g2 * 256 + 8 * pc); }
    if ((int)blockIdx.x < 2048) F2_LOAD((int)blockIdx.x)
    for (int unit = blockIdx.x; unit < 2048; unit += gridDim.x) {
        const int b = unit >> 10, t2 = (unit >> 3) & 127, g = unit & 7;
        __syncthreads();
        { const unsigned v0[4] = {rr[0].x, rr[0].y, rr[0].z, rr[0].w}, v1[4] = {rr[1].x, rr[1].y, rr[1].z, rr[1].w}, v2[4] = {rr[2].x, rr[2].y, rr[2].z, rr[2].w}, v3[4] = {rr[3].x, rr[3].y, rr[3].z, rr[3].w};
          lptr bw = Bl + m0 * SR + (comp * 64 + 4 * tq) * 2;
#pragma unroll
          for (int e = 0; e < 8; ++e) { const int q2 = e >> 1; v2u w;
              if (e & 1) { w.x = (v0[q2] >> 16) | (v1[q2] & 0xffff0000u); w.y = (v2[q2] >> 16) | (v3[q2] & 0xffff0000u); }
              else       { w.x = (v0[q2] & 0xffffu) | (v1[q2] << 16);     w.y = (v2[q2] & 0xffffu) | (v3[q2] << 16); }
              *(LAS v2u*)(bw + e * SR) = w; } }
        if (tid < 128) twc[tid] = TW[((tid >> 1) * 128 + t2) * 2 + (tid & 1)];
        if (unit + (int)gridDim.x < 2048) F2_LOAD(unit + (int)gridDim.x)
        __syncthreads();
        F16 ar, ai;
#pragma unroll
        for (int e = 0; e < 16; ++e) { ar[e] = 0.f; ai[e] = 0.f; }
        mma_ldsB<8>(ar, fr_, Bl + bt * 32 * SR, SR, lane);
        mma_ldsB<8>(ai, fi_, Bl + bt * 32 * SR, SR, lane);
#pragma unroll
        for (int e = 0; e < 16; ++e) { const int k1 = 32 * a + rowmap(e, hf), m = bt * 32 + l31; const float cs = twc[2 * k1], sn = twc[2 * k1 + 1];
            const float ur = ar[e] * cs + ai[e] * sn, ui = ai[e] * cs - ar[e] * sn;
            bf16* dst = U + (((size_t)b * 64 + k1) * 128 + t2) * 2048 + g * 256 + m;
            dst[0] = f2bf(ur); dst[128] = f2bf(ui); }
    }
#undef F2_LOAD
}
__device__ __forceinline__ void fn_stage3(const Args& A, lptr lds, int tid, int lane, int wave) {
    unsigned char* ws = A.ws;
    const bf16* U = (const bf16*)(ws + WS_G + 64 * MiB); bf16* Fr = (bf16*)(ws + WS_H); const bf16* D128 = (const bf16*)(ws + WS_D128);
    constexpr int SR = 528;
    lptr Bl = lds;
    const int hf = lane >> 5, l31 = lane & 31;
    const int a = wave >> 1, bt0 = (wave & 1) * 2;
    B8 fa_[16];
#pragma unroll
    for (int s = 0; s < 16; ++s) fa_[s] = *(const B8*)(D128 + (size_t)(32 * a + l31) * 256 + hf * 8 + s * 16);
    v4u rr[2][4];
#define F3_LOAD(u_) { const int u2 = (u_); const int b2 = u2 >> 9, k12 = (u2 >> 3) & 63, g2 = u2 & 7; \
        _Pragma("unroll") for (int k = 0; k < 2; ++k) { const int idx = tid + NT * k, tq = idx & 31, pc = idx >> 5; \
            _Pragma("unroll") for (int q = 0; q < 4; ++q) rr[k][q] = *(const v4u*)(U + (((size_t)b2 * 64 + k12) * 128 + 4 * tq + q) * 2048 + g2 * 256 + 8 * pc); } }
    if ((int)blockIdx.x < 1024) F3_LOAD((int)blockIdx.x)
    for (int unit = blockIdx.x; unit < 1024; unit += gridDim.x) {
        const int b = unit >> 9, k1 = (unit >> 3) & 63, g = unit & 7;
        __syncthreads();
#pragma unroll
        for (int k = 0; k < 2; ++k) { const int idx = tid + NT * k, tq = idx & 31, pc = idx >> 5, comp = pc >> 4, m0 = (pc & 15) * 8;
          const unsigned v0[4] = {rr[k][0].x, rr[k][0].y, rr[k][0].z, rr[k][0].w}, v1[4] = {rr[k][1].x, rr[k][1].y, rr[k][1].z, rr[k][1].w}, v2[4] = {rr[k][2].x, rr[k][2].y, rr[k][2].z, rr[k][2].w}, v3[4] = {rr[k][3].x, rr[k][3].y, rr[k][3].z, rr[k][3].w};
          lptr bw = Bl + m0 * SR + (comp * 128 + 4 * tq) * 2;
#pragma unroll
          for (int e = 0; e < 8; ++e) { const int q2 = e >> 1; v2u w;
              if (e & 1) { w.x = (v0[q2] >> 16) | (v1[q2] & 0xffff0000u); w.y = (v2[q2] >> 16) | (v3[q2] & 0xffff0000u); }
              else       { w.x = (v0[q2] & 0xffffu) | (v1[q2] << 16);     w.y = (v2[q2] & 0xffffu) | (v3[q2] << 16); }
              *(LAS v2u*)(bw + e * SR) = w; } }
        if (unit + (int)gridDim.x < 1024) F3_LOAD(unit + (int)gridDim.x)
        __syncthreads();
        F16 c0, c1;
#pragma unroll
        for (int e = 0; e < 16; ++e) { c0[e] = 0.f; c1[e] = 0.f; }
        mma_ldsB<16>(c0, fa_, Bl + bt0 * 32 * SR, SR, lane);
        mma_ldsB<16>(c1, fa_, Bl + (bt0 + 1) * 32 * SR, SR, lane);
#pragma unroll
        for (int e = 0; e < 16; ++e) { const int k2 = 32 * a + rowmap(e, hf); bf16* dst = Fr + ((size_t)b * SEQ + k1 + 64 * k2) * D + g * 128 + bt0 * 32 + l31;
            dst[0] = f2bf(c0[e]); dst[32] = f2bf(c1[e]); }
    }
#undef F3_LOAD
}

#ifdef PROBE_L
#define PROBE_ONE(q, ptr, n) { const unsigned* rp_ = (ptr); const size_t n_ = (n); unsigned long long s = 0ull; for (size_t i = gt; i < n_; i += NGT) s += (unsigned long long)__hip_atomic_load(rp_ + i, __ATOMIC_RELAXED, __HIP_MEMORY_SCOPE_AGENT) * (unsigned long long)(2 * (i & 1023) + 1); atomicAdd(&SV[q], s); }
#define PROBE_CMP(q) { const unsigned long long cur = __hip_atomic_load(&SV[q], __ATOMIC_RELAXED, __HIP_MEMORY_SCOPE_AGENT); if (valid && cur != SV[8 + q]) fl |= (1ull << q); SV[8 + q] = cur; }
#define PROBE_RUN() { FRESH() \
            unsigned long long* SV = (unsigned long long*)(ws + 372 * MiB); \
            PROBE_ONE(0, PROBE_R0, PROBE_N0) PROBE_ONE(1, PROBE_R1, PROBE_N1) PROBE_ONE(2, PROBE_R2, PROBE_N2) PROBE_ONE(3, PROBE_R3, PROBE_N3) \
            GSYNC(); \
            if (blockIdx.x == 0 && tid == 0) { unsigned long long fl = 0ull; const bool valid = (SV[16] == 0x1234567887654321ull); \
                if (valid) fl = SV[17]; \
                PROBE_CMP(0) PROBE_CMP(1) PROBE_CMP(2) PROBE_CMP(3) \
                SV[16] = 0x1234567887654321ull; SV[17] = fl; } \
            GSYNC(); \
            const float scale = 1.f + 0.1f * (float)__hip_atomic_load(&SV[17], __ATOMIC_RELAXED, __HIP_MEMORY_SCOPE_AGENT); \
            for (int row = gw; row < NLAT; row += NGW) for (int j = 0; j < 16; ++j) A.out[(size_t)row * D + lane + 64 * j] = scale * (float)((row * 1024 + lane + 64 * j) % 977) * 0.01f; \
            return; }
#else
#define PROBE_POS -1
#define PROBE_L -1
#define PROBE_RUN() {}
#endif
__global__ void __launch_bounds__(NT, 2) mega_fwd(Args A) {
    extern __shared__ __attribute__((aligned(16))) unsigned char lds_raw[];
    cg::grid_group grid = cg::this_grid();
    lptr lds_raw_l = (lptr)lds_raw;
#ifdef TS_A
    int nts_ = 0; unsigned long long* tsb_ = (unsigned long long*)(A.ws + 373 * MiB + 524288);
    if (blockIdx.x == 0 && threadIdx.x == 0) tsb_[63] = __builtin_amdgcn_s_memrealtime();
#define TSTAMP() do { if (blockIdx.x == 0 && threadIdx.x == 0) tsb_[nts_] = __builtin_amdgcn_s_memrealtime(); ++nts_; } while (0)
#else
#define TSTAMP() do {} while (0)
#endif
    if (threadIdx.x < 4) ((volatile LAS unsigned*)(lds_raw_l + LDS_BYTES - 16))[threadIdx.x] = 0u;
    __syncthreads();
    XcdBarrier xbar = xcd_barrier_post((unsigned*)(A.ws + WS_BAR), (volatile LAS unsigned*)(lds_raw_l + LDS_BYTES - 16));
    grid.sync();
#define GSYNC() do { xcd_barrier(xbar); TSTAMP(); } while (0)
    lptr lds = (lptr)lds_raw;
    const int G = gridDim.x, NGW = G * NWAVES, NGT = G * NT;
#define FRESH() int tid = threadIdx.x; asm volatile("" : "+v"(tid)); const int lane = tid & 63, wave = __builtin_amdgcn_readfirstlane(tid >> 6); const int gw = blockIdx.x * NWAVES + wave, gt = blockIdx.x * NT + tid; (void)gw; (void)gt; (void)lane;
    unsigned char* ws = A.ws;
    const float* MV = (const float*)(ws + WS_MV);
    bf16* XS = (bf16*)(ws + WS_XS); bf16* H = (bf16*)(ws + WS_H); bf16* Y = (bf16*)(ws + WS_Y); bf16* GB = (bf16*)(ws + WS_G);
    const float* norm_g = A.in[6];


#ifndef NO_P0
    { FRESH() p0_prologue(A, lds, tid, lane, wave, 0); }
#ifdef PROBE_L
    if (blockIdx.x == 0 && threadIdx.x < 8) ((unsigned long long*)(ws + 372 * MiB))[threadIdx.x] = 0ull;
#endif
#endif

    GSYNC();
    { FRESH() RowArgs ra{nullptr, A.in[0], A.in[2], nullptr, nullptr, nullptr, nullptr, nullptr, nullptr, H, norm_g, MV, MV + 1024, R}; rowpass(ra, gw, NGW, lane);
      p0_prologue(A, lds, tid, lane, wave, 1); }
    GSYNC();

#pragma unroll 1
#ifndef NLAYERS
#define NLAYERS 4
#endif
    for (int L = 0; L < NLAYERS; ++L) {
        const float* MVL = MV + (size_t)L * 3 * 6144; const float* gL = norm_g + L * 4 * D;
        const int M = (L == 0) ? R : NLAT;
#ifdef SKIPMIX_L
        const bool skipmix = (L == SKIPMIX_L);
#else
        const bool skipmix = false;
#endif
        if (skipmix) {} else
        if (L == 0) {
            pg8::Gemm g{H, (const bf16*)(ws + WS_SSDIN), R, 6400, 1024}; pg8::StaticOrder S; S.init(R, 6400, G, (int)blockIdx.x);
            pg8::EpiSsdIn E{(bf16*)(ws + WS_ZX), (float*)(ws + WS_DT), A.in[12]};

#ifndef NO_GSSD
            pg8::gemm_phase<pg8::EpiSsdIn, pg8::StaticOrder, false, true>(lds, g, S, E);
#endif

        } else {
            pg8::Gemm g; pg8::EpiStore<0> E;
            if (L == 1) { g = pg8::Gemm{H, (const bf16*)(ws + WS_QKVW), R, 3072, 1024}; E = pg8::EpiStore<0>{GB, 3072}; }
            else if (L == 2) { g = pg8::Gemm{H, (const bf16*)(ws + WS_SCIN), NLAT, 3072, 1024}; E = pg8::EpiStore<0>{GB, 3072}; }
            else { g = pg8::Gemm{H, (const bf16*)(ws + WS_CST), NLAT * 8, 256, 128}; E = pg8::EpiStore<0>{GB, 256}; }
            pg8::StaticOrder S; S.init(g.M, g.N, G, (int)blockIdx.x);

#ifndef NO_GIN
            pg8::gemm_phase<pg8::EpiStore<0>, pg8::StaticOrder, true, true>(lds, g, S, E);
#endif

        }
        GSYNC();
#ifdef PROBE_L
        if (PROBE_POS == 0 && L == PROBE_L) PROBE_RUN()
#endif
#ifdef DUMP_P_L
        if (L == DUMP_P_L) { FRESH() const bf16* Pp = (const bf16*)(ws + DUMP_SRC) + DUMP_COL0;
            for (int row = gw; row < NLAT; row += NGW) for (int j = 0; j < 16; ++j) { const size_t ei = (size_t)row * DUMP_LD + lane + 64 * j; const unsigned wv = __hip_atomic_load((const unsigned*)Pp + (ei >> 1), __ATOMIC_RELAXED, __HIP_MEMORY_SCOPE_AGENT);
                A.out[(size_t)row * D + lane + 64 * j] = row < DUMP_ROWS ? ((ei & 1) ? bfhi(wv) : bflo(wv)) : 0.f; }
            return; }
#endif
        const bf16* oA = H; const bf16* oB; int oK = 1024;
        if (L == 0) {

#ifndef NO_SCAN
#ifdef SCAN_DELAY
            for (int q_ = 0; q_ < SCAN_DELAY; ++q_) __builtin_amdgcn_s_sleep(64);
            GSYNC();
#endif
            { FRESH() ssd_act_phase(A, gt, NGT); }
            GSYNC();
            { FRESH() ssd_scan_phase(A, lds, tid, lane, wave); }
            GSYNC();
            { FRESH() ssd_corr_phase(A, lds, tid, lane, wave); }
#endif

            GSYNC();
        if (PROBE_POS == 1 && L == PROBE_L) PROBE_RUN()


#ifndef NO_COMB
            { FRESH() ssd_combine(A, gw, NGW, lane); }
#endif

            GSYNC();
        if (PROBE_POS == 2 && L == PROBE_L) PROBE_RUN()

            oA = (const bf16*)(ws + WS_YN); oB = (const bf16*)(ws + WS_SSDOUT); oK = 2048;
        } else if (L == 1) {

#ifndef NO_NA
            { FRESH() na_phase(A, lds, tid, lane, wave); }
#endif

            GSYNC();
            oB = (const bf16*)(ws + WS_NAOUT);
        } else if (L == 2) {
            if (!skipmix)
#ifndef NO_CONV
            { FRESH() sc_conv_phase(A, gt, NGT); }
#endif

            GSYNC();
            oB = (const bf16*)(ws + WS_SCOUT);
        } else {

#ifndef NO_F2
            { FRESH() fn_stage2(A, lds, tid, lane, wave); }
#endif

            GSYNC();

#ifndef NO_F3
            { FRESH() fn_stage3(A, lds, tid, lane, wave); }
#endif

            GSYNC();
            oB = (const bf16*)(ws + WS_FNW);
        }
#pragma unroll 1
        for (int half = 0; half < 2; ++half) {
            if (half == 1) {
                const bf16* w1 = (const bf16*)(ws + (L == 0 ? WS_W1_0 : WS_W1L + (size_t)(L - 1) * 8 * MiB));
                pg8::Gemm g{H, w1, M, FF, 1024}; pg8::StaticOrder S; S.init(M, FF, G, (int)blockIdx.x); pg8::EpiStore<1> E{GB, FF};
#ifndef NO_MLP1
                pg8::gemm_phase<pg8::EpiStore<1>, pg8::StaticOrder, true, true>(lds, g, S, E);
#endif
                GSYNC();
            }
            const bf16* gA = half ? (const bf16*)GB : oA;
            const bf16* gB = half ? (const bf16*)(ws + (L == 0 ? WS_W2_0 : WS_W2L + (size_t)(L - 1) * 8 * MiB)) : oB;
            const int gK = half ? FF : oK;
            const float* gate = MVL + (half ? 5 : 2) * 1024; const float* gY = gL + (half ? 3 : 1) * D;
            const float* gH = gL + (half ? 4 : 2) * D; const float* shf = half ? MVL + 3 * 6144 : MVL + 3 * 1024; const float* scl = half ? MVL + 3 * 6144 + 1024 : MVL + 4 * 1024;
            const bool last = (L == 3 && half == 1);
            if (L == 0 || G != 256) {
                bf16* YP = (bf16*)(ws + 378 * MiB);
#pragma unroll 1
                for (int part = 0; part < (L == 0 ? 2 : 1); ++part) {
                  pg8::Gemm g{gA, gB, part ? R : NLAT, 1024, part ? gK / 4 : gK, gK}; pg8::StaticOrder S; S.init(g.M, 1024, G, (int)blockIdx.x); S.split = part; S.kbytes = (gK / 4) * 2;
                  pg8::EpiStore<0> E{part ? YP : Y, 1024, part ? (size_t)512 * 1024 : (size_t)0, part ? NLAT : 0};
#ifndef NO_GOUT
                  pg8::gemm_phase<pg8::EpiStore<0>, pg8::StaticOrder, true, true>(lds, g, S, E);
#endif
                }
                GSYNC();
                { FRESH() RowArgs ra{L == 0 ? YP : nullptr, (L == 0 && !half) ? A.in[0] : nullptr, (L == 0 && !half) ? A.in[2] : nullptr, XS, Y, gate, gY, last ? A.out : nullptr, last ? nullptr : XS, last ? nullptr : H, gH, shf, scl, M};
                  rowpass(ra, gw, NGW, lane);
                  if (L == 0 && half == 0) late_weights(A, lds, lane, wave); }
                if (!last) GSYNC();
            } else {
                const int bank = (((L - 1) * 2 + half) * 2);
                unsigned* cnt0 = (unsigned*)(ws + WS_BAR + 65536) + (size_t)bank * 4096; float* sl0 = (float*)(ws + 374 * MiB) + (size_t)bank * 65536;
                pg8::Gemm g{gA, gB, NLAT, 1024, gK}; pg8::StaticOrder S; S.init(NLAT, 1024, G, (int)blockIdx.x);
                pg8::EpiRowFuse E{XS, last ? A.out : nullptr, last ? nullptr : H, gate, gY, gH, shf, scl, pg8::RowStat{sl0, cnt0}, pg8::RowStat{sl0 + 65536, cnt0 + 4096}};
#ifndef NO_MLP2
                pg8::gemm_phase<pg8::EpiRowFuse, pg8::StaticOrder, false, true>(lds, g, S, E);
#endif
                if (!last) GSYNC();
            }
        }
    }
#ifdef TS_A
    GSYNC();
    { const float us_a = 0.01f * (float)(long long)(__hip_atomic_load(&tsb_[TS_B], __ATOMIC_RELAXED, __HIP_MEMORY_SCOPE_AGENT) - __hip_atomic_load(&tsb_[TS_A], __ATOMIC_RELAXED, __HIP_MEMORY_SCOPE_AGENT));
      const float us_c = 0.01f * (float)(long long)(__hip_atomic_load(&tsb_[TS_D], __ATOMIC_RELAXED, __HIP_MEMORY_SCOPE_AGENT) - __hip_atomic_load(&tsb_[TS_C], __ATOMIC_RELAXED, __HIP_MEMORY_SCOPE_AGENT));
      const bool warm_ = (__hip_atomic_load(&tsb_[62], __ATOMIC_RELAXED, __HIP_MEMORY_SCOPE_AGENT) == 0x5555aaaa12345678ull);
      const float sc_ = warm_ ? 1.f + us_a * (1.f / 2000.f) : 1.f; (void)us_c;
      for (size_t i = (size_t)blockIdx.x * NT + threadIdx.x; i < (size_t)NLAT * D; i += (size_t)gridDim.x * NT) { float v = A.out[i] * sc_; A.out[i] = v; } }
    GSYNC();
    if (blockIdx.x == 0 && threadIdx.x == 0) tsb_[62] = 0x5555aaaa12345678ull;
#endif
#if NLAYERS < 4
    { FRESH() for (int row = gw; row < NLAT; row += NGW) for (int j = 0; j < 4; ++j) ((F4*)(A.out + (size_t)row * D))[lane + 64 * j] = ((const F4*)(XS + (size_t)row * D))[lane + 64 * j]; }
#endif
}

extern "C" void kernel_launch(void* const* d_in, const int* in_sizes, int n_in, void* d_out, int out_size, void* d_ws, size_t ws_size, hipStream_t stream) {
    static int grid = 0;
    if (grid == 0) {
        if (n_in != 24 || ws_size < (size_t)382 * MiB) { fprintf(stderr, "kernel_launch: need 24 inputs and %zu bytes of workspace (got %d, %zu)\n", (size_t)WS_END, n_in, ws_size); grid = -1; return; }
        int dev = 0, cus = 0, per_cu = 0;
        hipGetDevice(&dev); hipDeviceGetAttribute(&cus, hipDeviceAttributeMultiprocessorCount, dev);
        if (hipFuncSetAttribute((const void*)mega_fwd, hipFuncAttributeMaxDynamicSharedMemorySize, LDS_BYTES) != hipSuccess) { fprintf(stderr, "kernel_launch: hipFuncSetAttribute failed\n"); grid = -1; return; }
        if (hipOccupancyMaxActiveBlocksPerMultiprocessor(&per_cu, (const void*)mega_fwd, NT, LDS_BYTES) != hipSuccess || per_cu < 1) { fprintf(stderr, "kernel_launch: occupancy query says %d\n", per_cu); per_cu = 1; }
        (void)hipGetLastError();
        grid = cus;
    }
    if (grid < 0) return;
    if (hipMemsetAsync((char*)d_ws + WS_BAR, 0, 262144, stream) != hipSuccess) { fprintf(stderr, "kernel_launch: memset failed\n"); return; }
    Args a{};
    for (int i = 0; i < 24; ++i) a.in[i] = (const float*)d_in[i];
    a.out = (float*)d_out; a.ws = (unsigned char*)d_ws;
    void* args[] = {&a};
    hipError_t e = hipLaunchCooperativeKernel((const void*)mega_fwd, dim3(grid), dim3(NT), args, LDS_BYTES, stream);
    if (e != hipSuccess) fprintf(stderr, "cooperative launch failed: %s (grid %d)\n", hipGetErrorString(e), grid);
}
```

```cpp
#include <hip/hip_runtime.h>
#include <hip/hip_cooperative_groups.h>
#include <cstdio>
#include <cstdint>
namespace cg = cooperative_groups;
namespace pg8 {
#define PG8_LAS __attribute__((address_space(3)))
typedef unsigned short bf16_t;
typedef short bf16x8 __attribute__((ext_vector_type(8)));
typedef float f32x4 __attribute__((ext_vector_type(4)));
typedef unsigned u32x4 __attribute__((ext_vector_type(4)));
constexpr int BM = 256, BK = 64, HALF = 128, HTB = HALF * BK * 2  , STAGE_BYTES = 8 * HTB, NXCD = 8, WGM = 4;

__host__ __device__ __forceinline__ int lds_byte(int r, int c) { const int st = (r >> 4) * 2 + (c >> 5), rr = r & 15, cc = c & 31, ob = rr * 64 + cc * 2; return st * 1024 + (ob ^ (((ob >> 9) & 1) << 5)); }
__host__ __device__ __forceinline__ void stage_rc(int b, int& R, int& C) { const int st = b / 1024, sb = b % 1024, swz = sb ^ (((sb >> 9) & 1) << 5); R = (st >> 1) * 16 + swz / 64; C = (st & 1) * 32 + (swz % 64) / 2; }
__host__ __device__ __forceinline__ int perm32(int rho) { const int n = rho >> 4, i = rho & 15; return 8 * (i >> 2) + 4 * n + (i & 3); }

struct Unit { int pm, pn, ko, ks; };
struct Gemm { const bf16_t* A; const bf16_t* Bt; int M, N, K, ld; };

struct StaticOrder {
    int nM, nN, nwg, G, c, split, kbytes;
    __host__ __device__ void init(int M, int N, int G_, int c_) { nM = M / BM; nN = N / BM; nwg = nM * nN; G = G_; c = c_; split = 0; kbytes = 0; }
    __host__ __device__ bool next(int i, Unit& u) const {
        const long L = (long)i * G + c;
        if (split) { if (L >= 32) return false; const int t = (int)L >> 2; u.ks = (int)L & 3; u.ko = u.ks * kbytes; u.pm = 64 + (t >> 2); u.pn = t & 3; return true; }
        if (L >= nwg) return false;
        u.ko = 0; u.ks = 0;
        int wgid = (int)L; { const int q = nwg / NXCD, r = nwg % NXCD, xcd = wgid % NXCD, off = wgid / NXCD; wgid = (xcd < r ? xcd * (q + 1) : r * (q + 1) + (xcd - r) * q) + off; }
        const int nig = WGM * nN, gid = wgid / nig, fm = gid * WGM, gsz = (nM - fm) < WGM ? (nM - fm) : WGM;
        u.pm = fm + ((wgid % nig) % gsz); u.pn = (wgid % nig) / gsz; return true;
    }
    __device__ __forceinline__ void a_ready(const Unit&) const {}
    __device__ __forceinline__ void done(const Unit&) const {}
};

typedef float f32x2_cv __attribute__((ext_vector_type(2))); typedef __bf16 bf16x2_cv __attribute__((ext_vector_type(2)));
__device__ __forceinline__ unsigned cvt_pk_bf16(float lo, float hi) { const f32x2_cv v = {lo, hi}; const bf16x2_cv b = __builtin_convertvector(v, bf16x2_cv); return __builtin_bit_cast(unsigned, b); }
typedef float f32x2 __attribute__((ext_vector_type(2)));
template <int ACT> struct EpiStore {
    static constexpr bool PERM = true, AFTER_DRAIN = false;
    bf16_t* O; int ldc; size_t kstride; int rowsub;
    __device__ __forceinline__ void operator()(const f32x4 (&acc)[2][2][4][2], const Unit& u, int wr, int wc, int fr, int fq) const {
        bf16_t* O = this->O + (size_t)u.ks * kstride;
        const int row0 = u.pm * BM + wr * 64 + fr - rowsub; const int col0 = u.pn * BM + wc * 32 + 8 * fq;
#pragma unroll
        for (int ai = 0; ai < 2; ++ai)
#pragma unroll
            for (int m = 0; m < 4; ++m) { bf16_t* rowp = O + (size_t)(row0 + ai * HALF + m * 16) * ldc + col0;
#pragma unroll
                for (int bj = 0; bj < 2; ++bj) { f32x4 v0 = acc[ai][bj][m][0], v1 = acc[ai][bj][m][1];
                    if (ACT == 1) {
#pragma unroll
                        for (int e = 0; e < 4; ++e) { float a = v0[e] > 0.f ? v0[e] : 0.f; v0[e] = a * a; float b = v1[e] > 0.f ? v1[e] : 0.f; v1[e] = b * b; } }
                    u32x4 w; w.x = cvt_pk_bf16(v0[0], v0[1]); w.y = cvt_pk_bf16(v0[2], v0[3]); w.z = cvt_pk_bf16(v1[0], v1[1]); w.w = cvt_pk_bf16(v1[2], v1[3]);
                    *(u32x4*)(rowp + bj * HALF) = w; } }
    }
};
struct EpiSsdIn {
    static constexpr bool PERM = true, AFTER_DRAIN = false;
    bf16_t* ZX; float* DT; const float* dt_bias;
    __device__ __forceinline__ void operator()(const f32x4 (&acc)[2][2][4][2], const Unit& u, int wr, int wc, int fr, int fq) const {
        const int row0 = u.pm * BM + wr * 64 + fr;
        if (u.pn < 24) {
            const int col0 = u.pn * BM + wc * 32 + 8 * fq;
#pragma unroll
            for (int ai = 0; ai < 2; ++ai)
#pragma unroll
                for (int m = 0; m < 4; ++m) { bf16_t* rowp = ZX + (size_t)(row0 + ai * HALF + m * 16) * 6144 + col0;
#pragma unroll
                    for (int bj = 0; bj < 2; ++bj) { const f32x4 v0 = acc[ai][bj][m][0], v1 = acc[ai][bj][m][1];
                        u32x4 w; w.x = cvt_pk_bf16(v0[0], v0[1]); w.y = cvt_pk_bf16(v0[2], v0[3]); w.z = cvt_pk_bf16(v1[0], v1[1]); w.w = cvt_pk_bf16(v1[2], v1[3]);
                        *(u32x4*)(rowp + bj * HALF) = w; } }
        } else if (wc < 2) {
            const int col0 = wc * 32 + 8 * fq;
#pragma unroll
            for (int ai = 0; ai < 2; ++ai)
#pragma unroll
                for (int m = 0; m < 4; ++m) { float* rowp = DT + (size_t)(row0 + ai * HALF + m * 16) * 64 + col0;
#pragma unroll
                    for (int n = 0; n < 2; ++n) { f32x4 v = acc[ai][0][m][n]; f32x4 o;
#pragma unroll
                        for (int e = 0; e < 4; ++e) o[e] = v[e];
                        *(f32x4*)(rowp + 4 * n) = o; } }
        }
    }
};

struct RowStat {
    float* slots; unsigned* cnt;
    __device__ __forceinline__ void run(const f32x4 (&v)[2][2][4][2], const Unit& u, int wr, int wc, int fr, int fq, PG8_LAS unsigned char* lds, int tid, int lane) const {
        PG8_LAS float* P = (PG8_LAS float*)lds;
        PG8_LAS float* S = (PG8_LAS float*)(lds + 4096);
#pragma unroll
        for (int ai = 0; ai < 2; ++ai)
#pragma unroll
            for (int m = 0; m < 4; ++m) { float q = 0.f;
#pragma unroll
                for (int bj = 0; bj < 2; ++bj)
#pragma unroll
                    for (int n = 0; n < 2; ++n) { const f32x4 x = v[ai][bj][m][n]; q += (x[0] * x[0] + x[1] * x[1]) + (x[2] * x[2] + x[3] * x[3]); }
                q += __shfl_xor(q, 16); q += __shfl_xor(q, 32);
                if (fq == 0) P[(ai * HALF + wr * 64 + m * 16 + fr) * 4 + wc] = q; }
        asm volatile("s_waitcnt lgkmcnt(0)" ::: "memory"); __builtin_amdgcn_s_barrier(); asm volatile("" ::: "memory");
        if (tid < 256) { const float q = (P[tid * 4 + 0] + P[tid * 4 + 1]) + (P[tid * 4 + 2] + P[tid * 4 + 3]);
            __hip_atomic_store(slots + (size_t)(u.pm * BM + tid) * 4 + u.pn, q, __ATOMIC_RELAXED, __HIP_MEMORY_SCOPE_AGENT);
            asm volatile("s_waitcnt vmcnt(0)" ::: "memory");
            if (lane == 0) __hip_atomic_fetch_add(cnt + 64 * u.pm, 1u, __ATOMIC_RELAXED, __HIP_MEMORY_SCOPE_AGENT); }
        if (tid < 64) { while ((unsigned)__builtin_amdgcn_readfirstlane(__hip_atomic_load(cnt + 64 * u.pm, __ATOMIC_RELAXED, __HIP_MEMORY_SCOPE_AGENT)) < 16u) __builtin_amdgcn_s_sleep(1);
            __builtin_amdgcn_fence(__ATOMIC_ACQUIRE, "agent"); }
        asm volatile("s_waitcnt vmcnt(0) lgkmcnt(0)" ::: "memory"); __builtin_amdgcn_s_barrier(); asm volatile("" ::: "memory");
        if (tid < 256) { const float* sl = slots + (size_t)(u.pm * BM + tid) * 4; float q = 0.f;
#pragma unroll
            for (int t4 = 0; t4 < 4; ++t4) q += __hip_atomic_load(sl + t4, __ATOMIC_RELAXED, __HIP_MEMORY_SCOPE_AGENT);
            S[tid] = rsqrtf(q * (1.f / 1024.f) + 1e-6f); }
        asm volatile("s_waitcnt vmcnt(0) lgkmcnt(0)" ::: "memory"); __builtin_amdgcn_s_barrier(); asm volatile("" ::: "memory");
    }
};
struct EpiRowFuse {
    static constexpr bool PERM = false, AFTER_DRAIN = true;
    bf16_t* XS; float* outF; bf16_t* H;
    const float* gate; const float* gY; const float* gH; const float* shift; const float* scale;
    RowStat st1, st2;
    __device__ __forceinline__ void fused(f32x4 (&acc)[2][2][4][2], const Unit& u, int wr, int wc, int fr, int fq, PG8_LAS unsigned char* lds, int wid, int lane) const {
        const int tid = wid * 64 + lane; const int set = u.pm >= 32 ? 1 : 0;
        const PG8_LAS float* S = (const PG8_LAS float*)(lds + 4096);
        const int col0 = u.pn * BM + wc * 32 + 4 * fq;
        st1.run(acc, u, wr, wc, fr, fq, lds, tid, lane);
        typedef unsigned u32x2v __attribute__((ext_vector_type(2)));
#pragma unroll
        for (int bj = 0; bj < 2; ++bj)
#pragma unroll
            for (int n = 0; n < 2; ++n) { const int c = col0 + bj * HALF + n * 16;
                const f32x4 g4 = *(const f32x4*)(gate + set * 6144 + c), gy = *(const f32x4*)(gY + c);
#pragma unroll
                for (int ai = 0; ai < 2; ++ai)
#pragma unroll
                    for (int m = 0; m < 4; ++m) { const int r = ai * HALF + wr * 64 + m * 16 + fr; const size_t off = (size_t)(u.pm * BM + r) * 1024 + c;
                        const u32x2v w = *(const u32x2v*)(XS + off);
                        f32x4 t; t[0] = __builtin_bit_cast(float, w.x << 16); t[1] = __builtin_bit_cast(float, w.x & 0xffff0000u); t[2] = __builtin_bit_cast(float, w.y << 16); t[3] = __builtin_bit_cast(float, w.y & 0xffff0000u);
                        t = t + g4 * ((acc[ai][bj][m][n] * S[r]) * gy);
                        if (outF) { *(f32x4*)(outF + off) = t; }
                        else { u32x2v o; o.x = cvt_pk_bf16(t[0], t[1]); o.y = cvt_pk_bf16(t[2], t[3]); *(u32x2v*)(XS + off) = o;
                            t[0] = __builtin_bit_cast(float, o.x << 16); t[1] = __builtin_bit_cast(float, o.x & 0xffff0000u); t[2] = __builtin_bit_cast(float, o.y << 16); t[3] = __builtin_bit_cast(float, o.y & 0xffff0000u); }
                        acc[ai][bj][m][n] = t; } }
        if (H) {
            st2.run(acc, u, wr, wc, fr, fq, lds, tid, lane);
#pragma unroll
            for (int bj = 0; bj < 2; ++bj)
#pragma unroll
                for (int n = 0; n < 2; ++n) { const int c = col0 + bj * HALF + n * 16;
                    const f32x4 g = *(const f32x4*)(gH + c), sh = *(const f32x4*)(shift + set * 6144 + c), sc = *(const f32x4*)(scale + set * 6144 + c);
#pragma unroll
                    for (int ai = 0; ai < 2; ++ai)
#pragma unroll
                        for (int m = 0; m < 4; ++m) { const int r = ai * HALF + wr * 64 + m * 16 + fr; const size_t off = (size_t)(u.pm * BM + r) * 1024 + c;
                            const f32x4 hv = ((acc[ai][bj][m][n] * S[r]) * g) * (sc + 1.f) + sh;
                            u32x2v o; o.x = cvt_pk_bf16(hv[0], hv[1]); o.y = cvt_pk_bf16(hv[2], hv[3]); *(u32x2v*)(H + off) = o; } }
        }
    }
};
#ifndef PG8_AUX
#define PG8_AUX 0
#endif

template <class Epi, class Sched, bool ALIGN_EPI = false, bool SP2 = false>
__device__ __forceinline__ void gemm_phase(PG8_LAS unsigned char* lds, const Gemm g, const Sched& S, const Epi& E) {
    int tid_l = threadIdx.x; asm volatile("" : "+v"(tid_l)); const int tid = tid_l, wid = __builtin_amdgcn_readfirstlane(tid >> 6), lane = tid & 63, wr = wid >> 2, wc = wid & 3, fr = lane & 15, fq = lane >> 4;
    const int K = g.K, nt = K / BK, LD = g.ld ? g.ld : g.K;
    unsigned voffA[2], voffB[2];
#pragma unroll
    for (int i = 0; i < 2; ++i) { int R, C; stage_rc(tid * 16 + i * 8192, R, C); const int Rb = Epi::PERM ? ((R & ~31) + perm32(R & 31)) : R;
        voffA[i] = (unsigned)(R * LD + C) * 2u; voffB[i] = (unsigned)(Rb * LD + C) * 2u; }
    const size_t kstep = (size_t)(BK * 2);
    const size_t hstep = (size_t)HALF * LD * 2;
    const size_t tstep = 2 * hstep;
    const unsigned ldsw = (unsigned)wid * 1024u;
    const int aoff = lds_byte(wr * 64 + fr, fq * 8), boff = lds_byte(wc * 32 + fr, fq * 8);
#define PG8_SA(b, h) (((b) * 2 + (h)) * HTB)
#define PG8_SB(b, h) ((4 + (b) * 2 + (h)) * HTB)
#define PG8_STAGE(bufoff, gbase, voff) do { _Pragma("unroll") for (int _i = 0; _i < 2; ++_i) \
        __builtin_amdgcn_global_load_lds((const unsigned*)((const char*)(gbase) + (voff)[_i]), (PG8_LAS unsigned*)(lds + (bufoff) + ldsw + _i * 8192), 16, 0, PG8_AUX); } while (0)
#define PG8_LDA(dst, b, h) do { _Pragma("unroll") for (int m = 0; m < 4; ++m) _Pragma("unroll") for (int k = 0; k < 2; ++k) dst[m][k] = *(const PG8_LAS bf16x8*)(lds + PG8_SA(b, h) + aoff + m * 2048 + k * 1024); } while (0)
#define PG8_LDB(dst, b, h) do { _Pragma("unroll") for (int n = 0; n < 2; ++n) _Pragma("unroll") for (int k = 0; k < 2; ++k) dst[n][k] = *(const PG8_LAS bf16x8*)(lds + PG8_SB(b, h) + boff + n * 2048 + k * 1024); } while (0)
#define PG8_MMA(ai, bj, At, Bt) do { __builtin_amdgcn_s_setprio(1); _Pragma("unroll") for (int m = 0; m < 4; ++m) _Pragma("unroll") for (int n = 0; n < 2; ++n) _Pragma("unroll") for (int k = 0; k < 2; ++k) \
        acc[ai][bj][m][n] = __builtin_amdgcn_mfma_f32_16x16x32_bf16(Bt[n][k], At[m][k], acc[ai][bj][m][n], 0, 0, 0); __builtin_amdgcn_s_setprio(0); } while (0)
#define PG8_WAIT_V(n) asm volatile("s_waitcnt vmcnt(" #n ")" ::: "memory")
#define PG8_WAIT_L(n) asm volatile("s_waitcnt lgkmcnt(" #n ")" ::: "memory")
#define PG8_BAR __builtin_amdgcn_s_barrier()
#define PG8_SCHED __builtin_amdgcn_sched_barrier(0)
    Unit cur, nxt; int ui = 0;
    if (!S.next(0, cur)) return;
    f32x4 acc[2][2][4][2];
#pragma unroll
    for (int a = 0; a < 2; ++a)
#pragma unroll
        for (int b = 0; b < 2; ++b)
#pragma unroll
            for (int m = 0; m < 4; ++m)
#pragma unroll
                for (int n = 0; n < 2; ++n) acc[a][b][m][n] = (f32x4){0.f, 0.f, 0.f, 0.f};
    bf16x8 At[4][2], B0[2][2], B1[2][2];
    const char* cA = (const char*)g.A + (size_t)cur.pm * tstep + cur.ko; const char* cB = (const char*)g.Bt + (size_t)cur.pn * tstep + cur.ko;
    S.a_ready(cur);
    if constexpr (SP2) {
        PG8_STAGE(PG8_SB(0, 0), cB, voffB); PG8_STAGE(PG8_SB(0, 1), cB + hstep, voffB); PG8_STAGE(PG8_SA(0, 0), cA, voffA); PG8_STAGE(PG8_SA(0, 1), cA + hstep, voffA);
        if (wr == 1) PG8_BAR;
        PG8_WAIT_V(2); PG8_BAR;
        PG8_STAGE(PG8_SB(1, 0), cB + kstep, voffB); PG8_STAGE(PG8_SA(1, 0), cA + kstep, voffA); PG8_STAGE(PG8_SB(1, 1), cB + hstep + kstep, voffB);
        PG8_WAIT_V(6); PG8_BAR;
    } else {
        PG8_STAGE(PG8_SB(0, 0), cB, voffB); PG8_STAGE(PG8_SA(0, 0), cA, voffA); PG8_STAGE(PG8_SB(0, 1), cB + hstep, voffB); PG8_STAGE(PG8_SA(0, 1), cA + hstep, voffA);
        if (wr == 1) PG8_BAR;
        PG8_WAIT_V(4); PG8_BAR;
        PG8_STAGE(PG8_SB(1, 0), cB + kstep, voffB); PG8_STAGE(PG8_SA(1, 0), cA + kstep, voffA); PG8_STAGE(PG8_SB(1, 1), cB + hstep + kstep, voffB);
        PG8_WAIT_V(6); PG8_BAR;
    }
    for (;;) {
        const bool has_next = S.next(ui + 1, nxt);
        const char* nA = has_next ? (const char*)g.A + (size_t)nxt.pm * tstep + nxt.ko : cA; const char* nB = has_next ? (const char*)g.Bt + (size_t)nxt.pn * tstep + nxt.ko : cB;
        for (int t = 0; t < nt; t += 2) {
            const bool last = (t == nt - 2);
            const char* a1 = cA + (size_t)(t + 1) * kstep;
            const char* a2 = last ? nA : cA + (size_t)(t + 2) * kstep; const char* b2 = last ? nB : cB + (size_t)(t + 2) * kstep;
            const char* a3 = a2 + kstep; const char* b3 = b2 + kstep;
            if (last && has_next) S.a_ready(nxt);
            if constexpr (SP2) {
            PG8_LDB(B0, 0, 0); PG8_LDB(B1, 0, 1); PG8_SCHED; PG8_LDA(At, 0, 0); PG8_STAGE(PG8_SA(1, 1), a1 + hstep, voffA);
            PG8_WAIT_V(8); PG8_WAIT_L(0); PG8_BAR; PG8_MMA(0, 0, At, B0); PG8_MMA(0, 1, At, B1); PG8_BAR; PG8_SCHED;
            PG8_LDA(At, 0, 1); PG8_STAGE(PG8_SB(0, 0), b2, voffB); PG8_STAGE(PG8_SB(0, 1), b2 + hstep, voffB); PG8_STAGE(PG8_SA(0, 0), a2, voffA);
            PG8_WAIT_V(8); PG8_WAIT_L(0); PG8_BAR; PG8_MMA(1, 0, At, B0); PG8_MMA(1, 1, At, B1); PG8_BAR; PG8_SCHED;
            PG8_LDB(B0, 1, 0); PG8_LDB(B1, 1, 1); PG8_SCHED; PG8_LDA(At, 1, 0); PG8_STAGE(PG8_SA(0, 1), a2 + hstep, voffA);
            PG8_WAIT_V(8); PG8_WAIT_L(0); PG8_BAR; PG8_MMA(0, 0, At, B0); PG8_MMA(0, 1, At, B1); PG8_BAR; PG8_SCHED;
            PG8_LDA(At, 1, 1); PG8_STAGE(PG8_SB(1, 0), b3, voffB); PG8_STAGE(PG8_SB(1, 1), b3 + hstep, voffB); PG8_STAGE(PG8_SA(1, 0), a3, voffA);
            PG8_WAIT_V(8); PG8_WAIT_L(0); PG8_BAR; PG8_MMA(1, 0, At, B0); PG8_MMA(1, 1, At, B1); PG8_BAR; PG8_SCHED;
            } else {
            PG8_LDB(B0, 0, 0); PG8_SCHED; PG8_LDA(At, 0, 0); PG8_STAGE(PG8_SA(1, 1), a1 + hstep, voffA);
            PG8_WAIT_L(8); PG8_BAR; PG8_WAIT_L(0); PG8_MMA(0, 0, At, B0); PG8_BAR; PG8_SCHED;
            PG8_LDB(B1, 0, 1); PG8_STAGE(PG8_SB(0, 0), b2, voffB);
            PG8_BAR; PG8_WAIT_L(0); PG8_MMA(0, 1, At, B1); PG8_BAR;
            PG8_LDA(At, 0, 1); PG8_STAGE(PG8_SA(0, 0), a2, voffA);
            PG8_BAR; PG8_WAIT_L(0); PG8_MMA(1, 0, At, B0); PG8_BAR; PG8_SCHED;
            PG8_STAGE(PG8_SB(0, 1), b2 + hstep, voffB);
            PG8_WAIT_V(6); PG8_BAR; PG8_MMA(1, 1, At, B1); PG8_BAR;
            PG8_LDB(B0, 1, 0); PG8_SCHED; PG8_LDA(At, 1, 0); PG8_STAGE(PG8_SA(0, 1), a2 + hstep, voffA);
            PG8_WAIT_L(8); PG8_BAR; PG8_WAIT_L(0); PG8_MMA(0, 0, At, B0); PG8_BAR; PG8_SCHED;
            PG8_LDB(B1, 1, 1); PG8_STAGE(PG8_SB(1, 0), b3, voffB);
            PG8_BAR; PG8_WAIT_L(0); PG8_MMA(0, 1, At, B1); PG8_BAR;
            PG8_LDA(At, 1, 1); PG8_STAGE(PG8_SA(1, 0), a3, voffA);
            PG8_BAR; PG8_WAIT_L(0); PG8_MMA(1, 0, At, B0); PG8_BAR; PG8_SCHED;
            PG8_STAGE(PG8_SB(1, 1), b3 + hstep, voffB);
            PG8_WAIT_V(6); PG8_BAR; PG8_MMA(1, 1, At, B1); PG8_BAR;
            }
        }
        if constexpr (ALIGN_EPI) { if (wr == 0) PG8_BAR; }
        if constexpr (!Epi::AFTER_DRAIN) { E(acc, cur, wr, wc, fr, fq); S.done(cur);
#ifdef EPI_DRAIN
        PG8_WAIT_V(0);
#endif
        }
        if (!has_next) break;
#pragma unroll
        for (int a = 0; a < 2; ++a)
#pragma unroll
            for (int b = 0; b < 2; ++b)
#pragma unroll
                for (int m = 0; m < 4; ++m)
#pragma unroll
                    for (int n = 0; n < 2; ++n) acc[a][b][m][n] = (f32x4){0.f, 0.f, 0.f, 0.f};
        cur = nxt; cA = nA; cB = nB; ++ui;
        if constexpr (ALIGN_EPI) { if (wr == 1) PG8_BAR; }
    }
    PG8_WAIT_V(0);
    if constexpr (!ALIGN_EPI) { if (wr == 0) PG8_BAR; }
    PG8_BAR;
    if constexpr (Epi::AFTER_DRAIN) { E.fused(acc, cur, wr, wc, fr, fq, lds, wid, lane); S.done(cur); }
#undef PG8_SA
#undef PG8_SB
#undef PG8_STAGE
#undef PG8_LDA
#undef PG8_LDB
#undef PG8_MMA
#undef PG8_WAIT_V
#undef PG8_WAIT_L
#undef PG8_BAR
#undef PG8_SCHED
}
}
#define LAS __attribute__((address_space(3)))
typedef unsigned short bf16;
typedef unsigned v4u __attribute__((ext_vector_type(4)));
typedef unsigned v2u __attribute__((ext_vector_type(2)));
typedef float F4 __attribute__((ext_vector_type(4)));
typedef float F16 __attribute__((ext_vector_type(16)));
typedef short B8 __attribute__((ext_vector_type(8)));
typedef short S4 __attribute__((ext_vector_type(4)));
typedef LAS unsigned char* lptr;

constexpr int NT = 512, NWAVES = 8;
constexpr int D = 1024, SEQ = 8192, NLAT = 16384, CTXL = 256, R = 16896, FF = 4096;
constexpr int LDS_BYTES = 155648;
constexpr size_t MiB = 1u << 20;
constexpr size_t WS_MV = 0, WS_CST = 512 * 1024, WS_D64 = 576 * 1024, WS_D128 = 640 * 1024, WS_TW = 704 * 1024;
constexpr size_t WS_BAR = 1 * MiB;
constexpr size_t WS_XS = 4 * MiB, WS_H = 70 * MiB, WS_Y = 103 * MiB;
constexpr size_t WS_SSDIN = 136 * MiB, WS_SSDOUT = WS_SSDIN + 6400ull * 1024 * 2, WS_W1_0 = WS_SSDOUT + 4 * MiB, WS_W2_0 = WS_W1_0 + 8 * MiB;
constexpr size_t WS_WL = WS_W2_0 + 8 * MiB;
#ifdef SWAP_W
constexpr size_t WS_W1L = WS_WL, WS_W2L = WS_W1L + 24 * MiB, WS_SCIN = WS_W2L + 24 * MiB, WS_NAOUT = WS_SCIN + 6 * MiB, WS_QKVW = WS_NAOUT + 2 * MiB;
#define WS_SCIN_END (WS_QKVW + 6 * MiB)
#else
constexpr size_t WS_W1L = WS_WL, WS_W2L = WS_W1L + 24 * MiB, WS_QKVW = WS_W2L + 24 * MiB, WS_NAOUT = WS_QKVW + 6 * MiB, WS_SCIN = WS_NAOUT + 2 * MiB;
#define WS_SCIN_END (WS_SCIN + 6 * MiB)
#endif

    constexpr size_t WS_SCOUT = WS_SCIN_END, WS_FNW = WS_SCOUT + 2 * MiB;
constexpr size_t WS_G = WS_FNW + 2 * MiB;
constexpr size_t WS_ZX = WS_WL;
constexpr size_t WS_DT = WS_G + 132 * MiB;
constexpr size_t WS_END = WS_DT + (size_t)R * 64 * 4;
constexpr size_t WS_ACT = WS_XS;
constexpr size_t WS_YN = WS_XS;
static_assert(WS_ACT + (size_t)R * 4096 * 2 == WS_SSDIN, "ACT fills XS|H|Y exactly");
static_assert(WS_WL == 168 * MiB + MiB / 2 && WS_G == 234 * MiB + MiB / 2, "map");
static_assert(WS_ZX + (size_t)R * 6144 * 2 == WS_DT, "ZX fills later-weights + G");
static_assert(WS_H + (size_t)R * D * 2 == WS_Y && WS_Y + (size_t)R * D * 2 == WS_SSDIN && WS_XS + (size_t)R * D * 4 == WS_H, "map2");

struct Args { const float* in[24]; float* out; unsigned char* ws; };

__device__ __forceinline__ unsigned pk2(float lo, float hi) { return pg8::cvt_pk_bf16(lo, hi); }
__device__ __forceinline__ float bflo(unsigned w) { return __builtin_bit_cast(float, w << 16); }
__device__ __forceinline__ float bfhi(unsigned w) { return __builtin_bit_cast(float, w & 0xffff0000u); }
__device__ __forceinline__ float bf2f(unsigned short b) { return __builtin_bit_cast(float, (unsigned)b << 16); }
__device__ __forceinline__ unsigned short f2bf(float f) { return (unsigned short)(pk2(f, 0.f) & 0xffffu); }
__device__ __forceinline__ float wave_sum(float v) {
#pragma unroll
    for (int o = 1; o < 64; o <<= 1) v += __shfl_xor(v, o);
    return v;
}
__device__ __forceinline__ float silu_f(float v) { return v * __builtin_amdgcn_rcpf(1.f + __expf(-v)); }
__device__ __forceinline__ int rowmap(int reg, int hf) { return (reg & 3) + 8 * (reg >> 2) + 4 * hf; }
#define LDS_WAIT() asm volatile("s_waitcnt lgkmcnt(0)" ::: "memory")

template <int KS> __device__ __forceinline__ void mma_lds(F16& acc, lptr A, int sa, lptr B, int sb, int lane) {
    const int r = lane & 31, h = lane >> 5;
    lptr pa = A + r * sa + h * 16; lptr pb = B + r * sb + h * 16;
    B8 a[KS], b[KS];
#pragma unroll
    for (int s = 0; s < KS; ++s) { a[s] = *(const LAS B8*)(pa + s * 32); b[s] = *(const LAS B8*)(pb + s * 32); }
#pragma unroll
    for (int s = 0; s < KS; ++s) acc = __builtin_amdgcn_mfma_f32_32x32x16_bf16(a[s], b[s], acc, 0, 0, 0);
}
template <int KS> __device__ __forceinline__ void mma_ldsB(F16& acc, const B8 (&a)[KS], lptr B, int sb, int lane) {
    const int r = lane & 31, h = lane >> 5; lptr pb = B + r * sb + h * 16;
    B8 b[KS];
#pragma unroll
    for (int s = 0; s < KS; ++s) b[s] = *(const LAS B8*)(pb + s * 32);
#pragma unroll
    for (int s = 0; s < KS; ++s) acc = __builtin_amdgcn_mfma_f32_32x32x16_bf16(a[s], b[s], acc, 0, 0, 0);
}
template <int KS> __device__ __forceinline__ void mma_lds_swz(F16& acc, lptr A, int sa, int zA0, int maskA, lptr B, int sb, int zB0, int maskB, int lane) {
    const int r = lane & 31, h = lane >> 5;
    lptr pa = A + r * sa; lptr pb = B + r * sb; const int za = (zA0 + (r >> 3)) & maskA, zb = (zB0 + (r >> 3)) & maskB;
    B8 a[KS], b[KS];
#pragma unroll
    for (int s = 0; s < KS; ++s) { a[s] = *(const LAS B8*)(pa + (((2 * s + h) ^ za) << 4)); b[s] = *(const LAS B8*)(pb + (((2 * s + h) ^ zb) << 4)); }
#pragma unroll
    for (int s = 0; s < KS; ++s) acc = __builtin_amdgcn_mfma_f32_32x32x16_bf16(a[s], b[s], acc, 0, 0, 0);
}
__device__ __forceinline__ void mma_lds_swz_rt(F16& acc, lptr A, int sa, int zA0, int maskA, lptr B, int sb, int zB0, int maskB, int lane, int ks) {
    const int r = lane & 31, h = lane >> 5;
    lptr pa = A + r * sa; lptr pb = B + r * sb; const int za = (zA0 + (r >> 3)) & maskA, zb = (zB0 + (r >> 3)) & maskB;
#pragma unroll 2
    for (int s = 0; s < ks; ++s) { const B8 a = *(const LAS B8*)(pa + (((2 * s + h) ^ za) << 4)); const B8 b = *(const LAS B8*)(pb + (((2 * s + h) ^ zb) << 4)); acc = __builtin_amdgcn_mfma_f32_32x32x16_bf16(a, b, acc, 0, 0, 0); }
}
template <int KS> __device__ __forceinline__ void mma_gA(F16& acc, const bf16* A, int lda, lptr B, int sb, int lane) {
    const int r = lane & 31, h = lane >> 5;
    const bf16* pa = A + (size_t)r * lda + h * 8; lptr pb = B + r * sb + h * 16;
#pragma unroll
    for (int s = 0; s < KS; ++s) { const B8 a = *(const B8*)(pa + s * 16); const B8 b = *(const LAS B8*)(pb + s * 32); acc = __builtin_amdgcn_mfma_f32_32x32x16_bf16(a, b, acc, 0, 0, 0); }
}

#define XB_TMO      128
#define XB_XCNT(j)  (256  + 64 * (j))
#define XB_XSUB(j)  (1280 + 64 * (j))
#define XB_XGEN(j)  (2304 + 64 * (j))
#define XB_TOP      3328
#define XB_TOPGEN   3392
#define XCD_BAR_WORDS 3456
#define XB_SPIN_CAP (1u << 18)

__device__ __forceinline__ unsigned xb_ld(unsigned* p)              { return __hip_atomic_load(p, __ATOMIC_RELAXED, __HIP_MEMORY_SCOPE_AGENT); }
__device__ __forceinline__ unsigned xb_add(unsigned* p, unsigned v) { return __hip_atomic_fetch_add(p, v, __ATOMIC_RELAXED, __HIP_MEMORY_SCOPE_AGENT); }
__device__ __forceinline__ unsigned xb_xcc_id() { return (unsigned)__builtin_amdgcn_s_getreg((3 << 11) | 20) & 0xFu; }
#define XB_SPIN(cond, bar) do { unsigned _sp = 0; while (cond) { __builtin_amdgcn_s_sleep(1); \
    if ((++_sp & 255u) == 0u) { if (xb_ld(&(bar)[XB_TMO])) break; if (_sp > XB_SPIN_CAP) { atomicAdd(&(bar)[XB_TMO], 1u); break; } } } } while (0)

struct XcdBarrier {
    unsigned* bar; unsigned x;
    volatile LAS unsigned* st;
};

__device__ __forceinline__ XcdBarrier xcd_barrier_post(unsigned* bar, volatile LAS unsigned* st) {
    XcdBarrier b; b.bar = bar; b.x = xb_xcc_id(); b.st = st;
    if (threadIdx.x == 0) (void)xb_add(&bar[XB_XCNT(b.x)], 1u);
    return b;
}
__device__ __forceinline__ void xcd_barrier_complete(unsigned* bar, unsigned x, unsigned& nloc, unsigned& nx) {
    const unsigned G = gridDim.x * gridDim.y * gridDim.z;
    unsigned sum, cnt, mine, sp = 0u;
    for (;;) {
        sum = 0u; cnt = 0u; mine = 0u;
#pragma unroll
        for (unsigned j = 0; j < 16; ++j) { const unsigned c = xb_ld(&bar[XB_XCNT(j)]); sum += c; cnt += (c > 0u) ? 1u : 0u; mine = (j == x) ? c : mine; }
        if (sum == G) break;
        __builtin_amdgcn_s_sleep(1);
        if ((++sp & 255u) == 0u) { if (xb_ld(&bar[XB_TMO])) break; if (sp > XB_SPIN_CAP) { atomicAdd(&bar[XB_TMO], 1u); break; } }
    }
    nloc = mine > 0u ? mine : 1u; nx = cnt > 0u ? cnt : 1u;
}

__device__ __forceinline__ void xcd_barrier(const XcdBarrier& b) {
    asm volatile("s_waitcnt vmcnt(0)" ::: "memory");
    __syncthreads();
    if (threadIdx.x == 0) {
        unsigned* bar = b.bar;
        __builtin_amdgcn_s_waitcnt(0);
        unsigned nloc = b.st[0], nx = b.st[1];
        if (nloc == 0u) { xcd_barrier_complete(bar, b.x, nloc, nx); b.st[0] = nloc; b.st[1] = nx; }
        const unsigned old = xb_add(&bar[XB_XSUB(b.x)], 1u);
        const unsigned gen = old / nloc;
        if (old + 1u == (gen + 1u) * nloc) {
            __builtin_amdgcn_fence(__ATOMIC_RELEASE, "agent");
            asm volatile("s_waitcnt vmcnt(0)" ::: "memory");
            const unsigned og = xb_add(&bar[XB_TOP], 1u);
            const unsigned tg = og / nx;
            if (og + 1u == (tg + 1u) * nx) xb_add(&bar[XB_TOPGEN], 1u);
            else XB_SPIN(xb_ld(&bar[XB_TOPGEN]) == tg, bar);
            __builtin_amdgcn_fence(__ATOMIC_ACQUIRE, "agent");
            xb_add(&bar[XB_XGEN(b.x)], 1u);
            asm volatile("s_waitcnt vmcnt(0)" ::: "memory");
        } else {
            XB_SPIN(xb_ld(&bar[XB_XGEN(b.x)]) == gen, bar);
            __builtin_amdgcn_fence(__ATOMIC_ACQUIRE, "agent");
            asm volatile("s_waitcnt vmcnt(0)" ::: "memory");
        }
    }
    __syncthreads();
}

__device__ __forceinline__ void transpose_item(const float* W, int K, int N, bf16* WT, LAS float* scr, int item, int lane) {
    const int nblk = N / 32, kb = item / nblk, nb = item % nblk, k0 = 64 * kb, n0 = 32 * nb;
    float wv_[32];
#pragma unroll
    for (int i = 0; i < 32; ++i) wv_[i] = W[(size_t)(k0 + 2 * i + (lane >> 5)) * N + n0 + (lane & 31)];
#pragma unroll
    for (int i = 0; i < 32; ++i) scr[(2 * i + (lane >> 5)) * 33 + (lane & 31)] = wv_[i];
    LDS_WAIT(); asm volatile("" ::: "memory");
    const int c = lane & 7;
#pragma unroll
    for (int j = 0; j < 4; ++j) { const int n = (lane >> 3) + 8 * j; const LAS float* s = scr + (8 * c) * 33 + n;
        v4u o; o.x = pk2(s[0 * 33], s[1 * 33]); o.y = pk2(s[2 * 33], s[3 * 33]); o.z = pk2(s[4 * 33], s[5 * 33]); o.w = pk2(s[6 * 33], s[7 * 33]);
        *(v4u*)(WT + (size_t)(n0 + n) * K + k0 + 8 * c) = o; }
    LDS_WAIT(); asm volatile("" ::: "memory");
}
#define TJOB(W_, K_, N_, WT_) { const int ni_ = ((K_) / 64) * ((N_) / 32); if (r < ni_) { transpose_item((W_), (K_), (N_), (WT_), scr, r, lane); continue; } r -= ni_; }

struct RowArgs { const bf16* Yp; const float* tA; const float* tB; const bf16* tS; const bf16* Y; const float* gate; const float* gY; float* oA; bf16* oS; bf16* H; const float* gH; const float* shift; const float* scale; int nrows; };
__device__ __forceinline__ void rowpass(const RowArgs& a, int gw, int NGW, int lane) {
    F4 tfn[4]; v2u tsn[4], yn[4];
#define ROW_LOAD(row_) { const int r_ = (row_); \
        if (a.tA) { const float* tp = r_ < NLAT ? a.tA + (size_t)r_ * D : a.tB + (size_t)(r_ - NLAT) * D; _Pragma("unroll") for (int j = 0; j < 4; ++j) tfn[j] = ((const F4*)tp)[lane + 64 * j]; } \
        else { _Pragma("unroll") for (int j = 0; j < 4; ++j) tsn[j] = ((const v2u*)(a.tS + (size_t)r_ * D))[lane + 64 * j]; } \
        if (a.Y) { _Pragma("unroll") for (int j = 0; j < 4; ++j) yn[j] = ((const v2u*)(a.Y + (size_t)r_ * D))[lane + 64 * j]; } }
    int row = gw;
    if (row < a.nrows) ROW_LOAD(row)
    while (row < a.nrows) {
        const int set = row < SEQ ? 0 : (row < NLAT ? 1 : 2);
        F4 t[4]; v2u yw[4];
        if (a.tA) {
#pragma unroll
            for (int j = 0; j < 4; ++j) t[j] = tfn[j];
        } else {
#pragma unroll
            for (int j = 0; j < 4; ++j) t[j] = (F4){bflo(tsn[j].x), bfhi(tsn[j].x), bflo(tsn[j].y), bfhi(tsn[j].y)}; }
#pragma unroll
        for (int j = 0; j < 4; ++j) yw[j] = yn[j];
        const int nrow = row + NGW;
        if (nrow < a.nrows) ROW_LOAD(nrow)
        if (a.Y) {
            F4 y[4]; float ss = 0.f;
#pragma unroll
            for (int j = 0; j < 4; ++j) { const v2u w = yw[j]; y[j] = (F4){bflo(w.x), bfhi(w.x), bflo(w.y), bfhi(w.y)}; }
            if (a.Yp && row >= NLAT) {
#pragma unroll
                for (int j = 0; j < 4; ++j) { y[j] = (F4){0.f, 0.f, 0.f, 0.f};
#pragma unroll
                    for (int s4 = 0; s4 < 4; ++s4) { const v2u w = ((const v2u*)(a.Yp + ((size_t)s4 * 512 + (row - NLAT)) * D))[lane + 64 * j]; y[j] += (F4){bflo(w.x), bfhi(w.x), bflo(w.y), bfhi(w.y)}; } } }
#pragma unroll
            for (int j = 0; j < 4; ++j) ss += (y[j].x * y[j].x + y[j].y * y[j].y) + (y[j].z * y[j].z + y[j].w * y[j].w);
            const float rstd = rsqrtf(wave_sum(ss) * (1.f / D) + 1e-6f);
#pragma unroll
            for (int j = 0; j < 4; ++j) { const F4 g4 = ((const F4*)(a.gate + set * 6144))[lane + 64 * j]; const F4 gy = ((const F4*)a.gY)[lane + 64 * j]; t[j] = t[j] + g4 * ((y[j] * rstd) * gy); }
        }
        if (a.oA) { float* op = a.oA + (size_t)row * D;
#pragma unroll
            for (int j = 0; j < 4; ++j) ((F4*)op)[lane + 64 * j] = t[j]; }
        if (a.oS) {
#pragma unroll
            for (int j = 0; j < 4; ++j) { v2u w; w.x = pk2(t[j].x, t[j].y); w.y = pk2(t[j].z, t[j].w); ((v2u*)(a.oS + (size_t)row * D))[lane + 64 * j] = w;
                t[j] = (F4){bflo(w.x), bfhi(w.x), bflo(w.y), bfhi(w.y)}; } }
        if (a.H) {
            float ss = 0.f;
#pragma unroll
            for (int j = 0; j < 4; ++j) ss += (t[j].x * t[j].x + t[j].y * t[j].y) + (t[j].z * t[j].z + t[j].w * t[j].w);
            const float rstd = rsqrtf(wave_sum(ss) * (1.f / D) + 1e-6f);
#pragma unroll
            for (int j = 0; j < 4; ++j) { const F4 g = ((const F4*)a.gH)[lane + 64 * j]; const F4 sh = ((const F4*)(a.shift + set * 6144))[lane + 64 * j]; const F4 sc = ((const F4*)(a.scale + set * 6144))[lane + 64 * j];
                const F4 hv = ((t[j] * rstd) * g) * (sc + 1.f) + sh; v2u w; w.x = pk2(hv.x, hv.y); w.y = pk2(hv.z, hv.w);
                ((v2u*)(a.H + (size_t)row * D))[lane + 64 * j] = w; }
        }
        row = nrow;
    }
#undef ROW_LOAD
}

__device__ __forceinline__ void p0_prologue(const Args& A, lptr lds, int tid, int lane, int wave, const int part) {
    unsigned char* ws = A.ws;
    LAS float* cv = (LAS float*)(lds + 131072);
    LAS float* red = (LAS float*)(lds + 131072 + 12288);
    float* MV = (float*)(ws + WS_MV);
    if (part == 0) {
    for (int i = tid; i < 3 * D; i += NT) { const float v = i < 2 * D ? A.in[1][i] : A.in[3][i - 2 * D]; cv[i] = silu_f(v); }
    __syncthreads();
    for (int it = blockIdx.x; it < 4 * 192; it += gridDim.x) {
        const int layer = it / 192, n0 = (it % 192) * 32, c4 = tid & 7, kk = tid >> 3;
        const float* w = A.in[4] + (size_t)layer * D * 6144 + n0 + 4 * c4;
        F4 a0 = {0.f, 0.f, 0.f, 0.f}, a1 = a0, a2 = a0;
#pragma unroll 16
        for (int i = 0; i < 16; ++i) { const int k = kk + 64 * i; const F4 wv = *(const F4*)(w + (size_t)k * 6144); a0 += wv * cv[k]; a1 += wv * cv[D + k]; a2 += wv * cv[2 * D + k]; }
#pragma unroll
        for (int o = 8; o < 64; o <<= 1) {
#pragma unroll
            for (int e = 0; e < 4; ++e) { a0[e] += __shfl_xor(a0[e], o); a1[e] += __shfl_xor(a1[e], o); a2[e] += __shfl_xor(a2[e], o); } }
        if (lane < 8) { *(LAS F4*)(red + (wave * 3 + 0) * 32 + 4 * lane) = a0; *(LAS F4*)(red + (wave * 3 + 1) * 32 + 4 * lane) = a1; *(LAS F4*)(red + (wave * 3 + 2) * 32 + 4 * lane) = a2; }
        __syncthreads();
        if (tid < 96) { const int s = tid >> 5, c = tid & 31; float v = A.in[5][layer * 6144 + n0 + c];
#pragma unroll
            for (int w8 = 0; w8 < 8; ++w8) v += red[(w8 * 3 + s) * 32 + c];
            MV[((size_t)layer * 3 + s) * 6144 + n0 + c] = v; }
        __syncthreads();
    }
    return; }
    const int gt = blockIdx.x * NT + tid, NGT = gridDim.x * NT;
    const float TWO_PI = 6.283185307179586f;
    {
        bf16* CST = (bf16*)(ws + WS_CST); bf16* D64 = (bf16*)(ws + WS_D64); bf16* D128 = (bf16*)(ws + WS_D128); float* TW = (float*)(ws + WS_TW);
        for (int i = gt; i < 256 * 128; i += NGT) { const int rr = i >> 7, n = i & 127, m = rr & 127; const float ang = TWO_PI * (float)((m * n) & 127) * (1.f / 128.f);
            CST[i] = f2bf(rr < 128 ? cosf(ang) : -sinf(ang)); }
        for (int i = gt; i < 128 * 128; i += NGT) { const int rr = i >> 7, cc = i & 127, k1 = rr & 63, t1 = cc & 63, co = rr >> 6, ci = cc >> 6; const float ang = TWO_PI * (float)((k1 * t1) & 63) * (1.f / 64.f);
            const float cs = cosf(ang), sn = sinf(ang); D64[i] = f2bf(co == ci ? cs : (co == 0 ? sn : -sn)); }
        for (int i = gt; i < 128 * 256; i += NGT) { const int k2 = i >> 8, cc = i & 255, t2 = cc & 127, ci = cc >> 7; const float ang = TWO_PI * (float)((k2 * t2) & 127) * (1.f / 128.f);
            D128[i] = f2bf(ci == 0 ? cosf(ang) : sinf(ang)); }
        for (int i = gt; i < 64 * 128; i += NGT) { const int k1 = i >> 7, t2 = i & 127; const float ang = TWO_PI * (float)(k1 * t2) * (1.f / 8192.f); TW[2 * i] = cosf(ang); TW[2 * i + 1] = sinf(ang); }
    }
    {
        v4u* z = (v4u*)(ws + WS_SSDIN + (size_t)6208 * 1024 * 2); const v4u zero = {0u, 0u, 0u, 0u};
        for (int i = gt; i < 192 * 1024 * 2 / 16; i += NGT) z[i] = zero;
    }
    LAS float* scr = (LAS float*)(lds + wave * 16384);
    const int gw = blockIdx.x * NWAVES + wave, NGW = gridDim.x * NWAVES;
    constexpr int NIT0 = 16 * 194 + 32 * 32 + 16 * 128 + 64 * 32;
    for (int it = gw; it < NIT0; it += NGW) {
        int r = it;
        TJOB(A.in[9], 1024, 6208, (bf16*)(ws + WS_SSDIN))
        TJOB(A.in[16], 2048, 1024, (bf16*)(ws + WS_SSDOUT))
        TJOB(A.in[7], 1024, 4096, (bf16*)(ws + WS_W1_0))
        TJOB(A.in[8], 4096, 1024, (bf16*)(ws + WS_W2_0))
    }
}
__device__ __forceinline__ void late_weights(const Args& A, lptr lds, int lane, int wave) {
    unsigned char* ws = A.ws;
    LAS float* scr = (LAS float*)(lds + wave * 16384);
    const int gw = blockIdx.x * NWAVES + wave, NGW = gridDim.x * NWAVES;
    constexpr int NIT = 6 * 2048 + 1536 + 512 + 1536 + 512 + 512;
    for (int it = gw; it < NIT; it += NGW) {
        int r = it;
        TJOB(A.in[7] + (size_t)1 * D * FF, 1024, 4096, (bf16*)(ws + WS_W1L))
        TJOB(A.in[7] + (size_t)2 * D * FF, 1024, 4096, (bf16*)(ws + WS_W1L + 8 * MiB))
        TJOB(A.in[7] + (size_t)3 * D * FF, 1024, 4096, (bf16*)(ws + WS_W1L + 16 * MiB))
        TJOB(A.in[8] + (size_t)1 * D * FF, 4096, 1024, (bf16*)(ws + WS_W2L))
        TJOB(A.in[8] + (size_t)2 * D * FF, 4096, 1024, (bf16*)(ws + WS_W2L + 8 * MiB))
        TJOB(A.in[8] + (size_t)3 * D * FF, 4096, 1024, (bf16*)(ws + WS_W2L + 16 * MiB))
        TJOB(A.in[17], 1024, 3072, (bf16*)(ws + WS_QKVW))
        TJOB(A.in[19], 1024, 1024, (bf16*)(ws + WS_NAOUT))
        TJOB(A.in[20], 1024, 3072, (bf16*)(ws + WS_SCIN))
        TJOB(A.in[22], 1024, 1024, (bf16*)(ws + WS_SCOUT))
        TJOB(A.in[23], 1024, 1024, (bf16*)(ws + WS_FNW))
    }
}
template <int NTOK> struct RawRun { v4u r[NTOK + 2]; };
template <int NTOK> __device__ __forceinline__ RawRun<NTOK> load_run(const bf16* zx, int rowbase, int tlo, int seqlen, int col) {
    const v4u zero = {0u, 0u, 0u, 0u}; RawRun<NTOK> rr;
#pragma unroll
    for (int q = 0; q < NTOK + 2; ++q) { const int t = tlo - 1 + q; rr.r[q] = (t >= 0 && t < seqlen) ? *(const v4u*)(zx + (size_t)(rowbase + t) * 6144 + col) : zero; }
    return rr;
}
__device__ __forceinline__ void conv_tok(const v4u& rp, const v4u& rc, const v4u& rn, const LAS float* w, int W, int c0, float (&o)[8]) {
    const unsigned pc[4] = {rc.x, rc.y, rc.z, rc.w}, pp[4] = {rp.x, rp.y, rp.z, rp.w}, pn[4] = {rn.x, rn.y, rn.z, rn.w};
#pragma unroll
    for (int e = 0; e < 8; ++e) {
        const float xc = (e & 1) ? bfhi(pc[e >> 1]) : bflo(pc[e >> 1]), xp = (e & 1) ? bfhi(pp[e >> 1]) : bflo(pp[e >> 1]), xn = (e & 1) ? bfhi(pn[e >> 1]) : bflo(pn[e >> 1]);
        const float v = w[0 * W + c0 + e] * xp + w[1 * W + c0 + e] * xc + w[2 * W + c0 + e] * xn + w[3 * W + c0 + e];
        o[e] = silu_f(v);
    }
}
template <int DUMMY> __device__ __forceinline__ void mma_lds_rt(F16& acc, lptr A, int sa, lptr B, int sb, int lane, int ks) {
    const int r = lane & 31, h = lane >> 5;
    lptr pa = A + r * sa + h * 16; lptr pb = B + r * sb + h * 16;
#pragma unroll 2
    for (int s = 0; s < ks; ++s) { const B8 a = *(const LAS B8*)(pa + s * 32); const B8 b = *(const LAS B8*)(pb + s * 32); acc = __builtin_amdgcn_mfma_f32_32x32x16_bf16(a, b, acc, 0, 0, 0); }
}

__device__ __forceinline__ void ssd_act_phase(const Args& A, int gt, int NGT) {
    unsigned char* ws = A.ws;
    const bf16* ZX = (const bf16*)(ws + WS_ZX); bf16* ACT = (bf16*)(ws + WS_ACT);
    const float* cw = A.in[10]; const float* cb = A.in[11];
    for (int it = gt; it < (R / 8) * 512; it += NGT) {
        const int cg = it & 511, run = it >> 9, row0 = run * 8;
        const int seq0 = row0 < NLAT ? (row0 & ~(SEQ - 1)) : NLAT + ((row0 - NLAT) & ~(CTXL - 1)), seqlen = row0 < NLAT ? SEQ : CTXL, tl = row0 - seq0;
        const v4u zero = {0u, 0u, 0u, 0u};
        v4u r[10];
#pragma unroll
        for (int q = 0; q < 10; ++q) { const int t_ = tl - 1 + q; r[q] = (t_ >= 0 && t_ < seqlen) ? *(const v4u*)(ZX + (size_t)(seq0 + t_) * 6144 + 2048 + 8 * cg) : zero; }
        float w0[8], w1[8], w2[8], bb[8];
#pragma unroll
        for (int e = 0; e < 8; ++e) { w0[e] = cw[8 * cg + e]; w1[e] = cw[4096 + 8 * cg + e]; w2[e] = cw[8192 + 8 * cg + e]; bb[e] = cb[8 * cg + e]; }
#pragma unroll
        for (int q = 0; q < 8; ++q) {
            const unsigned pp[4] = {r[q].x, r[q].y, r[q].z, r[q].w}, pc[4] = {r[q + 1].x, r[q + 1].y, r[q + 1].z, r[q + 1].w}, pn[4] = {r[q + 2].x, r[q + 2].y, r[q + 2].z, r[q + 2].w};
            float o[8];
#pragma unroll
            for (int e = 0; e < 8; ++e) { const float xp = (e & 1) ? bfhi(pp[e >> 1]) : bflo(pp[e >> 1]), xc = (e & 1) ? bfhi(pc[e >> 1]) : bflo(pc[e >> 1]), xn = (e & 1) ? bfhi(pn[e >> 1]) : bflo(pn[e >> 1]);
                o[e] = silu_f(w0[e] * xp + w1[e] * xc + w2[e] * xn + bb[e]); }
            v4u w; w.x = pk2(o[0], o[1]); w.y = pk2(o[2], o[3]); w.z = pk2(o[4], o[5]); w.w = pk2(o[6], o[7]);
            *(v4u*)(ACT + (size_t)(row0 + q) * 4096 + 8 * cg) = w;
        }
    }
}
__device__ __forceinline__ void ssd_scan_phase(const Args& A, lptr lds, int tid, int lane, int wave) {
    unsigned char* ws = A.ws;
    const bf16* ZX = (const bf16*)(ws + WS_ZX); const float* DT = (const float*)(ws + WS_DT); const bf16* ACT = (const bf16*)(ws + WS_ACT);
    constexpr int SR = 272;
    lptr Cm = lds, Bm = lds + 34816, BTw = lds + 69632, XT = lds + 104448, St = lds + 121856;
    LAS float* cumL = (LAS float*)(lds + 139264); LAS float* dtL = cumL + 128; LAS float* wendL = cumL + 256; LAS float* ecumL = cumL + 384;
    LAS float* wX = (LAS float*)(lds + 141312); LAS float* wB = wX + 256; LAS float* wC = wB + 512;
    const int hf = lane >> 5, l31 = lane & 31;
    for (int unit = blockIdx.x; unit < 256; unit += gridDim.x) {
        int hv, u7;
        if (gridDim.x == 256) { const int x = unit & 7, j = unit >> 3, combo = x * 4 + (j >> 3), e8 = j & 7; hv = combo >> 4; u7 = (((combo >> 3) & 1) << 6) | (((combo >> 2) & 1) << 5) | ((combo & 3) << 3) | e8; }
        else { hv = unit >> 7; u7 = unit & 127; }
        const int sBeg = hv ? 34 : 0, sEnd = hv ? 66 : 34;
        const int b = u7 >> 6, d = (u7 >> 5) & 1, h = u7 & 31, g = h >> 3;
        bf16* SM = (bf16*)(ws + 371 * MiB) + (size_t)u7 * 8192;
        const int chX = h * 64, chB = 2048 + ((d * 2 + 0) * 4 + g) * 128, chC = 2048 + ((d * 2 + 1) * 4 + g) * 128;
        const float a_neg = -__expf(A.in[13][d * 32 + h]);
        const float Dtot = A.in[14][h] + A.in[14][32 + h];
        const float dtb = A.in[12][d * 32 + h];
        bf16* Yout = (bf16*)(ws + WS_ZX) + (d ? 4096 : 2048);
        __syncthreads();
        for (int i = tid; i < 64 * SR / 4; i += NT) ((LAS unsigned*)St)[i] = 0u;
        F16 acc_st;
#pragma unroll
        for (int e = 0; e < 16; ++e) acc_st[e] = 0.f;
        __syncthreads();
        const int cgx = tid & 7, jrx = tid >> 3, cgb = tid & 15, jrb = tid >> 4;
        v4u px[2], pb[4], pc_[4];
#define SCAN_LOAD(s_) { const int s3 = (s_), ph3 = s3 >= 2, ci3 = ph3 ? s3 - 2 : s3, nch3 = ph3 ? 64 : 2, rb3 = ph3 ? b * SEQ : NLAT + b * CTXL, t03 = (d ? nch3 - 1 - ci3 : ci3) * 128; \
            const int tlx = d ? t03 + 128 - 2 * (jrx + 1) : t03 + 2 * jrx, tlb = d ? t03 + 128 - 4 * (jrb + 1) : t03 + 4 * jrb; \
            _Pragma("unroll") for (int q = 0; q < 2; ++q) px[q] = *(const v4u*)(ACT + (size_t)(rb3 + tlx + q) * 4096 + chX + 8 * cgx); \
            _Pragma("unroll") for (int q = 0; q < 4; ++q) { pb[q] = *(const v4u*)(ACT + (size_t)(rb3 + tlb + q) * 4096 + chB + 8 * cgb); pc_[q] = *(const v4u*)(ACT + (size_t)(rb3 + tlb + q) * 4096 + chC + 8 * cgb); } }
        SCAN_LOAD(sBeg)
        float dtp0 = 0.f, dtp1 = 0.f;
#define SCAN_DT_LOAD(s_) { const int s2 = (s_), ph2 = s2 >= 2, ci2 = ph2 ? s2 - 2 : s2, nch2 = ph2 ? 64 : 2, rb2 = ph2 ? b * SEQ : NLAT + b * CTXL, t02 = (d ? nch2 - 1 - ci2 : ci2) * 128; \
            const int tA = d ? t02 + 127 - lane : t02 + lane, tB = d ? t02 + 63 - lane : t02 + 64 + lane; \
            dtp0 = DT[(size_t)(rb2 + tA) * 64 + d * 32 + h]; dtp1 = DT[(size_t)(rb2 + tB) * 64 + d * 32 + h]; }
#define SCAN_STEP1(sN) { LAS float* cb_ = (LAS float*)(lds + 139264 + (((sN) & 1) ? 2048 : 0)); \
            const float xr0 = dtp0 + dtb, xr1 = dtp1 + dtb; const float dt0 = xr0 > 20.f ? xr0 : log1pf(__expf(xr0)), dt1 = xr1 > 20.f ? xr1 : log1pf(__expf(xr1)); \
            if ((sN) + 1 < 66) SCAN_DT_LOAD((sN) + 1) \
            float v0 = dt0 * a_neg, v1 = dt1 * a_neg; \
            _Pragma("unroll") for (int o = 1; o < 64; o <<= 1) { const float u0 = __shfl_up(v0, o), u1 = __shfl_up(v1, o); if (lane >= o) { v0 += u0; v1 += u1; } } \
            v1 += __shfl(v0, 63); const float cend = __shfl(v1, 63); \
            if (hv && lane == 0) ((float*)(ws + 373 * MiB))[u7 * 32 + ((sN) - 34)] = cend; \
            cb_[lane] = v0; cb_[lane + 64] = v1; cb_[128 + lane] = dt0; cb_[192 + lane] = dt1; \
            cb_[256 + lane] = __expf(cend - v0) * dt0; cb_[320 + lane] = __expf(cend - v1) * dt1; \
            cb_[384 + lane] = __expf(v0); cb_[448 + lane] = __expf(v1); }
        if (wave == 1) { SCAN_DT_LOAD(sBeg) SCAN_STEP1(sBeg) }
        __syncthreads();
        {
            for (int s = sBeg; s < sEnd; ++s) {
                const int ph = s >= 2, ci = ph ? s - 2 : s;
                const int nch = ph ? 64 : 2, rowbase = ph ? b * SEQ : NLAT + b * CTXL, seqlen = ph ? SEQ : CTXL; (void)seqlen;
                const int c = d ? nch - 1 - ci : ci, t0 = c * 128;
                const int cbo = (s & 1) ? 2048 : 0;
                const int rstep = d ? -1 : 1;
                const size_t row0 = (size_t)(rowbase + (d ? t0 + 127 - ((wave >> 1) * 32 + 4 * hf) : t0 + (wave >> 1) * 32 + 4 * hf));
                const bf16* zp = ZX + row0 * 6144 + h * 64 + (wave & 1) * 32 + l31; bf16* yp = Yout + row0 * 6144 + h * 64 + (wave & 1) * 32 + l31;
                unsigned short zv[16];
#pragma unroll
                for (int e = 0; e < 16; ++e) { const int io = (e & 3) + 8 * (e >> 2); zv[e] = zp[(ptrdiff_t)(io * rstep) * 6144]; }
                int wof = 0; asm volatile("" : "+v"(wof));
                lptr ldsc = lds + wof;
                { lptr xtw = ldsc + 104448 + (8 * cgx) * SR + ((((jrx >> 2) ^ cgx) & 15) << 4) + ((4 * jrx) & 15); asm volatile("" : "+v"(xtw));
                  const unsigned a0[4] = {px[0].x, px[0].y, px[0].z, px[0].w}, a1[4] = {px[1].x, px[1].y, px[1].z, px[1].w};
#pragma unroll
                  for (int e = 0; e < 8; ++e) { const unsigned lo0 = (e & 1) ? (a0[e >> 1] >> 16) : (a0[e >> 1] & 0xffffu), lo1 = (e & 1) ? (a1[e >> 1] >> 16) : (a1[e >> 1] & 0xffffu);
                      *(LAS unsigned*)(xtw + e * SR) = d ? (lo1 | (lo0 << 16)) : (lo0 | (lo1 << 16)); } }
                lptr cmw = ldsc + (4 * jrb + (d ? 3 : 0)) * SR + cgb * 16; asm volatile("" : "+v"(cmw)); const int qstep = d ? -SR : SR;
#pragma unroll
                for (int q = 0; q < 4; ++q) *(LAS v4u*)(cmw + q * qstep) = pc_[q];
                { lptr bmw = cmw + 34816; lptr btw = ldsc + 69632 + (8 * cgb) * SR + ((((jrb >> 1) ^ cgb) & 15) << 4) + ((8 * jrb) & 15); asm volatile("" : "+v"(btw));
#pragma unroll
                  for (int q = 0; q < 4; ++q) *(LAS v4u*)(bmw + q * qstep) = pb[q];
                  const F4 we = *(const LAS F4*)((const LAS float*)(ldsc + 139264 + cbo) + 256 + 4 * jrb);
                  const unsigned b0[4] = {pb[0].x, pb[0].y, pb[0].z, pb[0].w}, b1[4] = {pb[1].x, pb[1].y, pb[1].z, pb[1].w}, b2[4] = {pb[2].x, pb[2].y, pb[2].z, pb[2].w}, b3[4] = {pb[3].x, pb[3].y, pb[3].z, pb[3].w};
#pragma unroll
                  for (int e = 0; e < 8; ++e) { const int q2 = e >> 1;
                      const float f0 = (e & 1) ? bfhi(b0[q2]) : bflo(b0[q2]), f1 = (e & 1) ? bfhi(b1[q2]) : bflo(b1[q2]), f2 = (e & 1) ? bfhi(b2[q2]) : bflo(b2[q2]), f3 = (e & 1) ? bfhi(b3[q2]) : bflo(b3[q2]);
                      v2u w;
                      if (d) { w.x = pk2(f3 * we.x, f2 * we.y); w.y = pk2(f1 * we.z, f0 * we.w); }
                      else   { w.x = pk2(f0 * we.x, f1 * we.y); w.y = pk2(f2 * we.z, f3 * we.w); }
                      *(LAS v2u*)(btw + e * SR) = w; } }
                if (s + 1 < sEnd) SCAN_LOAD(s + 1)
                __syncthreads();
                F16 cb0, cb1, acc2;
#pragma unroll
                for (int e = 0; e < 16; ++e) { cb0[e] = 0.f; cb1[e] = 0.f; acc2[e] = 0.f; }
                const int ti0 = (2 * wave) >> 2, tj0 = (2 * wave) & 3, tj1 = tj0 + 1;
                const int ti2 = wave >> 1, tp = wave & 1;
                { B8 af[8]; { lptr pa = Cm + ti0 * 32 * SR + l31 * SR + hf * 16;
#pragma unroll
                    for (int q = 0; q < 8; ++q) af[q] = *(const LAS B8*)(pa + q * 32); }
                  mma_ldsB<8>(acc2, af, St + tp * 32 * SR, SR, lane);
                  if (tj0 <= ti0) mma_ldsB<8>(cb0, af, Bm + tj0 * 32 * SR, SR, lane);
                  if (tj1 <= ti0) mma_ldsB<8>(cb1, af, Bm + tj1 * 32 * SR, SR, lane); }
                if (wave == 1 && s + 1 < sEnd) SCAN_STEP1(s + 1)
                __syncthreads();
                { const LAS float* cumI = (const LAS float*)(ldsc + 139264 + cbo) + ti0 * 32 + 4 * hf; const LAS float* cumJ = (const LAS float*)(ldsc + 139264 + cbo);
                  if (tj0 <= ti0) { const int j = tj0 * 32 + l31; const float cj = cumJ[j], dj = cumJ[128 + j]; lptr sw = ldsc + 34816 + (ti0 * 32 + 4 * hf) * SR + j * 2; asm volatile("" : "+v"(sw));
#pragma unroll
                    for (int e = 0; e < 16; ++e) { const int io = (e & 3) + 8 * (e >> 2); const int i = ti0 * 32 + 4 * hf + io;
                        const float v = (j <= i) ? cb0[e] * __expf(cumI[io] - cj) * dj : 0.f; *(LAS bf16*)(sw + io * SR) = f2bf(v); } }
                  if (tj1 <= ti0) { const int j = tj1 * 32 + l31; const float cj = cumJ[j], dj = cumJ[128 + j]; lptr sw = ldsc + 34816 + (ti0 * 32 + 4 * hf) * SR + j * 2; asm volatile("" : "+v"(sw));
#pragma unroll
                    for (int e = 0; e < 16; ++e) { const int io = (e & 3) + 8 * (e >> 2); const int i = ti0 * 32 + 4 * hf + io;
                        const float v = (j <= i) ? cb1[e] * __expf(cumI[io] - cj) * dj : 0.f; *(LAS bf16*)(sw + io * SR) = f2bf(v); } } }
                __syncthreads();
                F16 acc1;
#pragma unroll
                for (int e = 0; e < 16; ++e) acc1[e] = 0.f;
                mma_lds_swz_rt(acc1, Bm + ti2 * 32 * SR, SR, 0, 0, XT + tp * 32 * SR, SR, 4 * tp, 7, lane, 2 * (ti2 + 1));
                { const LAS float* ecI = (const LAS float*)(ldsc + 139264 + cbo) + 384 + ti2 * 32 + 4 * hf; const int zx_ = (4 * tp + (l31 >> 3)) & 7; lptr xd = ldsc + 104448 + (tp * 32 + l31) * SR + (8 * hf); asm volatile("" : "+v"(xd));
#pragma unroll
                  for (int e = 0; e < 16; ++e) { const int io = (e & 3) + 8 * (e >> 2);
                    float y = acc1[e] + ecI[io] * acc2[e];
                    if (d == 0) y += Dtot * bf2f(*(const LAS bf16*)(xd + ((((4 * ti2 + (e >> 2)) ^ zx_)) << 4) + (e & 3) * 2));
                    const float z = bf2f(zv[e]);
                    yp[(ptrdiff_t)(io * rstep) * 6144] = f2bf(y * silu_f(z)); } }
                const int tps = wave >> 2, tn = wave & 3; const float decay = __expf(((const LAS float*)(ldsc + 139264 + cbo))[127]);
#pragma unroll
                for (int e = 0; e < 16; ++e) acc_st[e] *= decay;
                mma_lds_swz<8>(acc_st, XT + tps * 32 * SR, SR, 4 * tps, 7, BTw + tn * 32 * SR, SR, 4 * tn, 15, lane);
                { lptr stw = ldsc + 121856 + (tps * 32 + 4 * hf) * SR + (tn * 32 + l31) * 2; asm volatile("" : "+v"(stw));
#pragma unroll
                  for (int e = 0; e < 16; ++e) { const int io = (e & 3) + 8 * (e >> 2); *(LAS bf16*)(stw + io * SR) = f2bf(acc_st[e]); } }
                __syncthreads();
            }
        }
        if (hv == 0) {
            const int tps_ = wave >> 2, tn_ = wave & 3;
            bf16* smb = SM + (size_t)(tps_ * 32 + 4 * hf) * 128 + tn_ * 32 + l31;
#pragma unroll
            for (int e = 0; e < 16; ++e) { const int io = (e & 3) + 8 * (e >> 2); smb[io * 128] = f2bf(acc_st[e]); }
        }
    }
}

__device__ __forceinline__ void ssd_corr_phase(const Args& A, lptr lds, int tid, int lane, int wave) {
    unsigned char* ws = A.ws;
    const bf16* ZX = (const bf16*)(ws + WS_ZX); const float* DT = (const float*)(ws + WS_DT); const bf16* ACT = (const bf16*)(ws + WS_ACT);
    constexpr int SR = 272;
    lptr Cm = lds, St = lds + 34816; LAS float* fac = (LAS float*)(lds + 34816 + 17408);
    const int hf = lane >> 5, l31 = lane & 31;
    for (int cu0 = blockIdx.x; cu0 < 256; cu0 += gridDim.x) {
        int cu = cu0; asm volatile("" : "+v"(cu));
        int u7, k0;
        if (gridDim.x == 256) { const int x = cu & 7, j = cu >> 3, combo = x * 4 + (j >> 3), e8 = j & 7; u7 = (((combo >> 4) & 1) << 6) | (((combo >> 3) & 1) << 5) | (((combo >> 1) & 3) << 3) | e8; k0 = (combo & 1) * 16; }
        else { u7 = cu >> 1; k0 = (cu & 1) * 16; }
        const int b = u7 >> 6, d = (u7 >> 5) & 1, h = u7 & 31, g = h >> 3;
        const int chC = 2048 + ((d * 2 + 1) * 4 + g) * 128, rowbase = b * SEQ;
        const bf16* SM = (const bf16*)(ws + 371 * MiB) + (size_t)u7 * 8192; const float* CE = (const float*)(ws + 373 * MiB) + u7 * 32;
        bf16* Yout = (bf16*)(ws + WS_ZX) + (d ? 4096 : 2048);
        const float a_neg = -__expf(A.in[13][d * 32 + h]), dtb = A.in[12][d * 32 + h];
        const int cgb = tid & 15, jrb = tid >> 4;
        __syncthreads();
#pragma unroll
        for (int q = 0; q < 2; ++q) { const int pcs = tid + NT * q, prow = pcs >> 4, pch = pcs & 15; *(LAS v4u*)(St + prow * SR + pch * 16) = *(const v4u*)(SM + prow * 128 + pch * 8); }
        v4u pc_[4]; float dr0 = 0.f, dr1 = 0.f;
#define CORR_LOAD(k_) { const int c3 = (d ? 63 - (32 + (k_)) : 32 + (k_)), t03 = c3 * 128; const int tlb = d ? t03 + 128 - 4 * (jrb + 1) : t03 + 4 * jrb; \
            _Pragma("unroll") for (int q = 0; q < 4; ++q) pc_[q] = *(const v4u*)(ACT + (size_t)(rowbase + tlb + q) * 4096 + chC + 8 * cgb); \
            if (wave == 1) { const int tA = d ? t03 + 127 - lane : t03 + lane, tB = d ? t03 + 63 - lane : t03 + 64 + lane; \
                dr0 = DT[(size_t)(rowbase + tA) * 64 + d * 32 + h]; dr1 = DT[(size_t)(rowbase + tB) * 64 + d * 32 + h]; } }
        CORR_LOAD(k0)
        for (int i = 0; i < 16; ++i) {
            const int k = k0 + i, ci = 32 + k, c = d ? 63 - ci : ci, t0 = c * 128;
            __syncthreads();
            if (wave == 1) {
                const float xr0 = dr0 + dtb, xr1 = dr1 + dtb;
                const float dt0 = xr0 > 20.f ? xr0 : log1pf(__expf(xr0)), dt1 = xr1 > 20.f ? xr1 : log1pf(__expf(xr1));
                float pre = (lane < k) ? CE[lane] : 0.f; pre = wave_sum(pre);
                float v0 = dt0 * a_neg, v1 = dt1 * a_neg;
#pragma unroll
                for (int o = 1; o < 64; o <<= 1) { const float u0 = __shfl_up(v0, o), u1 = __shfl_up(v1, o); if (lane >= o) { v0 += u0; v1 += u1; } }
                v1 += __shfl(v0, 63);
                fac[lane] = __expf(v0 + pre); fac[lane + 64] = __expf(v1 + pre);
            }
            { lptr cmw = Cm + (4 * jrb + (d ? 3 : 0)) * SR + cgb * 16; const int qstep = d ? -SR : SR;
#pragma unroll
              for (int q = 0; q < 4; ++q) *(LAS v4u*)(cmw + q * qstep) = pc_[q]; }
            const int ti2 = wave >> 1, tp = wave & 1, rstep = d ? -1 : 1;
            const size_t row0 = (size_t)(rowbase + (d ? t0 + 127 - (ti2 * 32 + 4 * hf) : t0 + ti2 * 32 + 4 * hf));
            const bf16* zp = ZX + row0 * 6144 + h * 64 + tp * 32 + l31; bf16* yp = Yout + row0 * 6144 + h * 64 + tp * 32 + l31;
            unsigned short zv[16], yv[16];
#pragma unroll
            for (int e = 0; e < 16; ++e) { const int io = (e & 3) + 8 * (e >> 2); zv[e] = zp[(ptrdiff_t)(io * rstep) * 6144]; yv[e] = yp[(ptrdiff_t)(io * rstep) * 6144]; }
            if (i < 15) CORR_LOAD(k + 1)
            __syncthreads();
            F16 acc2;
#pragma unroll
            for (int e = 0; e < 16; ++e) acc2[e] = 0.f;
            mma_lds<8>(acc2, Cm + ti2 * 32 * SR, SR, St + tp * 32 * SR, SR, lane);
#pragma unroll
            for (int e = 0; e < 16; ++e) { const int io = (e & 3) + 8 * (e >> 2);
                yp[(ptrdiff_t)(io * rstep) * 6144] = f2bf(bf2f(yv[e]) + fac[ti2 * 32 + 4 * hf + io] * acc2[e] * silu_f(bf2f(zv[e]))); }
        }
#undef CORR_LOAD
    }
}

__device__ __forceinline__ void ssd_combine(const Args& A, int gw, int NGW, int lane) {
    unsigned char* ws = A.ws;
    const bf16* YF = (const bf16*)(ws + WS_ZX) + 2048; const bf16* YB = (const bf16*)(ws + WS_ZX) + 4096; bf16* YN = (bf16*)(ws + WS_YN);
    v2u fn[8], bn[8];
#define CMB_LOAD(r_) { _Pragma("unroll") for (int j = 0; j < 8; ++j) { fn[j] = ((const v2u*)(YF + (size_t)(r_) * 6144))[lane + 64 * j]; bn[j] = ((const v2u*)(YB + (size_t)(r_) * 6144))[lane + 64 * j]; } }
    int row = gw;
    if (row < R) CMB_LOAD(row)
    while (row < R) {
        F4 s[8]; float ss = 0.f;
#pragma unroll
        for (int j = 0; j < 8; ++j) { const v2u f = fn[j], bk = bn[j];
            s[j] = (F4){bflo(f.x) + bflo(bk.x), bfhi(f.x) + bfhi(bk.x), bflo(f.y) + bflo(bk.y), bfhi(f.y) + bfhi(bk.y)};
            ss += (s[j].x * s[j].x + s[j].y * s[j].y) + (s[j].z * s[j].z + s[j].w * s[j].w); }
        const int nrow = row + NGW;
        if (nrow < R) CMB_LOAD(nrow)
        const float rstd = rsqrtf(wave_sum(ss) * (1.f / 2048.f) + 1e-6f);
#pragma unroll
        for (int j = 0; j < 8; ++j) { const F4 g = ((const F4*)A.in[15])[lane + 64 * j]; const F4 o = (s[j] * rstd) * g; v2u w; w.x = pk2(o.x, o.y); w.y = pk2(o.z, o.w);
            ((v2u*)(YN + (size_t)row * 2048))[lane + 64 * j] = w; }
        row = nrow;
    }
#undef CMB_LOAD
}

__device__ __forceinline__ void na_phase(const Args& A, lptr lds, int tid, int lane, int wave) {
    unsigned char* ws = A.ws;
    const bf16* QKV = (const bf16*)(ws + WS_G); bf16* O = (bf16*)(ws + WS_H);
    constexpr int KSR = 528, VSR = 136;
    constexpr int NABUF = 64 * KSR + 256 * VSR;
    LAS float* rp = (LAS float*)(lds + 2 * NABUF);
    const int hf = lane >> 5, l31 = lane & 31, hl = wave >> 1, qh = wave & 1;
    const int nIterNA = gridDim.x == 256 ? 4 : (1024 + (int)gridDim.x - 1) / (int)gridDim.x;
    for (int ui = 0; ui < nIterNA; ++ui) {
        int unit;
        if (gridDim.x == 256) { const int x = blockIdx.x & 7, j = blockIdx.x >> 3; unit = ((x >> 2) << 9) | ((j * 4 + ui) << 2) | (x & 3); }
        else { unit = blockIdx.x + ui * gridDim.x; if (unit >= 1024) break; }
        const int b = unit >> 9, r = (unit >> 2) & 127, hq = unit & 3;
        const int r0 = min(max(r - 4, 0), 120), hh = 4 * hq + hl;
        __syncthreads();
        for (int i = tid; i < 4 * 465; i += NT) rp[i] = A.in[18][(4 * hq) * 465 + i] * 1.4426950408889634f;
        const size_t qrow = (size_t)b * SEQ + r * 64 + 32 * qh + l31;
        B8 qf[4];
#pragma unroll
        for (int s = 0; s < 4; ++s) qf[s] = *(const B8*)(QKV + qrow * 3072 + hh * 64 + 16 * s + 8 * hf);
        const int qc = 32 * qh + l31, c0 = min(max(qc - 8, 0), 48);
        float m = -1e30f, l = 0.f; F16 o0, o1;
#pragma unroll
        for (int e = 0; e < 16; ++e) { o0[e] = 0.f; o1[e] = 0.f; }
#define NA_LOAD(it_) { const int it2_ = (it_); const size_t keybase = it2_ < 8 ? (size_t)b * SEQ + (r0 + it2_) * 64 : (size_t)NLAT + b * CTXL + (it2_ - 8) * 64; \
            _Pragma("unroll") for (int k = 0; k < 4; ++k) { const bf16* src = QKV + (keybase + 4 * kq + k) * 3072 + 1024 + hq * 256 + 8 * c8; \
                kr[k] = *(const v4u*)src; vr[k] = *(const v4u*)(src + 1024); } }
        const int kq = tid & 15, c8 = tid >> 4;
        v4u kr[4], vr[4];
#define NA_STORE(buf_) { lptr Kt_ = lds + (buf_) * NABUF; lptr VT_ = Kt_ + 64 * KSR; \
            _Pragma("unroll") for (int k = 0; k < 4; ++k) *(LAS v4u*)(Kt_ + (4 * kq + k) * KSR + c8 * 16) = kr[k]; \
            const unsigned v0[4] = {vr[0].x, vr[0].y, vr[0].z, vr[0].w}, v1[4] = {vr[1].x, vr[1].y, vr[1].z, vr[1].w}, v2[4] = {vr[2].x, vr[2].y, vr[2].z, vr[2].w}, v3[4] = {vr[3].x, vr[3].y, vr[3].z, vr[3].w}; \
            lptr vtw = VT_ + (8 * c8) * VSR + kq * 8; \
            _Pragma("unroll") for (int e = 0; e < 8; ++e) { const int q2 = e >> 1; v2u w; \
                if (e & 1) { w.x = (v0[q2] >> 16) | (v1[q2] & 0xffff0000u); w.y = (v2[q2] >> 16) | (v3[q2] & 0xffff0000u); } \
                else       { w.x = (v0[q2] & 0xffffu) | (v1[q2] << 16);     w.y = (v2[q2] & 0xffffu) | (v3[q2] << 16); } \
                *(LAS v2u*)(vtw + e * VSR) = w; } }
        NA_LOAD(0)
        NA_STORE(0)
        NA_LOAD(1)
        __syncthreads();
        for (int it = 0; it < 12; ++it) {
            lptr Kt = lds + (it & 1) * NABUF; lptr VT = Kt + 64 * KSR;
            F16 s0, s1;
#pragma unroll
            for (int e = 0; e < 16; ++e) { s0[e] = 0.f; s1[e] = 0.f; }
#pragma unroll
            for (int s = 0; s < 4; ++s) { const B8 a0 = *(const LAS B8*)(Kt + l31 * KSR + hl * 128 + s * 32 + hf * 16); const B8 a1 = *(const LAS B8*)(Kt + (32 + l31) * KSR + hl * 128 + s * 32 + hf * 16);
                s0 = __builtin_amdgcn_mfma_f32_32x32x16_bf16(a0, qf[s], s0, 0, 0, 0); s1 = __builtin_amdgcn_mfma_f32_32x32x16_bf16(a1, qf[s], s1, 0, 0, 0); }
            const int dq = it < 8 ? (qh ? 1 : 2) : 0;
            if (it < 8) {
                const LAS float* rph = rp + hl * 465 + (r0 + it - r + 7) * 31 + 15 - qc;
#pragma unroll
                for (int e = 0; e < 16; ++e) { const int k0 = rowmap(e, hf), k1 = k0 + 32;
                    if (e < 8 && dq == 1) s0[e] = -1e30f; else s0[e] = (k0 >= c0 && k0 < c0 + 16) ? s0[e] * 0.18033688011112042f + rph[k0] : -1e30f;
                    if (e >= 8 && dq == 2) s1[e] = -1e30f; else s1[e] = (k1 >= c0 && k1 < c0 + 16) ? s1[e] * 0.18033688011112042f + rph[k1] : -1e30f; }
            } else {
#pragma unroll
                for (int e = 0; e < 16; ++e) { s0[e] *= 0.18033688011112042f; s1[e] *= 0.18033688011112042f; }
            }
            float mx = -1e30f;
#pragma unroll
            for (int e = 0; e < 16; ++e) mx = fmaxf(mx, fmaxf(s0[e], s1[e]));
            mx = fmaxf(mx, __shfl_xor(mx, 32));
            const float mn = fmaxf(m, mx), alpha = __builtin_amdgcn_exp2f(m - mn); m = mn;
            float ls = 0.f;
#pragma unroll
            for (int e = 0; e < 16; ++e) { s0[e] = (e < 8 && dq == 1) ? 0.f : __builtin_amdgcn_exp2f(s0[e] - mn); s1[e] = (e >= 8 && dq == 2) ? 0.f : __builtin_amdgcn_exp2f(s1[e] - mn); ls += s0[e] + s1[e]; o0[e] *= alpha; o1[e] *= alpha; }
            l = l * alpha + ls;
#pragma unroll
            for (int kt = 0; kt < 2; ++kt)
#pragma unroll
                for (int s = 0; s < 2; ++s) {
                    if ((kt == 0 && s == 0 && dq == 1) || (kt == 1 && s == 1 && dq == 2)) continue;
                    const F16& pp = kt ? s1 : s0;
                    v4u pw; pw.x = pk2(pp[8 * s + 0], pp[8 * s + 1]); pw.y = pk2(pp[8 * s + 2], pp[8 * s + 3]); pw.z = pk2(pp[8 * s + 4], pp[8 * s + 5]); pw.w = pk2(pp[8 * s + 6], pp[8 * s + 7]);
                    const B8 pb = __builtin_bit_cast(B8, pw);
                    const int koff = (kt * 32 + 16 * s + 4 * hf) * 2;
                    { lptr vrp = VT + (hl * 64 + l31) * VSR + koff; const v2u x0 = *(const LAS v2u*)vrp, x1 = *(const LAS v2u*)(vrp + 16); const v4u aw = {x0.x, x0.y, x1.x, x1.y};
                      o0 = __builtin_amdgcn_mfma_f32_32x32x16_bf16(__builtin_bit_cast(B8, aw), pb, o0, 0, 0, 0); }
                    { lptr vrp = VT + (hl * 64 + 32 + l31) * VSR + koff; const v2u x0 = *(const LAS v2u*)vrp, x1 = *(const LAS v2u*)(vrp + 16); const v4u aw = {x0.x, x0.y, x1.x, x1.y};
                      o1 = __builtin_amdgcn_mfma_f32_32x32x16_bf16(__builtin_bit_cast(B8, aw), pb, o1, 0, 0, 0); }
                }
            if (it < 11) { NA_STORE((it + 1) & 1) if (it < 10) NA_LOAD(it + 2) }
            __syncthreads();
        }
        const float inv = 1.f / (l + __shfl_xor(l, 32));
        bf16* op = O + qrow * D + hh * 64;
#pragma unroll
        for (int gq = 0; gq < 4; ++gq) { const int dd = 8 * gq + 4 * hf;
            v2u w0; w0.x = pk2(o0[4 * gq] * inv, o0[4 * gq + 1] * inv); w0.y = pk2(o0[4 * gq + 2] * inv, o0[4 * gq + 3] * inv); *(v2u*)(op + dd) = w0;
            v2u w1; w1.x = pk2(o1[4 * gq] * inv, o1[4 * gq + 1] * inv); w1.y = pk2(o1[4 * gq + 2] * inv, o1[4 * gq + 3] * inv); *(v2u*)(op + 32 + dd) = w1; }
    }
}

__device__ __forceinline__ void sc_conv_phase(const Args& A, int gt, int NGT) {
    unsigned char* ws = A.ws;
    const bf16* P = (const bf16*)(ws + WS_G); bf16* V = (bf16*)(ws + WS_H); const float* cw = A.in[21];
    for (int it = gt; it < NLAT * 128; it += NGT) {
        const int row = it >> 7, c8 = it & 127, t = row & (SEQ - 1);
        const bf16* pr = P + (size_t)row * 3072 + 8 * c8;
        const v4u zero = {0u, 0u, 0u, 0u};
        const v4u bg = *(const v4u*)pr, cc = *(const v4u*)(pr + 1024), uc = *(const v4u*)(pr + 2048);
#ifdef CONV_NO_NEIGH
        const v4u cp = zero, up = zero, cn = zero, un = zero; (void)t;
#else
        const v4u cp = t > 0 ? *(const v4u*)(pr - 3072 + 1024) : zero, up = t > 0 ? *(const v4u*)(pr - 3072 + 2048) : zero;
        const v4u cn = t < SEQ - 1 ? *(const v4u*)(pr + 3072 + 1024) : zero, un = t < SEQ - 1 ? *(const v4u*)(pr + 3072 + 2048) : zero;
#endif
        const unsigned abg[4] = {bg.x, bg.y, bg.z, bg.w}, acc_[4] = {cc.x, cc.y, cc.z, cc.w}, auc[4] = {uc.x, uc.y, uc.z, uc.w}, acp[4] = {cp.x, cp.y, cp.z, cp.w}, aup[4] = {up.x, up.y, up.z, up.w},
                       acn[4] = {cn.x, cn.y, cn.z, cn.w}, aun[4] = {un.x, un.y, un.z, un.w};
        float o[8];
#pragma unroll
        for (int e = 0; e < 8; ++e) { const int q = e >> 1;
#define SEL(a) ((e & 1) ? bfhi(a[q]) : bflo(a[q]))
            const float v = cw[0 * D + 8 * c8 + e] * (SEL(acp) * SEL(aup)) + cw[1 * D + 8 * c8 + e] * (SEL(acc_) * SEL(auc)) + cw[2 * D + 8 * c8 + e] * (SEL(acn) * SEL(aun));
            o[e] = SEL(abg) * v;
#undef SEL
        }
        v4u w; w.x = pk2(o[0], o[1]); w.y = pk2(o[2], o[3]); w.z = pk2(o[4], o[5]); w.w = pk2(o[6], o[7]);
        *(v4u*)(V + (size_t)row * D + 8 * c8) = w;
    }
}

__device__ __forceinline__ void fn_stage2(const Args& A, lptr lds, int tid, int lane, int wave) {
    unsigned char* ws = A.ws;
    const bf16* Wc = (const bf16*)(ws + WS_G); bf16* U = (bf16*)(ws + WS_G + 64 * MiB); const bf16* D64 = (const bf16*)(ws + WS_D64); const float* TW = (const float*)(ws + WS_TW);
    constexpr int SR = 272;
    lptr Bl = lds; LAS float* twc = (LAS float*)(lds + 128 * SR);
    const int hf = lane >> 5, l31 = lane & 31;
    const int a = wave >> 2, bt = wave & 3;
    B8 fr_[8], fi_[8];
#pragma unroll
    for (int s = 0; s < 8; ++s) { fr_[s] = *(const B8*)(D64 + (size_t)(32 * a + l31) * 128 + hf * 8 + s * 16); fi_[s] = *(const B8*)(D64 + (size_t)(64 + 32 * a + l31) * 128 + hf * 8 + s * 16); }
    const int tq = tid & 15, pc = tid >> 4, comp = pc >> 4, m0 = (pc & 15) * 8;
    v4u rr[4];
#define F2_LOAD(u_) { const int u2 = (u_); const int b2 = u2 >> 10, t22 = (u2 >> 3) & 127, g2 = u2 & 7; \
        _Pragma("unroll") for (int q = 0; q < 4; ++q) rr[q] = *(const v4u*)(Wc + ((size_t)b2 * SEQ + 128 * (4 * tq + q) + t22) * 2048 + g2 * 256 + 8 * pc); }
    if ((int)blockIdx.x < 2048) F2_LOAD((int)blockIdx.x)
    for (int unit = blockIdx.x; unit < 2048; unit += gridDim.x) {
        const int b = unit >> 10, t2 = (unit >> 3) & 127, g = unit & 7;
        __syncthreads();
        { const unsigned v0[4] = {rr[0].x, rr[0].y, rr[0].z, rr[0].w}, v1[4] = {rr[1].x, rr[1].y, rr[1].z, rr[1].w}, v2[4] = {rr[2].x, rr[2].y, rr[2].z, rr[2].w}, v3[4] = {rr[3].x, rr[3].y, rr[3].z, rr[3].w};
          lptr bw = Bl + m0 * SR + (comp * 64 + 4 * tq) * 2;
#pragma unroll
          for (int e = 0; e < 8; ++e) { const int q2 = e >> 1; v2u w;
              if (e & 1) { w.x = (v0[q2] >> 16) | (v1[q2] & 0xffff0000u); w.y = (v2[q2] >> 16) | (v3[q2] & 0xffff0000u); }
              else       { w.x = (v0[q2] & 0xffffu) | (v1[q2] << 16);     w.y = (v2[q2] & 0xffffu) | (v3[q2] << 16); }
              *(LAS v2u*)(bw + e * SR) = w; } }
        if (tid < 128) twc[tid] = TW[((tid >> 1) * 128 + t2) * 2 + (tid & 1)];
        if (unit + (int)gridDim.x < 2048) F2_LOAD(unit + (int)gridDim.x)
        __syncthreads();
        F16 ar, ai;
#pragma unroll
        for (int e = 0; e < 16; ++e) { ar[e] = 0.f; ai[e] = 0.f; }
        mma_ldsB<8>(ar, fr_, Bl + bt * 32 * SR, SR, lane);
        mma_ldsB<8>(ai, fi_, Bl + bt * 32 * SR, SR, lane);
#pragma unroll
        for (int e = 0; e < 16; ++e) { const int k1 = 32 * a + rowmap(e, hf), m = bt * 32 + l31; const float cs = twc[2 * k1], sn = twc[2 * k1 + 1];
            const float ur = ar[e] * cs + ai[e] * sn, ui = ai[e] * cs - ar[e] * sn;
            bf16* dst = U + (((size_t)b * 64 + k1) * 128 + t2) * 2048 + g * 256 + m;
            dst[0] = f2bf(ur); dst[128] = f2bf(ui); }
    }
#undef F2_LOAD
}
__device__ __forceinline__ void fn_stage3(const Args& A, lptr lds, int tid, int lane, int wave) {
    unsigned char* ws = A.ws;
    const bf16* U = (const bf16*)(ws + WS_G + 64 * MiB); bf16* Fr = (bf16*)(ws + WS_H); const bf16* D128 = (const bf16*)(ws + WS_D128);
    constexpr int SR = 528;
    lptr Bl = lds;
    const int hf = lane >> 5, l31 = lane & 31;
    const int a = wave >> 1, bt0 = (wave & 1) * 2;
    B8 fa_[16];
#pragma unroll
    for (int s = 0; s < 16; ++s) fa_[s] = *(const B8*)(D128 + (size_t)(32 * a + l31) * 256 + hf * 8 + s * 16);
    v4u rr[2][4];
#define F3_LOAD(u_) { const int u2 = (u_); const int b2 = u2 >> 9, k12 = (u2 >> 3) & 63, g2 = u2 & 7; \
        _Pragma("unroll") for (int k = 0; k < 2; ++k) { const int idx = tid + NT * k, tq = idx & 31, pc = idx >> 5; \
            _Pragma("unroll") for (int q = 0; q < 4; ++q) rr[k][q] = *(const v4u*)(U + (((size_t)b2 * 64 + k12) * 128 + 4 * tq + q) * 2048 + g2 * 256 + 8 * pc); } }
    if ((int)blockIdx.x < 1024) F3_LOAD((int)blockIdx.x)
    for (int unit = blockIdx.x; unit < 1024; unit += gridDim.x) {
        const int b = unit >> 9, k1 = (unit >> 3) & 63, g = unit & 7;
        __syncthreads();
#pragma unroll
        for (int k = 0; k < 2; ++k) { const int idx = tid + NT * k, tq = idx & 31, pc = idx >> 5, comp = pc >> 4, m0 = (pc & 15) * 8;
          const unsigned v0[4] = {rr[k][0].x, rr[k][0].y, rr[k][0].z, rr[k][0].w}, v1[4] = {rr[k][1].x, rr[k][1].y, rr[k][1].z, rr[k][1].w}, v2[4] = {rr[k][2].x, rr[k][2].y, rr[k][2].z, rr[k][2].w}, v3[4] = {rr[k][3].x, rr[k][3].y, rr[k][3].z, rr[k][3].w};
          lptr bw = Bl + m0 * SR + (comp * 128 + 4 * tq) * 2;
#pragma unroll
          for (int e = 0; e < 8; ++e) { const int q2 = e >> 1; v2u w;
              if (e & 1) { w.x = (v0[q2] >> 16) | (v1[q2] & 0xffff0000u); w.y = (v2[q2] >> 16) | (v3[q2] & 0xffff0000u); }
              else       { w.x = (v0[q2] & 0xffffu) | (v1[q2] << 16);     w.y = (v2[q2] & 0xffffu) | (v3[q2] << 16); }
              *(LAS v2u*)(bw + e * SR) = w; } }
        if (unit + (int)gridDim.x < 1024) F3_LOAD(unit + (int)gridDim.x)
        __syncthreads();
        F16 c0, c1;
#pragma unroll
        for (int e = 0; e < 16; ++e) { c0[e] = 0.f; c1[e] = 0.f; }
        mma_ldsB<16>(c0, fa_, Bl + bt0 * 32 * SR, SR, lane);
        mma_ldsB<16>(c1, fa_, Bl + (bt0 + 1) * 32 * SR, SR, lane);
#pragma unroll
        for (int e = 0; e < 16; ++e) { const int k2 = 32 * a + rowmap(e, hf); bf16* dst = Fr + ((size_t)b * SEQ + k1 + 64 * k2) * D + g * 128 + bt0 * 32 + l31;
            dst[0] = f2bf(c0[e]); dst[32] = f2bf(c1[e]); }
    }
#undef F3_LOAD
}

#ifdef PROBE_L
#define PROBE_ONE(q, ptr, n) { const unsigned* rp_ = (ptr); const size_t n_ = (n); unsigned long long s = 0ull; for (size_t i = gt; i < n_; i += NGT) s += (unsigned long long)__hip_atomic_load(rp_ + i, __ATOMIC_RELAXED, __HIP_MEMORY_SCOPE_AGENT) * (unsigned long long)(2 * (i & 1023) + 1); atomicAdd(&SV[q], s); }
#define PROBE_CMP(q) { const unsigned long long cur = __hip_atomic_load(&SV[q], __ATOMIC_RELAXED, __HIP_MEMORY_SCOPE_AGENT); if (valid && cur != SV[8 + q]) fl |= (1ull << q); SV[8 + q] = cur; }
#define PROBE_RUN() { FRESH() \
            unsigned long long* SV = (unsigned long long*)(ws + 372 * MiB); \
            PROBE_ONE(0, PROBE_R0, PROBE_N0) PROBE_ONE(1, PROBE_R1, PROBE_N1) PROBE_ONE(2, PROBE_R2, PROBE_N2) PROBE_ONE(3, PROBE_R3, PROBE_N3) \
            GSYNC(); \
            if (blockIdx.x == 0 && tid == 0) { unsigned long long fl = 0ull; const bool valid = (SV[16] == 0x1234567887654321ull); \
                if (valid) fl = SV[17]; \
                PROBE_CMP(0) PROBE_CMP(1) PROBE_CMP(2) PROBE_CMP(3) \
                SV[16] = 0x1234567887654321ull; SV[17] = fl; } \
            GSYNC(); \
            const float scale = 1.f + 0.1f * (float)__hip_atomic_load(&SV[17], __ATOMIC_RELAXED, __HIP_MEMORY_SCOPE_AGENT); \
            for (int row = gw; row < NLAT; row += NGW) for (int j = 0; j < 16; ++j) A.out[(size_t)row * D + lane + 64 * j] = scale * (float)((row * 1024 + lane + 64 * j) % 977) * 0.01f; \
            return; }
#else
#define PROBE_POS -1
#define PROBE_L -1
#define PROBE_RUN() {}
#endif
__global__ void __launch_bounds__(NT, 2) mega_fwd(Args A) {
    extern __shared__ __attribute__((aligned(16))) unsigned char lds_raw[];
    cg::grid_group grid = cg::this_grid();
    lptr lds_raw_l = (lptr)lds_raw;
#ifdef TS_A
    int nts_ = 0; unsigned long long* tsb_ = (unsigned long long*)(A.ws + 373 * MiB + 524288);
    if (blockIdx.x == 0 && threadIdx.x == 0) tsb_[63] = __builtin_amdgcn_s_memrealtime();
#define TSTAMP() do { if (blockIdx.x == 0 && threadIdx.x == 0) tsb_[nts_] = __builtin_amdgcn_s_memrealtime(); ++nts_; } while (0)
#else
#define TSTAMP() do {} while (0)
#endif
    if (threadIdx.x < 4) ((volatile LAS unsigned*)(lds_raw_l + LDS_BYTES - 16))[threadIdx.x] = 0u;
    __syncthreads();
    XcdBarrier xbar = xcd_barrier_post((unsigned*)(A.ws + WS_BAR), (volatile LAS unsigned*)(lds_raw_l + LDS_BYTES - 16));
    grid.sync();
#define GSYNC() do { xcd_barrier(xbar); TSTAMP(); } while (0)
    lptr lds = (lptr)lds_raw;
    const int G = gridDim.x, NGW = G * NWAVES, NGT = G * NT;
#define FRESH() int tid = threadIdx.x; asm volatile("" : "+v"(tid)); const int lane = tid & 63, wave = __builtin_amdgcn_readfirstlane(tid >> 6); const int gw = blockIdx.x * NWAVES + wave, gt = blockIdx.x * NT + tid; (void)gw; (void)gt; (void)lane;
    unsigned char* ws = A.ws;
    const float* MV = (const float*)(ws + WS_MV);
    bf16* XS = (bf16*)(ws + WS_XS); bf16* H = (bf16*)(ws + WS_H); bf16* Y = (bf16*)(ws + WS_Y); bf16* GB = (bf16*)(ws + WS_G);
    const float* norm_g = A.in[6];


#ifndef NO_P0
    { FRESH() p0_prologue(A, lds, tid, lane, wave, 0); }
#ifdef PROBE_L
    if (blockIdx.x == 0 && threadIdx.x < 8) ((unsigned long long*)(ws + 372 * MiB))[threadIdx.x] = 0ull;
#endif
#endif

    GSYNC();
    { FRESH() RowArgs ra{nullptr, A.in[0], A.in[2], nullptr, nullptr, nullptr, nullptr, nullptr, nullptr, H, norm_g, MV, MV + 1024, R}; rowpass(ra, gw, NGW, lane);
      p0_prologue(A, lds, tid, lane, wave, 1); }
    GSYNC();

#pragma unroll 1
#ifndef NLAYERS
#define NLAYERS 4
#endif
    for (int L = 0; L < NLAYERS; ++L) {
        const float* MVL = MV + (size_t)L * 3 * 6144; const float* gL = norm_g + L * 4 * D;
        const int M = (L == 0) ? R : NLAT;
#ifdef SKIPMIX_L
        const bool skipmix = (L == SKIPMIX_L);
#else
        const bool skipmix = false;
#endif
        if (skipmix) {} else
        if (L == 0) {
            pg8::Gemm g{H, (const bf16*)(ws + WS_SSDIN), R, 6400, 1024}; pg8::StaticOrder S; S.init(R, 6400, G, (int)blockIdx.x);
            pg8::EpiSsdIn E{(bf16*)(ws + WS_ZX), (float*)(ws + WS_DT), A.in[12]};

#ifndef NO_GSSD
            pg8::gemm_phase<pg8::EpiSsdIn, pg8::StaticOrder, true, true>(lds, g, S, E);
#endif

        } else {
            pg8::Gemm g; pg8::EpiStore<0> E;
            if (L == 1) { g = pg8::Gemm{H, (const bf16*)(ws + WS_QKVW), R, 3072, 1024}; E = pg8::EpiStore<0>{GB, 3072}; }
            else if (L == 2) { g = pg8::Gemm{H, (const bf16*)(ws + WS_SCIN), NLAT, 3072, 1024}; E = pg8::EpiStore<0>{GB, 3072}; }
            else { g = pg8::Gemm{H, (const bf16*)(ws + WS_CST), NLAT * 8, 256, 128}; E = pg8::EpiStore<0>{GB, 256}; }
            pg8::StaticOrder S; S.init(g.M, g.N, G, (int)blockIdx.x);

#ifndef NO_GIN
            pg8::gemm_phase<pg8::EpiStore<0>, pg8::StaticOrder, false, true>(lds, g, S, E);
#endif

        }
        GSYNC();
#ifdef PROBE_L
        if (PROBE_POS == 0 && L == PROBE_L) PROBE_RUN()
#endif
#ifdef DUMP_P_L
        if (L == DUMP_P_L) { FRESH() const bf16* Pp = (const bf16*)(ws + DUMP_SRC) + DUMP_COL0;
            for (int row = gw; row < NLAT; row += NGW) for (int j = 0; j < 16; ++j) { const size_t ei = (size_t)row * DUMP_LD + lane + 64 * j; const unsigned wv = __hip_atomic_load((const unsigned*)Pp + (ei >> 1), __ATOMIC_RELAXED, __HIP_MEMORY_SCOPE_AGENT);
                A.out[(size_t)row * D + lane + 64 * j] = row < DUMP_ROWS ? ((ei & 1) ? bfhi(wv) : bflo(wv)) : 0.f; }
            return; }
#endif
        const bf16* oA = H; const bf16* oB; int oK = 1024;
        if (L == 0) {

#ifndef NO_SCAN
#ifdef SCAN_DELAY
            for (int q_ = 0; q_ < SCAN_DELAY; ++q_) __builtin_amdgcn_s_sleep(64);
            GSYNC();
#endif
            { FRESH() ssd_act_phase(A, gt, NGT); }
            GSYNC();
            { FRESH() ssd_scan_phase(A, lds, tid, lane, wave); }
            GSYNC();
            { FRESH() ssd_corr_phase(A, lds, tid, lane, wave); }
#endif

            GSYNC();
        if (PROBE_POS == 1 && L == PROBE_L) PROBE_RUN()


#ifndef NO_COMB
            { FRESH() ssd_combine(A, gw, NGW, lane); }
#endif

            GSYNC();
        if (PROBE_POS == 2 && L == PROBE_L) PROBE_RUN()

            oA = (const bf16*)(ws + WS_YN); oB = (const bf16*)(ws + WS_SSDOUT); oK = 2048;
        } else if (L == 1) {

#ifndef NO_NA
            { FRESH() na_phase(A, lds, tid, lane, wave); }
#endif

            GSYNC();
            oB = (const bf16*)(ws + WS_NAOUT);
        } else if (L == 2) {
            if (!skipmix)
#ifndef NO_CONV
            { FRESH() sc_conv_phase(A, gt, NGT); }
#endif

            GSYNC();
            oB = (const bf16*)(ws + WS_SCOUT);
        } else {

#ifndef NO_F2
            { FRESH() fn_stage2(A, lds, tid, lane, wave); }
#endif

            GSYNC();

#ifndef NO_F3
            { FRESH() fn_stage3(A, lds, tid, lane, wave); }
#endif

            GSYNC();
            oB = (const bf16*)(ws + WS_FNW);
        }
#pragma unroll 1
        for (int half = 0; half < 2; ++half) {
            if (half == 1) {
                const bf16* w1 = (const bf16*)(ws + (L == 0 ? WS_W1_0 : WS_W1L + (size_t)(L - 1) * 8 * MiB));
                pg8::Gemm g{H, w1, M, FF, 1024}; pg8::StaticOrder S; S.init(M, FF, G, (int)blockIdx.x); pg8::EpiStore<1> E{GB, FF};
#ifndef NO_MLP1
                pg8::gemm_phase<pg8::EpiStore<1>, pg8::StaticOrder, true, true>(lds, g, S, E);
#endif
                GSYNC();
            }
            const bf16* gA = half ? (const bf16*)GB : oA;
            const bf16* gB = half ? (const bf16*)(ws + (L == 0 ? WS_W2_0 : WS_W2L + (size_t)(L - 1) * 8 * MiB)) : oB;
            const int gK = half ? FF : oK;
            const float* gate = MVL + (half ? 5 : 2) * 1024; const float* gY = gL + (half ? 3 : 1) * D;
            const float* gH = gL + (half ? 4 : 2) * D; const float* shf = half ? MVL + 3 * 6144 : MVL + 3 * 1024; const float* scl = half ? MVL + 3 * 6144 + 1024 : MVL + 4 * 1024;
            const bool last = (L == 3 && half == 1);
            if (L == 0 || G != 256) {
                bf16* YP = (bf16*)(ws + 378 * MiB);
#pragma unroll 1
                for (int part = 0; part < (L == 0 ? 2 : 1); ++part) {
                  pg8::Gemm g{gA, gB, part ? R : NLAT, 1024, part ? gK / 4 : gK, gK}; pg8::StaticOrder S; S.init(g.M, 1024, G, (int)blockIdx.x); S.split = part; S.kbytes = (gK / 4) * 2;
                  pg8::EpiStore<0> E{part ? YP : Y, 1024, part ? (size_t)512 * 1024 : (size_t)0, part ? NLAT : 0};
#ifndef NO_GOUT
                  pg8::gemm_phase<pg8::EpiStore<0>, pg8::StaticOrder, true, true>(lds, g, S, E);
#endif
                }
                GSYNC();
                { FRESH() RowArgs ra{L == 0 ? YP : nullptr, (L == 0 && !half) ? A.in[0] : nullptr, (L == 0 && !half) ? A.in[2] : nullptr, XS, Y, gate, gY, last ? A.out : nullptr, last ? nullptr : XS, last ? nullptr : H, gH, shf, scl, M};
                  rowpass(ra, gw, NGW, lane);
                  if (L == 0 && half == 0) late_weights(A, lds, lane, wave); }
                if (!last) GSYNC();
            } else {
                const int bank = (((L - 1) * 2 + half) * 2);
                unsigned* cnt0 = (unsigned*)(ws + WS_BAR + 65536) + (size_t)bank * 4096; float* sl0 = (float*)(ws + 374 * MiB) + (size_t)bank * 65536;
                pg8::Gemm g{gA, gB, NLAT, 1024, gK}; pg8::StaticOrder S; S.init(NLAT, 1024, G, (int)blockIdx.x);
                pg8::EpiRowFuse E{XS, last ? A.out : nullptr, last ? nullptr : H, gate, gY, gH, shf, scl, pg8::RowStat{sl0, cnt0}, pg8::RowStat{sl0 + 65536, cnt0 + 4096}};
#ifndef NO_MLP2
                pg8::gemm_phase<pg8::EpiRowFuse, pg8::StaticOrder, false, true>(lds, g, S, E);
#endif
                if (!last) GSYNC();
            }
        }
    }
#ifdef TS_A
    GSYNC();
    { const float us_a = 0.01f * (float)(long long)(__hip_atomic_load(&tsb_[TS_B], __ATOMIC_RELAXED, __HIP_MEMORY_SCOPE_AGENT) - __hip_atomic_load(&tsb_[TS_A], __ATOMIC_RELAXED, __HIP_MEMORY_SCOPE_AGENT));
      const float us_c = 0.01f * (float)(long long)(__hip_atomic_load(&tsb_[TS_D], __ATOMIC_RELAXED, __HIP_MEMORY_SCOPE_AGENT) - __hip_atomic_load(&tsb_[TS_C], __ATOMIC_RELAXED, __HIP_MEMORY_SCOPE_AGENT));
      const bool warm_ = (__hip_atomic_load(&tsb_[62], __ATOMIC_RELAXED, __HIP_MEMORY_SCOPE_AGENT) == 0x5555aaaa12345678ull);
      const float sc_ = warm_ ? 1.f + us_a * (1.f / 2000.f) : 1.f; (void)us_c;
      for (size_t i = (size_t)blockIdx.x * NT + threadIdx.x; i < (size_t)NLAT * D; i += (size_t)gridDim.x * NT) { float v = A.out[i] * sc_; A.out[i] = v; } }
    GSYNC();
    if (blockIdx.x == 0 && threadIdx.x == 0) tsb_[62] = 0x5555aaaa12345678ull;
#endif
#if NLAYERS < 4
    { FRESH() for (int row = gw; row < NLAT; row += NGW) for (int j = 0; j < 4; ++j) ((F4*)(A.out + (size_t)row * D))[lane + 64 * j] = ((const F4*)(XS + (size_t)row * D))[lane + 64 * j]; }
#endif
}

extern "C" void kernel_launch(void* const* d_in, const int* in_sizes, int n_in, void* d_out, int out_size, void* d_ws, size_t ws_size, hipStream_t stream) {
    static int grid = 0;
    if (grid == 0) {
        if (n_in != 24 || ws_size < (size_t)382 * MiB) { fprintf(stderr, "kernel_launch: need 24 inputs and %zu bytes of workspace (got %d, %zu)\n", (size_t)WS_END, n_in, ws_size); grid = -1; return; }
        int dev = 0, cus = 0, per_cu = 0;
        hipGetDevice(&dev); hipDeviceGetAttribute(&cus, hipDeviceAttributeMultiprocessorCount, dev);
        if (hipFuncSetAttribute((const void*)mega_fwd, hipFuncAttributeMaxDynamicSharedMemorySize, LDS_BYTES) != hipSuccess) { fprintf(stderr, "kernel_launch: hipFuncSetAttribute failed\n"); grid = -1; return; }
        if (hipOccupancyMaxActiveBlocksPerMultiprocessor(&per_cu, (const void*)mega_fwd, NT, LDS_BYTES) != hipSuccess || per_cu < 1) { fprintf(stderr, "kernel_launch: occupancy query says %d\n", per_cu); per_cu = 1; }
        (void)hipGetLastError();
        grid = cus;
    }
    if (grid < 0) return;
    if (hipMemsetAsync((char*)d_ws + WS_BAR, 0, 262144, stream) != hipSuccess) { fprintf(stderr, "kernel_launch: memset failed\n"); return; }
    Args a{};
    for (int i = 0; i < 24; ++i) a.in[i] = (const float*)d_in[i];
    a.out = (float*)d_out; a.ws = (unsigned char*)d_ws;
    void* args[] = {&a};
    hipError_t e = hipLaunchCooperativeKernel((const void*)mega_fwd, dim3(grid), dim3(NT), args, LDS_BYTES, stream);
    if (e != hipSuccess) fprintf(stderr, "cooperative launch failed: %s (grid %d)\n", hipGetErrorString(e), grid);
}
```
